# Optimizing an MI355X kernel written in HIP

```python
import math
import jax
import jax.numpy as jnp
from jax import lax
import numpy as np

D_MODEL = 2048
BATCH = 4
SEQ = 2048
DEPTH = 4
DEC_BATCH = 32
DEC_SEQ = 64
PAST_LEN = 2048

CHUNK = 64
N_MIXERS = 3
N_LAYERS_A = (DEPTH + 2) // 3
N_LAYERS_B = (DEPTH + 1) // 3
N_LAYERS_C = DEPTH // 3
DEEPNORM_ALPHA = (2.0 * DEPTH) ** 0.25
DEEPNORM_BETA = (8.0 * DEPTH) ** -0.25
LN_EPS = 1e-5
RMS_EPS = 1e-6
NEG_INF = -1e30

SSM_GROUP = 16
SSM_GROUPS = D_MODEL // SSM_GROUP
SSM_STATE = 64
SSM_DT_MIN = 1e-3
SSM_DT_MAX = 1e-1

N_HEADS_B = 16
HEAD_DIM_B = D_MODEL // N_HEADS_B
LEFT_CHUNKS = 8
BAND_CHUNKS = LEFT_CHUNKS + 1
BAND_ROWS_MAX = LEFT_CHUNKS * CHUNK
MAX_REL_DIST = 128

N_HEADS_C = 16
HGRN_KDIM = D_MODEL // N_HEADS_C
HGRN_VDIM = D_MODEL // N_HEADS_C
HGRN_BLOCK = 16

D_FF = 4 * D_MODEL

BAND_ROWS = min(BAND_ROWS_MAX, PAST_LEN)

kernel_name = 'hybrid_s5_chunkattn_hgrn2_stream_step'


def layer_norm(x, g, b):
    xf = x.astype(jnp.float32)
    mu = jnp.mean(xf, axis=-1, keepdims=True)
    var = jnp.mean(jnp.square(xf - mu), axis=-1, keepdims=True)
    y = (xf - mu) * lax.rsqrt(var + LN_EPS) * g.astype(jnp.float32) + b.astype(jnp.float32)
    return y.astype(x.dtype)


def sq_relu_mlp(x, w1, w2):
    return jnp.square(jax.nn.relu(x @ w1)) @ w2


def _linear_combine(e1, e2):
    a1, h1 = e1
    a2, h2 = e2
    return a1 * a2, a2 * h1 + h2


def s5_mixer(x, h0_re, h0_im, a_re, a_im, log_dt, b_re, b_im, c_re, c_im, d_skip, w_out, w_gate):
    n, t, _ = x.shape
    f32 = jnp.float32
    u = x.astype(f32).reshape(n, t, SSM_GROUPS, SSM_GROUP)
    lam = lax.complex(a_re.astype(f32), a_im.astype(f32))
    dt = jnp.exp(log_dt.astype(f32))[:, None]
    a_bar = jnp.exp(lam * dt)
    b_bar = ((a_bar - 1.0) / lam)[..., None] * lax.complex(b_re.astype(f32), b_im.astype(f32))
    c = lax.complex(c_re.astype(f32), c_im.astype(f32))
    bu = jnp.einsum('gpq,ntgq->ntgp', b_bar, u.astype(jnp.complex64))
    a_seq = jnp.broadcast_to(a_bar, (1, t) + a_bar.shape)
    a_cum, h = lax.associative_scan(_linear_combine, (a_seq, bu), axis=1)
    if h0_re is not None:
        h0 = lax.complex(h0_re.astype(f32), h0_im.astype(f32))
        h = h + a_cum * h0[:, None]
    y = jnp.real(jnp.einsum('gqp,ntgp->ntgq', c, h)) + d_skip.astype(f32).reshape(SSM_GROUPS, SSM_GROUP) * u
    y = jax.nn.gelu(y.reshape(n, t, D_MODEL)).astype(x.dtype)
    out = (y @ w_out) * jax.nn.sigmoid(y @ w_gate)
    h_last = h[:, -1]
    return out.astype(x.dtype), jnp.real(h_last), jnp.imag(h_last)


def _rel_bias(table, qpos, kpos):
    rel = jnp.clip(qpos[:, None] - kpos[None, :], -MAX_REL_DIST, MAX_REL_DIST) + MAX_REL_DIST
    return table.astype(jnp.float32)[:, rel]


def _qkv_heads(x, w_qkv):
    n, t, _ = x.shape
    q, k, v = jnp.split(x @ w_qkv, 3, axis=-1)
    shp = (n, t, N_HEADS_B, HEAD_DIM_B)
    return q.reshape(shp), k.reshape(shp), v.reshape(shp)


def chunk_attn_prompt(x, w_qkv, rel_table, w_o):
    n, t, _ = x.shape
    nc = t // CHUNK
    q, k, v = _qkv_heads(x, w_qkv)
    cshape = (n, nc, CHUNK, N_HEADS_B, HEAD_DIM_B)
    pad = jnp.zeros((n, LEFT_CHUNKS, CHUNK, N_HEADS_B, HEAD_DIM_B), k.dtype)
    kp = jnp.concatenate([pad, k.reshape(cshape)], axis=1)
    vp = jnp.concatenate([pad, v.reshape(cshape)], axis=1)
    band = jnp.arange(nc)[:, None] + jnp.arange(BAND_CHUNKS)[None, :]
    kb = kp[:, band].reshape(n, nc, BAND_CHUNKS * CHUNK, N_HEADS_B, HEAD_DIM_B)
    vb = vp[:, band].reshape(n, nc, BAND_CHUNKS * CHUNK, N_HEADS_B, HEAD_DIM_B)
    valid = jnp.repeat(band >= LEFT_CHUNKS, CHUNK, axis=1)
    bias = _rel_bias(rel_table, jnp.arange(CHUNK), jnp.arange(BAND_CHUNKS * CHUNK) - LEFT_CHUNKS * CHUNK)
    s = jnp.einsum('ncqhd,nckhd->nchqk', q.reshape(cshape), kb, preferred_element_type=jnp.float32)
    s = s * (HEAD_DIM_B ** -0.5) + bias[None, None]
    s = jnp.where(valid[None, :, None, None, :], s, NEG_INF)
    p = jax.nn.softmax(s, axis=-1).astype(v.dtype)
    o = jnp.einsum('nchqk,nckhd->ncqhd', p, vb)
    y = o.reshape(n, t, D_MODEL) @ w_o
    rows = min(BAND_ROWS_MAX, t)
    return y, k[:, t - rows:], v[:, t - rows:]


def chunk_attn_sample(x, k_cache, v_cache, w_qkv, rel_table, w_o):
    n, t, _ = x.shape
    rows = k_cache.shape[1]
    q, k, v = _qkv_heads(x, w_qkv)
    kk = jnp.concatenate([k_cache.astype(k.dtype), k], axis=1)
    vv = jnp.concatenate([v_cache.astype(v.dtype), v], axis=1)
    kpos = jnp.concatenate([jnp.arange(rows) - rows, jnp.arange(t)])
    bias = _rel_bias(rel_table, jnp.arange(t), kpos)
    s = jnp.einsum('nqhd,nkhd->nhqk', q, kk, preferred_element_type=jnp.float32) * (HEAD_DIM_B ** -0.5) + bias[None]
    p = jax.nn.softmax(s, axis=-1).astype(v.dtype)
    o = jnp.einsum('nhqk,nkhd->nqhd', p, vv)
    return o.reshape(n, t, D_MODEL) @ w_o, k, v


def hgrn2_mixer(x, s0, w_in, lb, norm_g, w_o):
    n, t, _ = x.shape
    f32 = jnp.float32
    q, f_logit, i_val, g = jnp.split(x @ w_in, 4, axis=-1)
    lbf = lb.astype(f32)
    f = lbf + (1.0 - lbf) * jax.nn.sigmoid(f_logit.astype(f32))
    log_f = jnp.log(f)
    k = 1.0 - f
    pad = (-t) % HGRN_BLOCK
    tp = t + pad
    nb = tp // HGRN_BLOCK

    def blocks(a):
        a = jnp.pad(a.astype(f32), ((0, 0), (0, pad), (0, 0)))
        return a.reshape(n, nb, HGRN_BLOCK, N_HEADS_C, -1).transpose(1, 0, 2, 3, 4)

    qb, kb, vb, lfb = blocks(q), blocks(k), blocks(i_val), blocks(log_f)
    if s0 is None:
        s0 = jnp.zeros((n, N_HEADS_C, HGRN_KDIM, HGRN_VDIM), f32)
    else:
        s0 = s0.astype(f32)
    tril = jnp.tril(jnp.ones((HGRN_BLOCK, HGRN_BLOCK), dtype=bool))
    mid = HGRN_BLOCK // 2

    def step(s, blk):
        qc, kc, vc, lfc = blk
        bcum = jnp.cumsum(lfc, axis=1)
        ref = bcum[:, mid - 1:mid]
        intra = jnp.einsum('nthk,nshk->nhts', qc * jnp.exp(bcum - ref), kc * jnp.exp(ref - bcum))
        intra = jnp.where(tril, intra, 0.0)
        o = jnp.einsum('nhts,nshv->nthv', intra, vc) + jnp.einsum('nthk,nhkv->nthv', qc * jnp.exp(bcum), s)
        blast = bcum[:, -1:]
        s_new = s * jnp.exp(blast[:, 0])[..., None] + jnp.einsum('nshk,nshv->nhkv', kc * jnp.exp(blast - bcum), vc)
        return s_new, o

    s_fin, o = lax.scan(step, s0, (qb, kb, vb, lfb))
    o = o.transpose(1, 0, 2, 3, 4).reshape(n, tp, N_HEADS_C, HGRN_VDIM)[:, :t]
    o = o * lax.rsqrt(jnp.mean(jnp.square(o), axis=-1, keepdims=True) + RMS_EPS) * norm_g.astype(f32)
    o = (o.reshape(n, t, D_MODEL) * jax.nn.silu(g.astype(f32))).astype(x.dtype)
    return o @ w_o, s_fin


def setup_inputs(seed: int = 0) -> dict:
    key = jax.random.key(seed)
    keys = jax.random.split(key, 32)
    counter = iter(range(32))
    f32 = jnp.float32

    def nrm(shape, scale):
        return scale * jax.random.normal(keys[next(counter)], shape, f32)

    d_inv = D_MODEL ** -0.5
    x_prompt = nrm((BATCH, SEQ, D_MODEL), 1.0)
    x_sample = nrm((DEC_BATCH, DEC_SEQ, D_MODEL), 1.0)
    state_ssm_re = nrm((N_LAYERS_A, DEC_BATCH, SSM_GROUPS, SSM_STATE), 0.1)
    state_ssm_im = nrm((N_LAYERS_A, DEC_BATCH, SSM_GROUPS, SSM_STATE), 0.1)
    cache_attn_k = nrm((N_LAYERS_B, DEC_BATCH, BAND_ROWS, N_HEADS_B, HEAD_DIM_B), 1.0)
    cache_attn_v = nrm((N_LAYERS_B, DEC_BATCH, BAND_ROWS, N_HEADS_B, HEAD_DIM_B), 1.0)
    state_hgrn = nrm((N_LAYERS_C, DEC_BATCH, N_HEADS_C, HGRN_KDIM, HGRN_VDIM), 0.5)

    n_idx = jnp.arange(SSM_STATE, dtype=f32)
    ssm_a_re = -0.5 + nrm((N_LAYERS_A, SSM_GROUPS, SSM_STATE), 0.01)
    ssm_a_im = math.pi * n_idx + nrm((N_LAYERS_A, SSM_GROUPS, SSM_STATE), 0.01)
    ssm_log_dt = jax.random.uniform(keys[next(counter)], (N_LAYERS_A, SSM_GROUPS), f32,
                                    math.log(SSM_DT_MIN), math.log(SSM_DT_MAX))
    ssm_b_re = nrm((N_LAYERS_A, SSM_GROUPS, SSM_STATE, SSM_GROUP), SSM_GROUP ** -0.5)
    ssm_b_im = nrm((N_LAYERS_A, SSM_GROUPS, SSM_STATE, SSM_GROUP), SSM_GROUP ** -0.5)
    ssm_c_re = nrm((N_LAYERS_A, SSM_GROUPS, SSM_GROUP, SSM_STATE), 0.5)
    ssm_c_im = nrm((N_LAYERS_A, SSM_GROUPS, SSM_GROUP, SSM_STATE), 0.5)
    ssm_d = nrm((N_LAYERS_A, D_MODEL), 1.0)
    ssm_w_out = nrm((N_LAYERS_A, D_MODEL, D_MODEL), d_inv * DEEPNORM_BETA)
    ssm_w_gate = nrm((N_LAYERS_A, D_MODEL, D_MODEL), d_inv)

    qkv_scale = jnp.concatenate([jnp.ones((2 * D_MODEL,), f32), jnp.full((D_MODEL,), DEEPNORM_BETA, f32)])
    attn_w_qkv = nrm((N_LAYERS_B, D_MODEL, 3 * D_MODEL), d_inv) * qkv_scale
    attn_rel_bias = nrm((N_LAYERS_B, N_HEADS_B, 2 * MAX_REL_DIST + 1), 0.1)
    attn_w_o = nrm((N_LAYERS_B, D_MODEL, D_MODEL), d_inv * DEEPNORM_BETA)

    in_scale = jnp.concatenate([jnp.ones((2 * D_MODEL,), f32), jnp.full((D_MODEL,), DEEPNORM_BETA, f32),
                                jnp.ones((D_MODEL,), f32)])
    hgrn_w_in = nrm((N_LAYERS_C, D_MODEL, 4 * D_MODEL), d_inv) * in_scale
    hgrn_lb_logits = nrm((DEPTH, D_MODEL), 0.1)
    hgrn_norm_g = 1.0 + nrm((N_LAYERS_C, HGRN_VDIM), 0.01)
    hgrn_w_o = nrm((N_LAYERS_C, D_MODEL, D_MODEL), d_inv * DEEPNORM_BETA)

    ln_mix_g = 1.0 + nrm((DEPTH, D_MODEL), 0.01)
    ln_mix_b = nrm((DEPTH, D_MODEL), 0.01)
    ln_ffn_g = 1.0 + nrm((DEPTH, D_MODEL), 0.01)
    ln_ffn_b = nrm((DEPTH, D_MODEL), 0.01)
    ffn_w1 = nrm((DEPTH, D_MODEL, D_FF), d_inv * DEEPNORM_BETA)
    ffn_w2 = nrm((DEPTH, D_FF, D_MODEL), D_FF ** -0.5 * DEEPNORM_BETA)

    return {
        'x_prompt': x_prompt, 'x_sample': x_sample,
        'state_ssm_re': state_ssm_re, 'state_ssm_im': state_ssm_im,
        'cache_attn_k': cache_attn_k, 'cache_attn_v': cache_attn_v,
        'state_hgrn': state_hgrn,
        'ssm_a_re': ssm_a_re, 'ssm_a_im': ssm_a_im, 'ssm_log_dt': ssm_log_dt,
        'ssm_b_re': ssm_b_re, 'ssm_b_im': ssm_b_im, 'ssm_c_re': ssm_c_re, 'ssm_c_im': ssm_c_im,
        'ssm_d': ssm_d, 'ssm_w_out': ssm_w_out, 'ssm_w_gate': ssm_w_gate,
        'attn_w_qkv': attn_w_qkv, 'attn_rel_bias': attn_rel_bias, 'attn_w_o': attn_w_o,
        'hgrn_w_in': hgrn_w_in, 'hgrn_lb_logits': hgrn_lb_logits, 'hgrn_norm_g': hgrn_norm_g,
        'hgrn_w_o': hgrn_w_o,
        'ln_mix_g': ln_mix_g, 'ln_mix_b': ln_mix_b, 'ln_ffn_g': ln_ffn_g, 'ln_ffn_b': ln_ffn_b,
        'ffn_w1': ffn_w1, 'ffn_w2': ffn_w2,
    }


def reference(x_prompt, x_sample, state_ssm_re, state_ssm_im, cache_attn_k, cache_attn_v, state_hgrn,
              ssm_a_re, ssm_a_im, ssm_log_dt, ssm_b_re, ssm_b_im, ssm_c_re, ssm_c_im, ssm_d,
              ssm_w_out, ssm_w_gate, attn_w_qkv, attn_rel_bias, attn_w_o,
              hgrn_w_in, hgrn_lb_logits, hgrn_norm_g, hgrn_w_o,
              ln_mix_g, ln_mix_b, ln_ffn_g, ln_ffn_b, ffn_w1, ffn_w2):
    lb_cum = jnp.cumsum(jax.nn.softmax(hgrn_lb_logits.astype(jnp.float32), axis=0), axis=0)
    lower_bounds = lb_cum - lb_cum[:1]

    yp, ys = x_prompt, x_sample
    ssm_re_p, ssm_im_p, ssm_re_s, ssm_im_s = [], [], [], []
    k_p, v_p, k_s, v_s = [], [], [], []
    hg_p, hg_s = [], []
    for layer in range(DEPTH):
        kind = layer % N_MIXERS
        j = layer // N_MIXERS
        if kind == 0:
            w = (ssm_a_re[j], ssm_a_im[j], ssm_log_dt[j], ssm_b_re[j], ssm_b_im[j],
                 ssm_c_re[j], ssm_c_im[j], ssm_d[j], ssm_w_out[j], ssm_w_gate[j])
            mp, re_p, im_p = s5_mixer(yp, None, None, *w)
            ms, re_s, im_s = s5_mixer(ys, state_ssm_re[j], state_ssm_im[j], *w)
            ssm_re_p.append(re_p)
            ssm_im_p.append(im_p)
            ssm_re_s.append(re_s)
            ssm_im_s.append(im_s)
        elif kind == 1:
            mp, kp_new, vp_new = chunk_attn_prompt(yp, attn_w_qkv[j], attn_rel_bias[j], attn_w_o[j])
            ms, ks_new, vs_new = chunk_attn_sample(ys, cache_attn_k[j], cache_attn_v[j],
                                                   attn_w_qkv[j], attn_rel_bias[j], attn_w_o[j])
            k_p.append(kp_new)
            v_p.append(vp_new)
            k_s.append(ks_new)
            v_s.append(vs_new)
        else:
            w = (hgrn_w_in[j], lower_bounds[layer], hgrn_norm_g[j], hgrn_w_o[j])
            mp, sp_new = hgrn2_mixer(yp, None, *w)
            ms, ss_new = hgrn2_mixer(ys, state_hgrn[j], *w)
            hg_p.append(sp_new)
            hg_s.append(ss_new)
        yp = layer_norm(DEEPNORM_ALPHA * yp + mp, ln_mix_g[layer], ln_mix_b[layer])
        ys = layer_norm(DEEPNORM_ALPHA * ys + ms, ln_mix_g[layer], ln_mix_b[layer])
        yp = layer_norm(DEEPNORM_ALPHA * yp + sq_relu_mlp(yp, ffn_w1[layer], ffn_w2[layer]),
                        ln_ffn_g[layer], ln_ffn_b[layer])
        ys = layer_norm(DEEPNORM_ALPHA * ys + sq_relu_mlp(ys, ffn_w1[layer], ffn_w2[layer]),
                        ln_ffn_g[layer], ln_ffn_b[layer])

    return (yp, ys,
            jnp.stack(ssm_re_p), jnp.stack(ssm_im_p), jnp.stack(k_p), jnp.stack(v_p), jnp.stack(hg_p),
            jnp.stack(ssm_re_s), jnp.stack(ssm_im_s), jnp.stack(k_s), jnp.stack(v_s), jnp.stack(hg_s))
```

```cpp
#include <hip/hip_runtime.h>
#include <cstdio>
#include <cstdint>

#define LAS __attribute__((address_space(3)))
typedef unsigned short bf16_t;
typedef short bf16x8 __attribute__((ext_vector_type(8)));
typedef float f32x4 __attribute__((ext_vector_type(4)));
typedef float f32x2 __attribute__((ext_vector_type(2)));
typedef unsigned u32x4 __attribute__((ext_vector_type(4)));
typedef unsigned u32x2 __attribute__((ext_vector_type(2)));

constexpr int D = 2048, SEQ = 2048, NB = 4, DB = 32, DSEQ = 64, FF = 8192;
constexpr int MP = NB * SEQ, MS = DB * DSEQ, M = MP + MS;
constexpr int NG = 128, NP = 64, NQ = 16;
constexpr int NH = 16, HD = 128;
constexpr float ALPHA = 1.6817928305074290f;
constexpr float LN_EPS = 1e-5f, RMS_EPS = 1e-6f;
constexpr size_t O_YP = 0, O_YS = O_YP + (size_t)MP * D, O_SRP = O_YS + (size_t)MS * D, O_SIP = O_SRP + 2 * NB * NG * NP,
                 O_KP = O_SIP + 2 * NB * NG * NP, O_VP = O_KP + (size_t)NB * 512 * D, O_HP = O_VP + (size_t)NB * 512 * D,
                 O_SRS = O_HP + (size_t)NB * NH * 128 * 128, O_SIS = O_SRS + 2 * DB * NG * NP, O_KS = O_SIS + 2 * DB * NG * NP,
                 O_VS = O_KS + (size_t)MS * D, O_HS = O_VS + (size_t)MS * D, O_END = O_HS + (size_t)DB * NH * 128 * 128;

constexpr size_t MiB = 1u << 20;
constexpr size_t WS_CTL = 0;
constexpr size_t WS_WSSM = 1 * MiB;
constexpr size_t WS_WQKV = WS_WSSM + 32 * MiB;
constexpr size_t WS_WAO = WS_WQKV + 24 * MiB;
constexpr size_t WS_WHIN = WS_WAO + 8 * MiB;
constexpr size_t WS_WHO = WS_WHIN + 32 * MiB;
constexpr size_t WS_WF1 = WS_WHO + 8 * MiB;
constexpr size_t WS_WF2 = WS_WF1 + 128 * MiB;
constexpr size_t WS_X = WS_WF2 + 128 * MiB;
constexpr size_t WS_XB = WS_X + 80 * MiB;
constexpr size_t WS_Z = WS_XB + 40 * MiB;
constexpr size_t WS_H = WS_Z + 80 * MiB;
constexpr size_t WS_Y = WS_H + 160 * MiB;
constexpr size_t WS_PAR = WS_Y + 40 * MiB;
constexpr size_t WS_SCR = WS_PAR + 4 * MiB;
constexpr size_t WS_END = WS_SCR + 256 * MiB;
constexpr size_t PAR_ABAR = 0;
constexpr size_t PAR_BBAR = PAR_ABAR + 2 * NG * NP * 2 * 4;
constexpr size_t PAR_LB = PAR_BBAR + (size_t)2 * NG * NP * NQ * 2 * 4;
constexpr size_t PAR_END = PAR_LB + D * 4;
static_assert(PAR_END <= 4 * MiB, "params region");

__device__ __forceinline__ unsigned f2bf(float f) { unsigned u = __builtin_bit_cast(unsigned, f); return (u + 0x7fffu + ((u >> 16) & 1u)) >> 16; }
__device__ __forceinline__ unsigned pk2(float lo, float hi) { return f2bf(lo) | (f2bf(hi) << 16); }
__device__ __forceinline__ float bf2f(bf16_t b) { return __builtin_bit_cast(float, (unsigned)b << 16); }
__device__ __forceinline__ float sigmoidf_(float x) { return 1.0f / (1.0f + __expf(-x)); }
__device__ __forceinline__ float gelu_tanh(float x) { const float t = 1.5957691216057308f * (x + 0.044715f * x * x * x); return x / (1.0f + __expf(-t)); }

namespace pg8 {
constexpr int BM = 256, BK = 64, HALF = 128, HTB = HALF * BK * 2, STAGE_BYTES = 8 * HTB, NXCD = 8, WGM = 8;
__host__ __device__ __forceinline__ int lds_byte(int r, int c) { const int st = (r >> 4) * 2 + (c >> 5), rr = r & 15, cc = c & 31, ob = rr * 64 + cc * 2; return st * 1024 + (ob ^ (((ob >> 9) & 1) << 5)); }
__host__ __device__ __forceinline__ void stage_rc(int b, int& R, int& C) { const int st = b / 1024, sb = b % 1024, swz = sb ^ (((sb >> 9) & 1) << 5); R = (st >> 1) * 16 + swz / 64; C = (st & 1) * 32 + (swz % 64) / 2; }
__host__ __device__ __forceinline__ int perm32(int rho) { const int n = rho >> 4, i = rho & 15; return 8 * (i >> 2) + 4 * n + (i & 3); }

struct Unit { int pm, pn, k0, nt, part; };
struct Gemm { const bf16_t* A; const bf16_t* Bt; int lda, ldb; };

struct StaticOrder {
    int nM, nN, nwg, G, c, nt;
    __host__ __device__ void init(int M_, int N_, int K_, int G_, int c_) { nM = M_ / BM; nN = N_ / BM; nwg = nM * nN; G = G_; c = c_; nt = K_ / BK; }
    __host__ __device__ bool next(int i, Unit& u) const {
        const long L = (long)i * G + c; if (L >= nwg) return false;
        int wgid = (int)L; { const int q = nwg / NXCD, r = nwg % NXCD, xcd = wgid % NXCD, off = wgid / NXCD; wgid = (xcd < r ? xcd * (q + 1) : r * (q + 1) + (xcd - r) * q) + off; }
        const int nig = WGM * nN, gid = wgid / nig, fm = gid * WGM, gsz = (nM - fm) < WGM ? (nM - fm) : WGM;
        u.pm = fm + ((wgid % nig) % gsz); u.pn = (wgid % nig) / gsz; u.k0 = 0; u.nt = nt; u.part = 0; return true;
    }
    __device__ __forceinline__ void a_ready(const Unit&) const {}
    __device__ __forceinline__ void done(const Unit&) const {}
};

__device__ __forceinline__ unsigned cvt_pk_bf16(float lo, float hi) { unsigned r; asm volatile("v_cvt_pk_bf16_f32 %0, %1, %2" : "=v"(r) : "v"(lo), "v"(hi)); return r; }

template <class Epi, class Sched, bool ALIGN_EPI = true, bool SP2 = true>
__device__ __forceinline__ void gemm_phase(LAS unsigned char* lds, const Gemm g, const Sched& S, const Epi& E) {
    const int tid = threadIdx.x, wid = __builtin_amdgcn_readfirstlane(tid >> 6), lane = tid & 63, wr = wid >> 2, wc = wid & 3, fr = lane & 15, fq = lane >> 4;
    unsigned voffA[2], voffB[2];
#pragma unroll
    for (int i = 0; i < 2; ++i) { int R, C; stage_rc(tid * 16 + i * 8192, R, C); const int Rb = Epi::PERM ? ((R & ~31) + perm32(R & 31)) : R;
        voffA[i] = (unsigned)(R * g.lda + C) * 2u; voffB[i] = (unsigned)(Rb * g.ldb + C) * 2u; }
    const size_t kstep = (size_t)(BK * 2);
    const size_t hstepA = (size_t)HALF * g.lda * 2, hstepB = (size_t)HALF * g.ldb * 2;
    const unsigned ldsw = (unsigned)wid * 1024u;
    const int aoff = lds_byte(wr * 64 + fr, fq * 8), boff = lds_byte(wc * 32 + fr, fq * 8);
#define PG8_SA(b, h) (((b) * 2 + (h)) * HTB)
#define PG8_SB(b, h) ((4 + (b) * 2 + (h)) * HTB)
#define PG8_STAGE(bufoff, gbase, voff) do { _Pragma("unroll") for (int _i = 0; _i < 2; ++_i) \
        __builtin_amdgcn_global_load_lds((const unsigned*)((const char*)(gbase) + (voff)[_i]), (LAS unsigned*)(lds + (bufoff) + ldsw + _i * 8192), 16, 0, 0); } while (0)
#define PG8_LDA(dst, b, h) do { _Pragma("unroll") for (int m = 0; m < 4; ++m) _Pragma("unroll") for (int k = 0; k < 2; ++k) dst[m][k] = *(const LAS bf16x8*)(lds + PG8_SA(b, h) + aoff + m * 2048 + k * 1024); } while (0)
#define PG8_LDB(dst, b, h) do { _Pragma("unroll") for (int n = 0; n < 2; ++n) _Pragma("unroll") for (int k = 0; k < 2; ++k) dst[n][k] = *(const LAS bf16x8*)(lds + PG8_SB(b, h) + boff + n * 2048 + k * 1024); } while (0)
#define PG8_MMA(ai, bj, At, Bt) do { __builtin_amdgcn_s_setprio(1); _Pragma("unroll") for (int m = 0; m < 4; ++m) _Pragma("unroll") for (int n = 0; n < 2; ++n) _Pragma("unroll") for (int k = 0; k < 2; ++k) \
        acc[ai][bj][m][n] = __builtin_amdgcn_mfma_f32_16x16x32_bf16(Bt[n][k], At[m][k], acc[ai][bj][m][n], 0, 0, 0); __builtin_amdgcn_s_setprio(0); } while (0)
#define PG8_WAIT_V(n) asm volatile("s_waitcnt vmcnt(" #n ")" ::: "memory")
#define PG8_WAIT_L(n) asm volatile("s_waitcnt lgkmcnt(" #n ")" ::: "memory")
#define PG8_BAR __builtin_amdgcn_s_barrier()
#define PG8_SCHED __builtin_amdgcn_sched_barrier(0)
    Unit cur, nxt; int ui = 0;
    if (!S.next(0, cur)) return;
    f32x4 acc[2][2][4][2];
#pragma unroll
    for (int a = 0; a < 2; ++a)
#pragma unroll
        for (int b = 0; b < 2; ++b)
#pragma unroll
            for (int m = 0; m < 4; ++m)
#pragma unroll
                for (int n = 0; n < 2; ++n) acc[a][b][m][n] = (f32x4){0.f, 0.f, 0.f, 0.f};
    bf16x8 At[4][2], B0[2][2], B1[2][2];
    const char* cA = (const char*)g.A + (size_t)cur.pm * 2 * hstepA + (size_t)cur.k0 * 2; const char* cB = (const char*)g.Bt + (size_t)cur.pn * 2 * hstepB + (size_t)cur.k0 * 2;
    S.a_ready(cur);
    if constexpr (SP2) {
        PG8_STAGE(PG8_SB(0, 0), cB, voffB); PG8_STAGE(PG8_SB(0, 1), cB + hstepB, voffB); PG8_STAGE(PG8_SA(0, 0), cA, voffA); PG8_STAGE(PG8_SA(0, 1), cA + hstepA, voffA);
        if (wr == 1) PG8_BAR;
        PG8_WAIT_V(2); PG8_BAR;
        PG8_STAGE(PG8_SB(1, 0), cB + kstep, voffB); PG8_STAGE(PG8_SA(1, 0), cA + kstep, voffA); PG8_STAGE(PG8_SB(1, 1), cB + hstepB + kstep, voffB);
        PG8_WAIT_V(6); PG8_BAR;
    } else {
        PG8_STAGE(PG8_SB(0, 0), cB, voffB); PG8_STAGE(PG8_SA(0, 0), cA, voffA); PG8_STAGE(PG8_SB(0, 1), cB + hstepB, voffB); PG8_STAGE(PG8_SA(0, 1), cA + hstepA, voffA);
        if (wr == 1) PG8_BAR;
        PG8_WAIT_V(4); PG8_BAR;
        PG8_STAGE(PG8_SB(1, 0), cB + kstep, voffB); PG8_STAGE(PG8_SA(1, 0), cA + kstep, voffA); PG8_STAGE(PG8_SB(1, 1), cB + hstepB + kstep, voffB);
        PG8_WAIT_V(6); PG8_BAR;
    }
    for (;;) {
        const bool has_next = S.next(ui + 1, nxt);
        const int nt = cur.nt;
        const char* nA = has_next ? (const char*)g.A + (size_t)nxt.pm * 2 * hstepA + (size_t)nxt.k0 * 2 : cA; const char* nB = has_next ? (const char*)g.Bt + (size_t)nxt.pn * 2 * hstepB + (size_t)nxt.k0 * 2 : cB;
        for (int t = 0; t < nt; t += 2) {
            const bool last = (t == nt - 2);
            const char* a1 = cA + (size_t)(t + 1) * kstep;
            const char* a2 = last ? nA : cA + (size_t)(t + 2) * kstep; const char* b2 = last ? nB : cB + (size_t)(t + 2) * kstep;
            const char* a3 = a2 + kstep; const char* b3 = b2 + kstep;
            if (last && has_next) S.a_ready(nxt);
            if constexpr (SP2) {
            PG8_LDB(B0, 0, 0); PG8_LDB(B1, 0, 1); PG8_SCHED; PG8_LDA(At, 0, 0); PG8_STAGE(PG8_SA(1, 1), a1 + hstepA, voffA);
            PG8_WAIT_V(8); PG8_WAIT_L(0); PG8_BAR; PG8_MMA(0, 0, At, B0); PG8_MMA(0, 1, At, B1); PG8_BAR; PG8_SCHED;
            PG8_LDA(At, 0, 1); PG8_STAGE(PG8_SB(0, 0), b2, voffB); PG8_STAGE(PG8_SB(0, 1), b2 + hstepB, voffB); PG8_STAGE(PG8_SA(0, 0), a2, voffA);
            PG8_WAIT_V(8); PG8_WAIT_L(0); PG8_BAR; PG8_MMA(1, 0, At, B0); PG8_MMA(1, 1, At, B1); PG8_BAR; PG8_SCHED;
            PG8_LDB(B0, 1, 0); PG8_LDB(B1, 1, 1); PG8_SCHED; PG8_LDA(At, 1, 0); PG8_STAGE(PG8_SA(0, 1), a2 + hstepA, voffA);
            PG8_WAIT_V(8); PG8_WAIT_L(0); PG8_BAR; PG8_MMA(0, 0, At, B0); PG8_MMA(0, 1, At, B1); PG8_BAR; PG8_SCHED;
            PG8_LDA(At, 1, 1); PG8_STAGE(PG8_SB(1, 0), b3, voffB); PG8_STAGE(PG8_SB(1, 1), b3 + hstepB, voffB); PG8_STAGE(PG8_SA(1, 0), a3, voffA);
            PG8_WAIT_V(8); PG8_WAIT_L(0); PG8_BAR; PG8_MMA(1, 0, At, B0); PG8_MMA(1, 1, At, B1); PG8_BAR; PG8_SCHED;
            } else {
            PG8_LDB(B0, 0, 0); PG8_SCHED; PG8_LDA(At, 0, 0); PG8_STAGE(PG8_SA(1, 1), a1 + hstepA, voffA);
            PG8_WAIT_L(8); PG8_BAR; PG8_WAIT_L(0); PG8_MMA(0, 0, At, B0); PG8_BAR; PG8_SCHED;
            PG8_LDB(B1, 0, 1); PG8_STAGE(PG8_SB(0, 0), b2, voffB);
            PG8_BAR; PG8_WAIT_L(0); PG8_MMA(0, 1, At, B1); PG8_BAR;
            PG8_LDA(At, 0, 1); PG8_STAGE(PG8_SA(0, 0), a2, voffA);
            PG8_BAR; PG8_WAIT_L(0); PG8_MMA(1, 0, At, B0); PG8_BAR; PG8_SCHED;
            PG8_STAGE(PG8_SB(0, 1), b2 + hstepB, voffB);
            PG8_WAIT_V(6); PG8_BAR; PG8_MMA(1, 1, At, B1); PG8_BAR;
            PG8_LDB(B0, 1, 0); PG8_SCHED; PG8_LDA(At, 1, 0); PG8_STAGE(PG8_SA(0, 1), a2 + hstepA, voffA);
            PG8_WAIT_L(8); PG8_BAR; PG8_WAIT_L(0); PG8_MMA(0, 0, At, B0); PG8_BAR; PG8_SCHED;
            PG8_LDB(B1, 1, 1); PG8_STAGE(PG8_SB(1, 0), b3, voffB);
            PG8_BAR; PG8_WAIT_L(0); PG8_MMA(0, 1, At, B1); PG8_BAR;
            PG8_LDA(At, 1, 1); PG8_STAGE(PG8_SA(1, 0), a3, voffA);
            PG8_BAR; PG8_WAIT_L(0); PG8_MMA(1, 0, At, B0); PG8_BAR; PG8_SCHED;
            PG8_STAGE(PG8_SB(1, 1), b3 + hstepB, voffB);
            PG8_WAIT_V(6); PG8_BAR; PG8_MMA(1, 1, At, B1); PG8_BAR;
            }
        }
        if constexpr (ALIGN_EPI) { if (wr == 0) PG8_BAR; }
        E(acc, cur, wr, wc, fr, fq); S.done(cur);
        if (!has_next) break;
#pragma unroll
        for (int a = 0; a < 2; ++a)
#pragma unroll
            for (int b = 0; b < 2; ++b)
#pragma unroll
                for (int m = 0; m < 4; ++m)
#pragma unroll
                    for (int n = 0; n < 2; ++n) acc[a][b][m][n] = (f32x4){0.f, 0.f, 0.f, 0.f};
        cur = nxt; cA = nA; cB = nB; ++ui;
        if constexpr (ALIGN_EPI) { if (wr == 1) PG8_BAR; }
    }
    PG8_WAIT_V(0);
    if constexpr (!ALIGN_EPI) { if (wr == 0) PG8_BAR; }
    PG8_BAR;
#undef PG8_SA
#undef PG8_SB
#undef PG8_STAGE
#undef PG8_LDA
#undef PG8_LDB
#undef PG8_MMA
#undef PG8_WAIT_V
#undef PG8_WAIT_L
#undef PG8_BAR
#undef PG8_SCHED
}
}

using pg8::Unit;
struct ResSrc { const float* xp; const float* xs; __device__ __forceinline__ const float* row(int r) const { return r < MP ? xp + (size_t)r * D : xs + (size_t)(r - MP) * D; } };

struct EpiSsmGate {
    static constexpr bool PERM = false;
    ResSrc xr; float* Z;
    __device__ __forceinline__ void operator()(const f32x4 (&acc)[2][2][4][2], const Unit& u, int wr, int wc, int fr, int fq) const {
        const int row0 = u.pm * 256 + wr * 64 + fr, ch0 = u.pn * 128 + wc * 32 + 4 * fq;
#pragma unroll
        for (int ai = 0; ai < 2; ++ai)
#pragma unroll
            for (int m = 0; m < 4; ++m) { const int row = row0 + ai * 128 + m * 16; const float* xrow = xr.row(row) + ch0; float* zrow = Z + (size_t)row * D + ch0;
#pragma unroll
                for (int n = 0; n < 2; ++n) { const f32x4 o = acc[ai][0][m][n], gt = acc[ai][1][m][n]; const f32x4 x = *(const f32x4*)(xrow + n * 16); f32x4 z;
#pragma unroll
                    for (int j = 0; j < 4; ++j) z[j] = ALPHA * x[j] + o[j] * sigmoidf_(gt[j]);
                    *(f32x4*)(zrow + n * 16) = z; } }
    }
};
struct EpiRes {
    static constexpr bool PERM = false;
    ResSrc xr; float* Z;
    __device__ __forceinline__ void operator()(const f32x4 (&acc)[2][2][4][2], const Unit& u, int wr, int wc, int fr, int fq) const {
        const int row0 = u.pm * 256 + wr * 64 + fr, col0 = u.pn * 256 + wc * 32 + 4 * fq;
#pragma unroll
        for (int ai = 0; ai < 2; ++ai)
#pragma unroll
            for (int m = 0; m < 4; ++m) { const int row = row0 + ai * 128 + m * 16; const float* xrow = xr.row(row) + col0; float* zrow = Z + (size_t)row * D + col0;
#pragma unroll
                for (int bj = 0; bj < 2; ++bj)
#pragma unroll
                    for (int n = 0; n < 2; ++n) { const f32x4 x = *(const f32x4*)(xrow + bj * 128 + n * 16); *(f32x4*)(zrow + bj * 128 + n * 16) = ALPHA * x + acc[ai][bj][m][n]; } }
    }
};
struct EpiFfn1 {
    static constexpr bool PERM = true;
    bf16_t* H;
    __device__ __forceinline__ void operator()(const f32x4 (&acc)[2][2][4][2], const Unit& u, int wr, int wc, int fr, int fq) const {
        const int row0 = u.pm * 256 + wr * 64 + fr, col0 = u.pn * 256 + wc * 32 + 8 * fq;
#pragma unroll
        for (int ai = 0; ai < 2; ++ai)
#pragma unroll
            for (int m = 0; m < 4; ++m) { bf16_t* rowp = H + (size_t)(row0 + ai * 128 + m * 16) * FF + col0;
#pragma unroll
                for (int bj = 0; bj < 2; ++bj) { f32x4 v0 = acc[ai][bj][m][0], v1 = acc[ai][bj][m][1];
#pragma unroll
                    for (int j = 0; j < 4; ++j) { const float a = fmaxf(v0[j], 0.f), b = fmaxf(v1[j], 0.f); v0[j] = a * a; v1[j] = b * b; }
                    u32x4 w; w.x = pg8::cvt_pk_bf16(v0[0], v0[1]); w.y = pg8::cvt_pk_bf16(v0[2], v0[3]); w.z = pg8::cvt_pk_bf16(v1[0], v1[1]); w.w = pg8::cvt_pk_bf16(v1[2], v1[3]);
                    *(u32x4*)(rowp + bj * 128) = w; } }
    }
};
struct EpiQkv {
    static constexpr bool PERM = true;
    bf16_t* QKV; float* out;
    __device__ __forceinline__ void operator()(const f32x4 (&acc)[2][2][4][2], const Unit& u, int wr, int wc, int fr, int fq) const {
        const int t = u.pn >> 3; const int colt = (u.pn & 7) * 256;
        const int col0 = colt + wc * 32 + 8 * fq;
        bf16_t* base = QKV + (size_t)t * M * D;
        float* fdst = nullptr;
        if (t >= 1) {
            if (u.pm < 32) { if ((u.pm & 7) >= 6) { const int n = u.pm >> 3; fdst = out + (t == 1 ? O_KP : O_VP) + ((size_t)n * 512 + (size_t)((u.pm & 7) - 6) * 256) * D; } }
            else fdst = out + (t == 1 ? O_KS : O_VS) + (size_t)(u.pm - 32) * 256 * D;
        }
#pragma unroll
        for (int ai = 0; ai < 2; ++ai)
#pragma unroll
            for (int m = 0; m < 4; ++m) { const int rl = wr * 64 + fr + ai * 128 + m * 16; bf16_t* rowp = base + (size_t)(u.pm * 256 + rl) * D + col0;
#pragma unroll
                for (int bj = 0; bj < 2; ++bj) { const f32x4 v0 = acc[ai][bj][m][0], v1 = acc[ai][bj][m][1];
                    u32x4 w; w.x = pg8::cvt_pk_bf16(v0[0], v0[1]); w.y = pg8::cvt_pk_bf16(v0[2], v0[3]); w.z = pg8::cvt_pk_bf16(v1[0], v1[1]); w.w = pg8::cvt_pk_bf16(v1[2], v1[3]);
                    *(u32x4*)(rowp + bj * 128) = w;
                    if (fdst) { float* fp = fdst + (size_t)rl * D + col0 + bj * 128; *(f32x4*)fp = v0; *(f32x4*)(fp + 4) = v1; } } }
    }
};
struct EpiHgrnIn {
    static constexpr bool PERM = true;
    bf16_t* QIG; float* F; const float* lb;
    __device__ __forceinline__ void operator()(const f32x4 (&acc)[2][2][4][2], const Unit& u, int wr, int wc, int fr, int fq) const {
        const int t = u.pn >> 3; const int colt = (u.pn & 7) * 256;
        const int row0 = u.pm * 256 + wr * 64 + fr, col0 = colt + wc * 32 + 8 * fq;
        if (t == 1) {
#pragma unroll
            for (int bj = 0; bj < 2; ++bj) { const f32x4 l0 = *(const f32x4*)(lb + col0 + bj * 128), l1 = *(const f32x4*)(lb + col0 + bj * 128 + 4);
#pragma unroll
                for (int ai = 0; ai < 2; ++ai)
#pragma unroll
                    for (int m = 0; m < 4; ++m) { float* fp = F + (size_t)(row0 + ai * 128 + m * 16) * D + col0 + bj * 128; f32x4 v0 = acc[ai][bj][m][0], v1 = acc[ai][bj][m][1];
#pragma unroll
                        for (int j = 0; j < 4; ++j) { v0[j] = l0[j] + (1.0f - l0[j]) * sigmoidf_(v0[j]); v1[j] = l1[j] + (1.0f - l1[j]) * sigmoidf_(v1[j]); }
                        *(f32x4*)fp = v0; *(f32x4*)(fp + 4) = v1; } }
        } else {
            bf16_t* base = QIG + (size_t)(t == 0 ? 0 : t - 1) * M * D;
#pragma unroll
            for (int ai = 0; ai < 2; ++ai)
#pragma unroll
                for (int m = 0; m < 4; ++m) { bf16_t* rowp = base + (size_t)(row0 + ai * 128 + m * 16) * D + col0;
#pragma unroll
                    for (int bj = 0; bj < 2; ++bj) { const f32x4 v0 = acc[ai][bj][m][0], v1 = acc[ai][bj][m][1];
                        u32x4 w; w.x = pg8::cvt_pk_bf16(v0[0], v0[1]); w.y = pg8::cvt_pk_bf16(v0[2], v0[3]); w.z = pg8::cvt_pk_bf16(v1[0], v1[1]); w.w = pg8::cvt_pk_bf16(v1[2], v1[3]);
                        *(u32x4*)(rowp + bj * 128) = w; } }
        }
    }
};

struct Args { const float* in[30]; float* out; unsigned char* ws; int layer, a1, a2, pad; };

template <int WHICH> __global__ void __launch_bounds__(512, 2) k_gemm(Args a) {
    extern __shared__ __attribute__((aligned(16))) unsigned char lds_raw[];
    LAS unsigned char* lds = (LAS unsigned char*)lds_raw;
    unsigned char* ws = a.ws; const int L = a.layer;
    float* X = (float*)(ws + WS_X); bf16_t* XB = (bf16_t*)(ws + WS_XB); float* Z = (float*)(ws + WS_Z); bf16_t* H = (bf16_t*)(ws + WS_H); bf16_t* Y = (bf16_t*)(ws + WS_Y);
    ResSrc xr; if (L == 0) { xr.xp = a.in[0]; xr.xs = a.in[1]; } else { xr.xp = X; xr.xs = X + (size_t)MP * D; }
    const int G = gridDim.x, c = blockIdx.x;
    if constexpr (WHICH == 0) {
        pg8::Gemm g{Y, (const bf16_t*)(ws + WS_WSSM) + (size_t)a.a1 * 4096 * D, D, D}; pg8::StaticOrder S; S.init(M, 4096, D, G, c);
        EpiSsmGate E{xr, Z}; pg8::gemm_phase<EpiSsmGate, pg8::StaticOrder>(lds, g, S, E);
    } else if constexpr (WHICH == 1) {
        pg8::Gemm g{XB, (const bf16_t*)(ws + WS_WQKV), D, D}; pg8::StaticOrder S; S.init(M, 6144, D, G, c);
        EpiQkv E{H, a.out}; pg8::gemm_phase<EpiQkv, pg8::StaticOrder>(lds, g, S, E);
    } else if constexpr (WHICH == 2 || WHICH == 4) {
        pg8::Gemm g{Y, (const bf16_t*)(ws + (WHICH == 2 ? WS_WAO : WS_WHO)), D, D}; pg8::StaticOrder S; S.init(M, D, D, G, c);
        EpiRes E{xr, Z}; pg8::gemm_phase<EpiRes, pg8::StaticOrder>(lds, g, S, E);
    } else if constexpr (WHICH == 3) {
        pg8::Gemm g{XB, (const bf16_t*)(ws + WS_WHIN), D, D}; pg8::StaticOrder S; S.init(M, 8192, D, G, c);
        EpiHgrnIn E{H, Z, (const float*)(ws + WS_PAR + PAR_LB)}; pg8::gemm_phase<EpiHgrnIn, pg8::StaticOrder>(lds, g, S, E);
    } else if constexpr (WHICH == 5) {
        pg8::Gemm g{XB, (const bf16_t*)(ws + WS_WF1) + (size_t)L * FF * D, D, D}; pg8::StaticOrder S; S.init(M, FF, D, G, c);
        EpiFfn1 E{H}; pg8::gemm_phase<EpiFfn1, pg8::StaticOrder>(lds, g, S, E);
    } else {
        pg8::Gemm g{H, (const bf16_t*)(ws + WS_WF2) + (size_t)L * FF * D, FF, FF}; pg8::StaticOrder S; S.init(M, D, FF, G, c);
        ResSrc xr2{X, X + (size_t)MP * D};
        EpiRes E{xr2, Z}; pg8::gemm_phase<EpiRes, pg8::StaticOrder>(lds, g, S, E);
    }
}

__global__ void k_convert_w(const float* __restrict__ W, bf16_t* __restrict__ WT, int K, int N, int mode) {
    __shared__ float tile[32][33];
    const int nb = N / 32; const int kb = blockIdx.x / nb, nbi = blockIdx.x % nb; const int k0 = kb * 32, n0 = nbi * 32;
    const int tx = threadIdx.x & 31, ty = threadIdx.x >> 5;
#pragma unroll
    for (int i = 0; i < 4; ++i) tile[ty + 8 * i][tx] = W[(size_t)(k0 + ty + 8 * i) * N + n0 + tx];
    __syncthreads();
#pragma unroll
    for (int i = 0; i < 4; ++i) { const int n = n0 + ty + 8 * i; const int row = mode == 0 ? n : 256 * (n >> 7) + 128 * (mode - 1) + (n & 127);
        WT[(size_t)row * K + k0 + tx] = (bf16_t)f2bf(tile[tx][ty + 8 * i]); }
}
__global__ void k_params(Args a) {
    unsigned char* par = a.ws + WS_PAR;
    const int idx = blockIdx.x * blockDim.x + threadIdx.x;
    if (idx < 2 * NG * NP) {
        const int j = idx / (NG * NP), g = (idx / NP) % NG;
        const double are = a.in[7][idx], aim = a.in[8][idx], dt = exp((double)a.in[9][j * NG + g]);
        const double e = exp(are * dt), cr = e * cos(aim * dt), ci = e * sin(aim * dt);
        float* ab = (float*)(par + PAR_ABAR) + (size_t)idx * 2; ab[0] = (float)cr; ab[1] = (float)ci;
        const double xr = cr - 1.0, xi = ci, den = are * are + aim * aim; const double fr = (xr * are + xi * aim) / den, fi = (xi * are - xr * aim) / den;
        float* bb = (float*)(par + PAR_BBAR) + (size_t)idx * NQ * 2;
        for (int q = 0; q < NQ; ++q) { const double br = a.in[10][(size_t)idx * NQ + q], bi = a.in[11][(size_t)idx * NQ + q]; bb[2 * q] = (float)(fr * br - fi * bi); bb[2 * q + 1] = (float)(fr * bi + fi * br); }
    }
    if (idx < D) {
        const float* lg = a.in[21]; float v0 = lg[idx], v1 = lg[D + idx], v2 = lg[2 * D + idx], v3 = lg[3 * D + idx];
        const float mx = fmaxf(fmaxf(v0, v1), fmaxf(v2, v3));
        v0 = expf(v0 - mx); v1 = expf(v1 - mx); v2 = expf(v2 - mx); v3 = expf(v3 - mx);
        ((float*)(par + PAR_LB))[idx] = (v1 + v2) / (v0 + v1 + v2 + v3);
    }
}

__device__ __forceinline__ float wave_sum(float v) {
#pragma unroll
    for (int o = 1; o < 64; o <<= 1) v += __shfl_xor(v, o);
    return v;
}
__global__ void __launch_bounds__(256) k_ln(Args a) {
    unsigned char* ws = a.ws; const int L = a.layer;
    const float* Z = (const float*)(ws + WS_Z); float* Xo = a.a2 ? a.out : (float*)(ws + WS_X); bf16_t* XB = (bf16_t*)(ws + WS_XB);
    const float* gam = a.in[a.a1 ? 26 : 24] + (size_t)L * D; const float* bet = a.in[a.a1 ? 27 : 25] + (size_t)L * D;
    const int lane = threadIdx.x & 63, gw = blockIdx.x * 4 + (threadIdx.x >> 6), ngw = gridDim.x * 4;
    for (int r = gw; r < M; r += ngw) {
        const f32x4* zr = (const f32x4*)(Z + (size_t)r * D) + lane; f32x4 v[8]; float s = 0.f;
#pragma unroll
        for (int j = 0; j < 8; ++j) { v[j] = zr[64 * j]; s += (v[j].x + v[j].y) + (v[j].z + v[j].w); }
        const float mean = wave_sum(s) * (1.f / D); float s2 = 0.f;
#pragma unroll
        for (int j = 0; j < 8; ++j) { v[j] = v[j] - mean; s2 += (v[j].x * v[j].x + v[j].y * v[j].y) + (v[j].z * v[j].z + v[j].w * v[j].w); }
        const float rstd = 1.f / sqrtf(wave_sum(s2) * (1.f / D) + LN_EPS);
        f32x4* xo = (f32x4*)(Xo + (size_t)r * D) + lane; u32x2* xb = (u32x2*)(XB + (size_t)r * D) + lane;
#pragma unroll
        for (int j = 0; j < 8; ++j) { const f32x4 gg = ((const f32x4*)gam)[lane + 64 * j], bb = ((const f32x4*)bet)[lane + 64 * j]; const f32x4 y = v[j] * rstd * gg + bb;
            xo[64 * j] = y; u32x2 w; w.x = pk2(y.x, y.y); w.y = pk2(y.z, y.w); xb[64 * j] = w; }
    }
}

__global__ void __launch_bounds__(64) k_ssm_naive(Args a) {
    __shared__ float hre[64], him[64];
    unsigned char* ws = a.ws; const int j = a.a1, L = a.layer; const int p = threadIdx.x;
    const float* X = (const float*)(ws + WS_X);
    const int item = blockIdx.x; int n, g, T; const float* xbase; size_t rowbase; bool samp;
    if (item < NB * NG) { samp = false; n = item / NG; g = item % NG; T = SEQ; rowbase = (size_t)n * SEQ; xbase = (L == 0 ? a.in[0] : X) + rowbase * D; }
    else { samp = true; const int it = item - NB * NG; n = it / NG; g = it % NG; T = DSEQ; rowbase = (size_t)MP + (size_t)n * DSEQ; xbase = (L == 0 ? a.in[1] + (size_t)n * DSEQ * D : X + rowbase * D); }
    const float* ab = (const float*)(ws + WS_PAR + PAR_ABAR) + ((size_t)(j * NG + g) * NP + p) * 2; const float ar = ab[0], ai = ab[1];
    const float* bb = (const float*)(ws + WS_PAR + PAR_BBAR) + ((size_t)(j * NG + g) * NP + p) * NQ * 2;
    float br[NQ], bi[NQ];
#pragma unroll
    for (int q = 0; q < NQ; ++q) { br[q] = bb[2 * q]; bi[q] = bb[2 * q + 1]; }
    const int q_ = p & 15, part = p >> 4; float cr[16], ci[16];
    const float* cre = a.in[12] + ((size_t)(j * NG + g) * NQ + q_) * NP + part * 16; const float* cim = a.in[13] + ((size_t)(j * NG + g) * NQ + q_) * NP + part * 16;
#pragma unroll
    for (int i = 0; i < 16; ++i) { cr[i] = cre[i]; ci[i] = cim[i]; }
    const float dsk = a.in[14][(size_t)j * D + g * NQ + q_];
    float hr = 0.f, hi = 0.f;
    if (samp) { hr = a.in[2][((size_t)(j * DB + n) * NG + g) * NP + p]; hi = a.in[3][((size_t)(j * DB + n) * NG + g) * NP + p]; }
    bf16_t* Y = (bf16_t*)(ws + WS_Y);
    for (int t = 0; t < T; ++t) {
        const float* ur = xbase + (size_t)t * D + g * NQ; float sr = 0.f, si = 0.f;
#pragma unroll
        for (int q = 0; q < NQ; ++q) { const float u = ur[q]; sr += br[q] * u; si += bi[q] * u; }
        const float nr = ar * hr - ai * hi + sr, ni = ar * hi + ai * hr + si; hr = nr; hi = ni;
        __syncthreads(); hre[p] = hr; him[p] = hi; __syncthreads();
        float y = 0.f;
#pragma unroll
        for (int i = 0; i < 16; ++i) y += cr[i] * hre[part * 16 + i] - ci[i] * him[part * 16 + i];
        y += __shfl_xor(y, 16); y += __shfl_xor(y, 32);
        if (part == 0) { y += dsk * ur[q_]; Y[(rowbase + t) * D + g * NQ + q_] = (bf16_t)f2bf(gelu_tanh(y)); }
    }
    float* ore = a.out + (samp ? O_SRS : O_SRP) + ((size_t)(j * (samp ? DB : NB) + n) * NG + g) * NP + p;
    float* oim = a.out + (samp ? O_SIS : O_SIP) + ((size_t)(j * (samp ? DB : NB) + n) * NG + g) * NP + p;
    *ore = hr; *oim = hi;
}

__global__ void __launch_bounds__(64) k_attn_naive(Args a) {
    unsigned char* ws = a.ws; const bf16_t* Qb = (const bf16_t*)(ws + WS_H); const bf16_t* Kb = Qb + (size_t)M * D; const bf16_t* Vb = Kb + (size_t)M * D; bf16_t* Y = (bf16_t*)(ws + WS_Y);
    const int unit = blockIdx.x; const int i = threadIdx.x; int n, c, h; bool samp; size_t qrow;
    if (unit < NB * 32 * NH) { samp = false; n = unit / (32 * NH); c = (unit / NH) % 32; h = unit % NH; qrow = (size_t)n * SEQ + c * 64 + i; }
    else { samp = true; const int u2 = unit - NB * 32 * NH; n = u2 / NH; h = u2 % NH; c = 8; qrow = (size_t)MP + n * DSEQ + i; }
    float q[HD], o[HD];
#pragma unroll
    for (int d = 0; d < HD; ++d) { q[d] = bf2f(Qb[qrow * D + h * HD + d]) * 0.08838834764831845f; o[d] = 0.f; }
    const float* tab = a.in[18] + (size_t)h * 257;
    float mx = -1e30f, l = 0.f;
    const int t0 = samp ? 0 : (c >= 8 ? 0 : 8 - c);
    for (int tau = t0; tau <= 8; ++tau) {
        for (int kk = 0; kk < 64; ++kk) {
            float s = 0.f;
            int rel = i - ((tau - 8) * 64 + kk); rel = rel > 128 ? 128 : (rel < -128 ? -128 : rel);
            const float bias = tab[rel + 128];
            if (samp && tau < 8) {
                const float* kr = a.in[4] + (((size_t)n * 512 + tau * 64 + kk) * NH + h) * HD; const float* vr = a.in[5] + (((size_t)n * 512 + tau * 64 + kk) * NH + h) * HD;
#pragma unroll
                for (int d = 0; d < HD; ++d) s += q[d] * kr[d];
                s += bias; const float mn = fmaxf(mx, s), sc = __expf(mx - mn), pw = __expf(s - mn); l = l * sc + pw; mx = mn;
#pragma unroll
                for (int d = 0; d < HD; ++d) o[d] = o[d] * sc + pw * vr[d];
            } else {
                const size_t krow = samp ? (size_t)MP + n * DSEQ + kk : (size_t)n * SEQ + (size_t)(c - 8 + tau) * 64 + kk;
                const bf16_t* kr = Kb + krow * D + h * HD; const bf16_t* vr = Vb + krow * D + h * HD;
#pragma unroll
                for (int d = 0; d < HD; ++d) s += q[d] * bf2f(kr[d]);
                s += bias; const float mn = fmaxf(mx, s), sc = __expf(mx - mn), pw = __expf(s - mn); l = l * sc + pw; mx = mn;
#pragma unroll
                for (int d = 0; d < HD; ++d) o[d] = o[d] * sc + pw * bf2f(vr[d]);
            }
        }
    }
    const float inv = 1.f / l;
#pragma unroll
    for (int d = 0; d < HD; ++d) Y[qrow * D + h * HD + d] = (bf16_t)f2bf(o[d] * inv);
}

__global__ void __launch_bounds__(128) k_hgrn_naive(Args a) {
    __shared__ float fs[128], qs[128], red[2];
    unsigned char* ws = a.ws; const bf16_t* Qb = (const bf16_t*)(ws + WS_H); const bf16_t* Ib = Qb + (size_t)M * D; const bf16_t* Gb = Ib + (size_t)M * D; const float* F = (const float*)(ws + WS_Z);
    bf16_t* Y = (bf16_t*)(ws + WS_Y);
    const int unit = blockIdx.x, v = threadIdx.x; int n, h, T; bool samp; size_t rowbase;
    if (unit < NB * NH) { samp = false; n = unit / NH; h = unit % NH; T = SEQ; rowbase = (size_t)n * SEQ; }
    else { samp = true; const int u2 = unit - NB * NH; n = u2 / NH; h = u2 % NH; T = DSEQ; rowbase = (size_t)MP + n * DSEQ; }
    float S[128];
#pragma unroll
    for (int k = 0; k < 128; ++k) S[k] = samp ? a.in[6][(((size_t)n * NH + h) * 128 + k) * 128 + v] : 0.f;
    const float ng = a.in[22][v];
    for (int t = 0; t < T; ++t) {
        const size_t ro = (rowbase + t) * D + h * 128;
        __syncthreads(); fs[v] = F[ro + v]; qs[v] = bf2f(Qb[ro + v]); __syncthreads();
        const float iv = bf2f(Ib[ro + v]); float o = 0.f;
#pragma unroll
        for (int k = 0; k < 128; ++k) { const float f = fs[k]; S[k] = f * S[k] + (1.0f - f) * iv; o += qs[k] * S[k]; }
        const float ss = wave_sum(o * o); if ((v & 63) == 0) red[v >> 6] = ss; __syncthreads();
        const float ms = (red[0] + red[1]) * (1.f / 128.f);
        const float gv = bf2f(Gb[ro + v]);
        Y[ro + v] = (bf16_t)f2bf(o * (1.0f / sqrtf(ms + RMS_EPS)) * ng * gv * sigmoidf_(gv));
    }
    float* so = a.out + (samp ? O_HS : O_HP) + (((size_t)n * NH + h) * 128) * 128 + v;
#pragma unroll
    for (int k = 0; k < 128; ++k) so[(size_t)k * 128] = S[k];
}

template <int W> static void launch_gemm(const Args& a, hipStream_t st) {
    static bool attr = false; if (!attr) { (void)hipFuncSetAttribute((const void*)k_gemm<W>, hipFuncAttributeMaxDynamicSharedMemorySize, pg8::STAGE_BYTES); attr = true; }
    hipLaunchKernelGGL((k_gemm<W>), dim3(256), dim3(512), pg8::STAGE_BYTES, st, a);
}
extern "C" void kernel_launch(void* const* d_in, const int* in_sizes, int n_in, void* d_out, int out_size, void* d_ws, size_t ws_size, hipStream_t stream) {
    if (n_in != 30 || (size_t)out_size != O_END || ws_size < WS_END) { fprintf(stderr, "kernel_launch: unexpected shapes (n_in %d out %d ws %zu, need %zu)\n", n_in, out_size, ws_size, (size_t)WS_END); return; }
    Args a{}; for (int i = 0; i < 30; ++i) a.in[i] = (const float*)d_in[i]; a.out = (float*)d_out; a.ws = (unsigned char*)d_ws;
    unsigned char* ws = (unsigned char*)d_ws;
    auto conv = [&](const float* W, bf16_t* WT, int K, int N, int mode) { hipLaunchKernelGGL(k_convert_w, dim3((K / 32) * (N / 32)), dim3(256), 0, stream, W, WT, K, N, mode); };
    for (int j = 0; j < 2; ++j) { bf16_t* wt = (bf16_t*)(ws + WS_WSSM) + (size_t)j * 4096 * D; conv(a.in[15] + (size_t)j * D * D, wt, D, D, 1); conv(a.in[16] + (size_t)j * D * D, wt, D, D, 2); }
    conv(a.in[17], (bf16_t*)(ws + WS_WQKV), D, 3 * D, 0); conv(a.in[19], (bf16_t*)(ws + WS_WAO), D, D, 0);
    conv(a.in[20], (bf16_t*)(ws + WS_WHIN), D, 4 * D, 0); conv(a.in[23], (bf16_t*)(ws + WS_WHO), D, D, 0);
    for (int l = 0; l < 4; ++l) { conv(a.in[28] + (size_t)l * D * FF, (bf16_t*)(ws + WS_WF1) + (size_t)l * FF * D, D, FF, 0); conv(a.in[29] + (size_t)l * FF * D, (bf16_t*)(ws + WS_WF2) + (size_t)l * D * FF, FF, D, 0); }
    hipLaunchKernelGGL(k_params, dim3(64), dim3(256), 0, stream, a);
    for (int L = 0; L < 4; ++L) {
        a.layer = L; const int kind = L % 3, j = L / 3;
        if (kind == 0) { a.a1 = j; hipLaunchKernelGGL(k_ssm_naive, dim3(NB * NG + DB * NG), dim3(64), 0, stream, a); launch_gemm<0>(a, stream); }
        else if (kind == 1) { launch_gemm<1>(a, stream); hipLaunchKernelGGL(k_attn_naive, dim3(NB * 32 * NH + DB * NH), dim3(64), 0, stream, a); launch_gemm<2>(a, stream); }
        else { launch_gemm<3>(a, stream); hipLaunchKernelGGL(k_hgrn_naive, dim3(NB * NH + DB * NH), dim3(128), 0, stream, a); launch_gemm<4>(a, stream); }
        a.a1 = 0; a.a2 = 0; hipLaunchKernelGGL(k_ln, dim3(1024), dim3(256), 0, stream, a);
        launch_gemm<5>(a, stream); launch_gemm<6>(a, stream);
        a.a1 = 1; a.a2 = (L == 3) ? 1 : 0; hipLaunchKernelGGL(k_ln, dim3(1024), dim3(256), 0, stream, a);
    }
}
```

```cpp
#include <hip/hip_runtime.h>
#include <cstdio>
#include <cstdint>

#define LAS __attribute__((address_space(3)))
typedef unsigned short bf16_t;
typedef short bf16x8 __attribute__((ext_vector_type(8)));
typedef float f32x4 __attribute__((ext_vector_type(4)));
typedef float f32x2 __attribute__((ext_vector_type(2)));
typedef unsigned u32x4 __attribute__((ext_vector_type(4)));
typedef unsigned u32x2 __attribute__((ext_vector_type(2)));

constexpr int D = 2048, SEQ = 2048, NB = 4, DB = 32, DSEQ = 64, FF = 8192;
constexpr int MP = NB * SEQ, MS = DB * DSEQ, M = MP + MS;
constexpr int NG = 128, NP = 64, NQ = 16;
constexpr int NH = 16, HD = 128;
constexpr float ALPHA = 1.6817928305074290f;
constexpr float LN_EPS = 1e-5f, RMS_EPS = 1e-6f;
constexpr size_t O_YP = 0, O_YS = O_YP + (size_t)MP * D, O_SRP = O_YS + (size_t)MS * D, O_SIP = O_SRP + 2 * NB * NG * NP,
                 O_KP = O_SIP + 2 * NB * NG * NP, O_VP = O_KP + (size_t)NB * 512 * D, O_HP = O_VP + (size_t)NB * 512 * D,
                 O_SRS = O_HP + (size_t)NB * NH * 128 * 128, O_SIS = O_SRS + 2 * DB * NG * NP, O_KS = O_SIS + 2 * DB * NG * NP,
                 O_VS = O_KS + (size_t)MS * D, O_HS = O_VS + (size_t)MS * D, O_END = O_HS + (size_t)DB * NH * 128 * 128;

constexpr size_t MiB = 1u << 20;
constexpr size_t WS_CTL = 0;
constexpr size_t WS_WSSM = 1 * MiB;
constexpr size_t WS_WQKV = WS_WSSM + 32 * MiB;
constexpr size_t WS_WAO = WS_WQKV + 24 * MiB;
constexpr size_t WS_WHIN = WS_WAO + 8 * MiB;
constexpr size_t WS_WHO = WS_WHIN + 32 * MiB;
constexpr size_t WS_WF1 = WS_WHO + 8 * MiB;
constexpr size_t WS_WF2 = WS_WF1 + 128 * MiB;
constexpr size_t WS_X = WS_WF2 + 128 * MiB;
constexpr size_t WS_XB = WS_X + 80 * MiB;
constexpr size_t WS_Z = WS_XB + 40 * MiB;
constexpr size_t WS_H = WS_Z + 80 * MiB;
constexpr size_t WS_Y = WS_H + 160 * MiB;
constexpr size_t WS_PAR = WS_Y + 40 * MiB;
constexpr size_t WS_SCR = WS_PAR + 8 * MiB;
constexpr size_t WS_END = WS_SCR + 252 * MiB;
constexpr size_t PAR_ABAR = 0;
constexpr size_t PAR_BBAR = PAR_ABAR + 2 * NG * NP * 2 * 4;
constexpr size_t PAR_LB = PAR_BBAR + (size_t)2 * NG * NP * NQ * 2 * 4;
constexpr size_t PAR_BFRAG = PAR_LB + D * 4;
constexpr size_t PAR_CFRAG = PAR_BFRAG + (size_t)2 * NG * 8 * 64 * 16;
constexpr size_t PAR_END = PAR_CFRAG + (size_t)2 * NG * 4 * 64 * 16;
static_assert(PAR_END <= 8 * MiB, "params region");

__device__ __forceinline__ unsigned f2bf(float f) { unsigned u = __builtin_bit_cast(unsigned, f); return (u + 0x7fffu + ((u >> 16) & 1u)) >> 16; }
__device__ __forceinline__ unsigned pk2(float lo, float hi) { return f2bf(lo) | (f2bf(hi) << 16); }
__device__ __forceinline__ float bf2f(bf16_t b) { return __builtin_bit_cast(float, (unsigned)b << 16); }
__device__ __forceinline__ float sigmoidf_(float x) { return 1.0f / (1.0f + __expf(-x)); }
__device__ __forceinline__ float gelu_tanh(float x) { const float t = 1.5957691216057308f * (x + 0.044715f * x * x * x); return x / (1.0f + __expf(-t)); }

namespace pg8 {
constexpr int BM = 256, BK = 64, HALF = 128, HTB = HALF * BK * 2, STAGE_BYTES = 8 * HTB, NXCD = 8, WGM = 8;
__host__ __device__ __forceinline__ int lds_byte(int r, int c) { const int st = (r >> 4) * 2 + (c >> 5), rr = r & 15, cc = c & 31, ob = rr * 64 + cc * 2; return st * 1024 + (ob ^ (((ob >> 9) & 1) << 5)); }
__host__ __device__ __forceinline__ void stage_rc(int b, int& R, int& C) { const int st = b / 1024, sb = b % 1024, swz = sb ^ (((sb >> 9) & 1) << 5); R = (st >> 1) * 16 + swz / 64; C = (st & 1) * 32 + (swz % 64) / 2; }
__host__ __device__ __forceinline__ int perm32(int rho) { const int n = rho >> 4, i = rho & 15; return 8 * (i >> 2) + 4 * n + (i & 3); }

struct Unit { int pm, pn, k0, nt, part; };
struct Gemm { const bf16_t* A; const bf16_t* Bt; int lda, ldb; };

struct StaticOrder {
    int nM, nN, nwg, G, c, nt;
    __host__ __device__ void init(int M_, int N_, int K_, int G_, int c_) { nM = M_ / BM; nN = N_ / BM; nwg = nM * nN; G = G_; c = c_; nt = K_ / BK; }
    __host__ __device__ bool next(int i, Unit& u) const {
        const long L = (long)i * G + c; if (L >= nwg) return false;
        int wgid = (int)L; { const int q = nwg / NXCD, r = nwg % NXCD, xcd = wgid % NXCD, off = wgid / NXCD; wgid = (xcd < r ? xcd * (q + 1) : r * (q + 1) + (xcd - r) * q) + off; }
        const int nig = WGM * nN, gid = wgid / nig, fm = gid * WGM, gsz = (nM - fm) < WGM ? (nM - fm) : WGM;
        u.pm = fm + ((wgid % nig) % gsz); u.pn = (wgid % nig) / gsz; u.k0 = 0; u.nt = nt; u.part = 0; return true;
    }
    __device__ __forceinline__ void a_ready(const Unit&) const {}
    __device__ __forceinline__ void done(const Unit&) const {}
};

__device__ __forceinline__ unsigned cvt_pk_bf16(float lo, float hi) { unsigned r; asm volatile("v_cvt_pk_bf16_f32 %0, %1, %2" : "=v"(r) : "v"(lo), "v"(hi)); return r; }

template <class Epi, class Sched, bool ALIGN_EPI = true, bool SP2 = true>
__device__ __forceinline__ void gemm_phase(LAS unsigned char* lds, const Gemm g, const Sched& S, const Epi& E) {
    const int tid = threadIdx.x, wid = __builtin_amdgcn_readfirstlane(tid >> 6), lane = tid & 63, wr = wid >> 2, wc = wid & 3, fr = lane & 15, fq = lane >> 4;
    unsigned voffA[2], voffB[2];
#pragma unroll
    for (int i = 0; i < 2; ++i) { int R, C; stage_rc(tid * 16 + i * 8192, R, C); const int Rb = Epi::PERM ? ((R & ~31) + perm32(R & 31)) : R;
        voffA[i] = (unsigned)(R * g.lda + C) * 2u; voffB[i] = (unsigned)(Rb * g.ldb + C) * 2u; }
    const size_t kstep = (size_t)(BK * 2);
    const size_t hstepA = (size_t)HALF * g.lda * 2, hstepB = (size_t)HALF * g.ldb * 2;
    const unsigned ldsw = (unsigned)wid * 1024u;
    const int aoff = lds_byte(wr * 64 + fr, fq * 8), boff = lds_byte(wc * 32 + fr, fq * 8);
#define PG8_SA(b, h) (((b) * 2 + (h)) * HTB)
#define PG8_SB(b, h) ((4 + (b) * 2 + (h)) * HTB)
#define PG8_STAGE(bufoff, gbase, voff) do { _Pragma("unroll") for (int _i = 0; _i < 2; ++_i) \
        __builtin_amdgcn_global_load_lds((const unsigned*)((const char*)(gbase) + (voff)[_i]), (LAS unsigned*)(lds + (bufoff) + ldsw + _i * 8192), 16, 0, 0); } while (0)
#define PG8_LDA(dst, b, h) do { _Pragma("unroll") for (int m = 0; m < 4; ++m) _Pragma("unroll") for (int k = 0; k < 2; ++k) dst[m][k] = *(const LAS bf16x8*)(lds + PG8_SA(b, h) + aoff + m * 2048 + k * 1024); } while (0)
#define PG8_LDB(dst, b, h) do { _Pragma("unroll") for (int n = 0; n < 2; ++n) _Pragma("unroll") for (int k = 0; k < 2; ++k) dst[n][k] = *(const LAS bf16x8*)(lds + PG8_SB(b, h) + boff + n * 2048 + k * 1024); } while (0)
#define PG8_MMA(ai, bj, At, Bt) do { __builtin_amdgcn_s_setprio(1); _Pragma("unroll") for (int m = 0; m < 4; ++m) _Pragma("unroll") for (int n = 0; n < 2; ++n) _Pragma("unroll") for (int k = 0; k < 2; ++k) \
        acc[ai][bj][m][n] = __builtin_amdgcn_mfma_f32_16x16x32_bf16(Bt[n][k], At[m][k], acc[ai][bj][m][n], 0, 0, 0); __builtin_amdgcn_s_setprio(0); } while (0)
#define PG8_WAIT_V(n) asm volatile("s_waitcnt vmcnt(" #n ")" ::: "memory")
#define PG8_WAIT_L(n) asm volatile("s_waitcnt lgkmcnt(" #n ")" ::: "memory")
#define PG8_BAR __builtin_amdgcn_s_barrier()
#define PG8_SCHED __builtin_amdgcn_sched_barrier(0)
    Unit cur, nxt; int ui = 0;
    if (!S.next(0, cur)) return;
    f32x4 acc[2][2][4][2];
#pragma unroll
    for (int a = 0; a < 2; ++a)
#pragma unroll
        for (int b = 0; b < 2; ++b)
#pragma unroll
            for (int m = 0; m < 4; ++m)
#pragma unroll
                for (int n = 0; n < 2; ++n) acc[a][b][m][n] = (f32x4){0.f, 0.f, 0.f, 0.f};
    bf16x8 At[4][2], B0[2][2], B1[2][2];
    const char* cA = (const char*)g.A + (size_t)cur.pm * 2 * hstepA + (size_t)cur.k0 * 2; const char* cB = (const char*)g.Bt + (size_t)cur.pn * 2 * hstepB + (size_t)cur.k0 * 2;
    S.a_ready(cur);
    if constexpr (SP2) {
        PG8_STAGE(PG8_SB(0, 0), cB, voffB); PG8_STAGE(PG8_SB(0, 1), cB + hstepB, voffB); PG8_STAGE(PG8_SA(0, 0), cA, voffA); PG8_STAGE(PG8_SA(0, 1), cA + hstepA, voffA);
        if (wr == 1) PG8_BAR;
        PG8_WAIT_V(2); PG8_BAR;
        PG8_STAGE(PG8_SB(1, 0), cB + kstep, voffB); PG8_STAGE(PG8_SA(1, 0), cA + kstep, voffA); PG8_STAGE(PG8_SB(1, 1), cB + hstepB + kstep, voffB);
        PG8_WAIT_V(6); PG8_BAR;
    } else {
        PG8_STAGE(PG8_SB(0, 0), cB, voffB); PG8_STAGE(PG8_SA(0, 0), cA, voffA); PG8_STAGE(PG8_SB(0, 1), cB + hstepB, voffB); PG8_STAGE(PG8_SA(0, 1), cA + hstepA, voffA);
        if (wr == 1) PG8_BAR;
        PG8_WAIT_V(4); PG8_BAR;
        PG8_STAGE(PG8_SB(1, 0), cB + kstep, voffB); PG8_STAGE(PG8_SA(1, 0), cA + kstep, voffA); PG8_STAGE(PG8_SB(1, 1), cB + hstepB + kstep, voffB);
        PG8_WAIT_V(6); PG8_BAR;
    }
    for (;;) {
        const bool has_next = S.next(ui + 1, nxt);
        const int nt = cur.nt;
        const char* nA = has_next ? (const char*)g.A + (size_t)nxt.pm * 2 * hstepA + (size_t)nxt.k0 * 2 : cA; const char* nB = has_next ? (const char*)g.Bt + (size_t)nxt.pn * 2 * hstepB + (size_t)nxt.k0 * 2 : cB;
        for (int t = 0; t < nt; t += 2) {
            const bool last = (t == nt - 2);
            const char* a1 = cA + (size_t)(t + 1) * kstep;
            const char* a2 = last ? nA : cA + (size_t)(t + 2) * kstep; const char* b2 = last ? nB : cB + (size_t)(t + 2) * kstep;
            const char* a3 = a2 + kstep; const char* b3 = b2 + kstep;
            if (last && has_next) S.a_ready(nxt);
            if constexpr (SP2) {
            PG8_LDB(B0, 0, 0); PG8_LDB(B1, 0, 1); PG8_SCHED; PG8_LDA(At, 0, 0); PG8_STAGE(PG8_SA(1, 1), a1 + hstepA, voffA);
            PG8_WAIT_V(8); PG8_WAIT_L(0); PG8_BAR; PG8_MMA(0, 0, At, B0); PG8_MMA(0, 1, At, B1); PG8_BAR; PG8_SCHED;
            PG8_LDA(At, 0, 1); PG8_STAGE(PG8_SB(0, 0), b2, voffB); PG8_STAGE(PG8_SB(0, 1), b2 + hstepB, voffB); PG8_STAGE(PG8_SA(0, 0), a2, voffA);
            PG8_WAIT_V(8); PG8_WAIT_L(0); PG8_BAR; PG8_MMA(1, 0, At, B0); PG8_MMA(1, 1, At, B1); PG8_BAR; PG8_SCHED;
            PG8_LDB(B0, 1, 0); PG8_LDB(B1, 1, 1); PG8_SCHED; PG8_LDA(At, 1, 0); PG8_STAGE(PG8_SA(0, 1), a2 + hstepA, voffA);
            PG8_WAIT_V(8); PG8_WAIT_L(0); PG8_BAR; PG8_MMA(0, 0, At, B0); PG8_MMA(0, 1, At, B1); PG8_BAR; PG8_SCHED;
            PG8_LDA(At, 1, 1); PG8_STAGE(PG8_SB(1, 0), b3, voffB); PG8_STAGE(PG8_SB(1, 1), b3 + hstepB, voffB); PG8_STAGE(PG8_SA(1, 0), a3, voffA);
            PG8_WAIT_V(8); PG8_WAIT_L(0); PG8_BAR; PG8_MMA(1, 0, At, B0); PG8_MMA(1, 1, At, B1); PG8_BAR; PG8_SCHED;
            } else {
            PG8_LDB(B0, 0, 0); PG8_SCHED; PG8_LDA(At, 0, 0); PG8_STAGE(PG8_SA(1, 1), a1 + hstepA, voffA);
            PG8_WAIT_L(8); PG8_BAR; PG8_WAIT_L(0); PG8_MMA(0, 0, At, B0); PG8_BAR; PG8_SCHED;
            PG8_LDB(B1, 0, 1); PG8_STAGE(PG8_SB(0, 0), b2, voffB);
            PG8_BAR; PG8_WAIT_L(0); PG8_MMA(0, 1, At, B1); PG8_BAR;
            PG8_LDA(At, 0, 1); PG8_STAGE(PG8_SA(0, 0), a2, voffA);
            PG8_BAR; PG8_WAIT_L(0); PG8_MMA(1, 0, At, B0); PG8_BAR; PG8_SCHED;
            PG8_STAGE(PG8_SB(0, 1), b2 + hstepB, voffB);
            PG8_WAIT_V(6); PG8_BAR; PG8_MMA(1, 1, At, B1); PG8_BAR;
            PG8_LDB(B0, 1, 0); PG8_SCHED; PG8_LDA(At, 1, 0); PG8_STAGE(PG8_SA(0, 1), a2 + hstepA, voffA);
            PG8_WAIT_L(8); PG8_BAR; PG8_WAIT_L(0); PG8_MMA(0, 0, At, B0); PG8_BAR; PG8_SCHED;
            PG8_LDB(B1, 1, 1); PG8_STAGE(PG8_SB(1, 0), b3, voffB);
            PG8_BAR; PG8_WAIT_L(0); PG8_MMA(0, 1, At, B1); PG8_BAR;
            PG8_LDA(At, 1, 1); PG8_STAGE(PG8_SA(1, 0), a3, voffA);
            PG8_BAR; PG8_WAIT_L(0); PG8_MMA(1, 0, At, B0); PG8_BAR; PG8_SCHED;
            PG8_STAGE(PG8_SB(1, 1), b3 + hstepB, voffB);
            PG8_WAIT_V(6); PG8_BAR; PG8_MMA(1, 1, At, B1); PG8_BAR;
            }
        }
        if constexpr (ALIGN_EPI) { if (wr == 0) PG8_BAR; }
        E(acc, cur, wr, wc, fr, fq); S.done(cur);
        if (!has_next) break;
#pragma unroll
        for (int a = 0; a < 2; ++a)
#pragma unroll
            for (int b = 0; b < 2; ++b)
#pragma unroll
                for (int m = 0; m < 4; ++m)
#pragma unroll
                    for (int n = 0; n < 2; ++n) acc[a][b][m][n] = (f32x4){0.f, 0.f, 0.f, 0.f};
        cur = nxt; cA = nA; cB = nB; ++ui;
        if constexpr (ALIGN_EPI) { if (wr == 1) PG8_BAR; }
    }
    PG8_WAIT_V(0);
    if constexpr (!ALIGN_EPI) { if (wr == 0) PG8_BAR; }
    PG8_BAR;
#undef PG8_SA
#undef PG8_SB
#undef PG8_STAGE
#undef PG8_LDA
#undef PG8_LDB
#undef PG8_MMA
#undef PG8_WAIT_V
#undef PG8_WAIT_L
#undef PG8_BAR
#undef PG8_SCHED
}
}

using pg8::Unit;
struct ResSrc { const float* xp; const float* xs; __device__ __forceinline__ const float* row(int r) const { return r < MP ? xp + (size_t)r * D : xs + (size_t)(r - MP) * D; } };

struct EpiSsmGate {
    static constexpr bool PERM = false;
    ResSrc xr; float* Z;
    __device__ __forceinline__ void operator()(const f32x4 (&acc)[2][2][4][2], const Unit& u, int wr, int wc, int fr, int fq) const {
        const int row0 = u.pm * 256 + wr * 64 + fr, ch0 = u.pn * 128 + wc * 32 + 4 * fq;
#pragma unroll
        for (int ai = 0; ai < 2; ++ai)
#pragma unroll
            for (int m = 0; m < 4; ++m) { const int row = row0 + ai * 128 + m * 16; const float* xrow = xr.row(row) + ch0; float* zrow = Z + (size_t)row * D + ch0;
#pragma unroll
                for (int n = 0; n < 2; ++n) { const f32x4 o = acc[ai][0][m][n], gt = acc[ai][1][m][n]; const f32x4 x = *(const f32x4*)(xrow + n * 16); f32x4 z;
#pragma unroll
                    for (int j = 0; j < 4; ++j) z[j] = ALPHA * x[j] + o[j] * sigmoidf_(gt[j]);
                    *(f32x4*)(zrow + n * 16) = z; } }
    }
};
struct EpiRes {
    static constexpr bool PERM = false;
    ResSrc xr; float* Z;
    __device__ __forceinline__ void operator()(const f32x4 (&acc)[2][2][4][2], const Unit& u, int wr, int wc, int fr, int fq) const {
        const int row0 = u.pm * 256 + wr * 64 + fr, col0 = u.pn * 256 + wc * 32 + 4 * fq;
#pragma unroll
        for (int ai = 0; ai < 2; ++ai)
#pragma unroll
            for (int m = 0; m < 4; ++m) { const int row = row0 + ai * 128 + m * 16; const float* xrow = xr.row(row) + col0; float* zrow = Z + (size_t)row * D + col0;
#pragma unroll
                for (int bj = 0; bj < 2; ++bj)
#pragma unroll
                    for (int n = 0; n < 2; ++n) { const f32x4 x = *(const f32x4*)(xrow + bj * 128 + n * 16); *(f32x4*)(zrow + bj * 128 + n * 16) = ALPHA * x + acc[ai][bj][m][n]; } }
    }
};
struct EpiFfn1 {
    static constexpr bool PERM = true;
    bf16_t* H;
    __device__ __forceinline__ void operator()(const f32x4 (&acc)[2][2][4][2], const Unit& u, int wr, int wc, int fr, int fq) const {
        const int row0 = u.pm * 256 + wr * 64 + fr, col0 = u.pn * 256 + wc * 32 + 8 * fq;
#pragma unroll
        for (int ai = 0; ai < 2; ++ai)
#pragma unroll
            for (int m = 0; m < 4; ++m) { bf16_t* rowp = H + (size_t)(row0 + ai * 128 + m * 16) * FF + col0;
#pragma unroll
                for (int bj = 0; bj < 2; ++bj) { f32x4 v0 = acc[ai][bj][m][0], v1 = acc[ai][bj][m][1];
#pragma unroll
                    for (int j = 0; j < 4; ++j) { const float a = fmaxf(v0[j], 0.f), b = fmaxf(v1[j], 0.f); v0[j] = a * a; v1[j] = b * b; }
                    u32x4 w; w.x = pg8::cvt_pk_bf16(v0[0], v0[1]); w.y = pg8::cvt_pk_bf16(v0[2], v0[3]); w.z = pg8::cvt_pk_bf16(v1[0], v1[1]); w.w = pg8::cvt_pk_bf16(v1[2], v1[3]);
                    *(u32x4*)(rowp + bj * 128) = w; } }
    }
};
struct EpiQkv {
    static constexpr bool PERM = true;
    bf16_t* QKV; float* out;
    __device__ __forceinline__ void operator()(const f32x4 (&acc)[2][2][4][2], const Unit& u, int wr, int wc, int fr, int fq) const {
        const int t = u.pn >> 3; const int colt = (u.pn & 7) * 256;
        const int col0 = colt + wc * 32 + 8 * fq;
        bf16_t* base = QKV + (size_t)t * M * D;
        float* fdst = nullptr;
        if (t >= 1) {
            if (u.pm < 32) { if ((u.pm & 7) >= 6) { const int n = u.pm >> 3; fdst = out + (t == 1 ? O_KP : O_VP) + ((size_t)n * 512 + (size_t)((u.pm & 7) - 6) * 256) * D; } }
            else fdst = out + (t == 1 ? O_KS : O_VS) + (size_t)(u.pm - 32) * 256 * D;
        }
#pragma unroll
        for (int ai = 0; ai < 2; ++ai)
#pragma unroll
            for (int m = 0; m < 4; ++m) { const int rl = wr * 64 + fr + ai * 128 + m * 16; bf16_t* rowp = base + (size_t)(u.pm * 256 + rl) * D + col0;
#pragma unroll
                for (int bj = 0; bj < 2; ++bj) { const f32x4 v0 = acc[ai][bj][m][0], v1 = acc[ai][bj][m][1];
                    u32x4 w; w.x = pg8::cvt_pk_bf16(v0[0], v0[1]); w.y = pg8::cvt_pk_bf16(v0[2], v0[3]); w.z = pg8::cvt_pk_bf16(v1[0], v1[1]); w.w = pg8::cvt_pk_bf16(v1[2], v1[3]);
                    *(u32x4*)(rowp + bj * 128) = w;
                    if (fdst) { float* fp = fdst + (size_t)rl * D + col0 + bj * 128; *(f32x4*)fp = v0; *(f32x4*)(fp + 4) = v1; } } }
    }
};
struct EpiHgrnIn {
    static constexpr bool PERM = true;
    bf16_t* QIG; float* F; const float* lb;
    __device__ __forceinline__ void operator()(const f32x4 (&acc)[2][2][4][2], const Unit& u, int wr, int wc, int fr, int fq) const {
        const int t = u.pn >> 3; const int colt = (u.pn & 7) * 256;
        const int row0 = u.pm * 256 + wr * 64 + fr, col0 = colt + wc * 32 + 8 * fq;
        if (t == 1) {
#pragma unroll
            for (int bj = 0; bj < 2; ++bj) { const f32x4 l0 = *(const f32x4*)(lb + col0 + bj * 128), l1 = *(const f32x4*)(lb + col0 + bj * 128 + 4);
#pragma unroll
                for (int ai = 0; ai < 2; ++ai)
#pragma unroll
                    for (int m = 0; m < 4; ++m) { float* fp = F + (size_t)(row0 + ai * 128 + m * 16) * D + col0 + bj * 128; f32x4 v0 = acc[ai][bj][m][0], v1 = acc[ai][bj][m][1];
#pragma unroll
                        for (int j = 0; j < 4; ++j) { v0[j] = l0[j] + (1.0f - l0[j]) * sigmoidf_(v0[j]); v1[j] = l1[j] + (1.0f - l1[j]) * sigmoidf_(v1[j]); }
                        *(f32x4*)fp = v0; *(f32x4*)(fp + 4) = v1; } }
        } else {
            bf16_t* base = QIG + (size_t)(t == 0 ? 0 : t - 1) * M * D;
#pragma unroll
            for (int ai = 0; ai < 2; ++ai)
#pragma unroll
                for (int m = 0; m < 4; ++m) { bf16_t* rowp = base + (size_t)(row0 + ai * 128 + m * 16) * D + col0;
#pragma unroll
                    for (int bj = 0; bj < 2; ++bj) { const f32x4 v0 = acc[ai][bj][m][0], v1 = acc[ai][bj][m][1];
                        u32x4 w; w.x = pg8::cvt_pk_bf16(v0[0], v0[1]); w.y = pg8::cvt_pk_bf16(v0[2], v0[3]); w.z = pg8::cvt_pk_bf16(v1[0], v1[1]); w.w = pg8::cvt_pk_bf16(v1[2], v1[3]);
                        *(u32x4*)(rowp + bj * 128) = w; } }
        }
    }
};

struct Args { const float* in[30]; float* out; unsigned char* ws; int layer, a1, a2, pad; };

template <int WHICH> __global__ void __launch_bounds__(512, 2) k_gemm(Args a) {
    extern __shared__ __attribute__((aligned(16))) unsigned char lds_raw[];
    LAS unsigned char* lds = (LAS unsigned char*)lds_raw;
    unsigned char* ws = a.ws; const int L = a.layer;
    float* X = (float*)(ws + WS_X); bf16_t* XB = (bf16_t*)(ws + WS_XB); float* Z = (float*)(ws + WS_Z); bf16_t* H = (bf16_t*)(ws + WS_H); bf16_t* Y = (bf16_t*)(ws + WS_Y);
    ResSrc xr; if (L == 0) { xr.xp = a.in[0]; xr.xs = a.in[1]; } else { xr.xp = X; xr.xs = X + (size_t)MP * D; }
    const int G = gridDim.x, c = blockIdx.x;
    if constexpr (WHICH == 0) {
        pg8::Gemm g{Y, (const bf16_t*)(ws + WS_WSSM) + (size_t)a.a1 * 4096 * D, D, D}; pg8::StaticOrder S; S.init(M, 4096, D, G, c);
        EpiSsmGate E{xr, Z}; pg8::gemm_phase<EpiSsmGate, pg8::StaticOrder>(lds, g, S, E);
    } else if constexpr (WHICH == 1) {
        pg8::Gemm g{XB, (const bf16_t*)(ws + WS_WQKV), D, D}; pg8::StaticOrder S; S.init(M, 6144, D, G, c);
        EpiQkv E{H, a.out}; pg8::gemm_phase<EpiQkv, pg8::StaticOrder>(lds, g, S, E);
    } else if constexpr (WHICH == 2 || WHICH == 4) {
        pg8::Gemm g{Y, (const bf16_t*)(ws + (WHICH == 2 ? WS_WAO : WS_WHO)), D, D}; pg8::StaticOrder S; S.init(M, D, D, G, c);
        EpiRes E{xr, Z}; pg8::gemm_phase<EpiRes, pg8::StaticOrder>(lds, g, S, E);
    } else if constexpr (WHICH == 3) {
        pg8::Gemm g{XB, (const bf16_t*)(ws + WS_WHIN), D, D}; pg8::StaticOrder S; S.init(M, 8192, D, G, c);
        EpiHgrnIn E{H, Z, (const float*)(ws + WS_PAR + PAR_LB)}; pg8::gemm_phase<EpiHgrnIn, pg8::StaticOrder>(lds, g, S, E);
    } else if constexpr (WHICH == 5) {
        pg8::Gemm g{XB, (const bf16_t*)(ws + WS_WF1) + (size_t)L * FF * D, D, D}; pg8::StaticOrder S; S.init(M, FF, D, G, c);
        EpiFfn1 E{H}; pg8::gemm_phase<EpiFfn1, pg8::StaticOrder>(lds, g, S, E);
    } else {
        pg8::Gemm g{H, (const bf16_t*)(ws + WS_WF2) + (size_t)L * FF * D, FF, FF}; pg8::StaticOrder S; S.init(M, D, FF, G, c);
        ResSrc xr2{X, X + (size_t)MP * D};
        EpiRes E{xr2, Z}; pg8::gemm_phase<EpiRes, pg8::StaticOrder>(lds, g, S, E);
    }
}

__global__ void k_convert_w(const float* __restrict__ W, bf16_t* __restrict__ WT, int K, int N, int mode) {
    __shared__ float tile[32][33];
    const int nb = N / 32; const int kb = blockIdx.x / nb, nbi = blockIdx.x % nb; const int k0 = kb * 32, n0 = nbi * 32;
    const int tx = threadIdx.x & 31, ty = threadIdx.x >> 5;
#pragma unroll
    for (int i = 0; i < 4; ++i) tile[ty + 8 * i][tx] = W[(size_t)(k0 + ty + 8 * i) * N + n0 + tx];
    __syncthreads();
#pragma unroll
    for (int i = 0; i < 4; ++i) { const int n = n0 + ty + 8 * i; const int row = mode == 0 ? n : 256 * (n >> 7) + 128 * (mode - 1) + (n & 127);
        WT[(size_t)row * K + k0 + tx] = (bf16_t)f2bf(tile[tx][ty + 8 * i]); }
}
__global__ void k_params(Args a) {
    unsigned char* par = a.ws + WS_PAR;
    const int idx = blockIdx.x * blockDim.x + threadIdx.x;
    if (idx < 2 * NG * NP) {
        const int j = idx / (NG * NP), g = (idx / NP) % NG;
        const double are = a.in[7][idx], aim = a.in[8][idx], dt = exp((double)a.in[9][j * NG + g]);
        const double e = exp(are * dt), cr = e * cos(aim * dt), ci = e * sin(aim * dt);
        float* ab = (float*)(par + PAR_ABAR) + (size_t)idx * 2; ab[0] = (float)cr; ab[1] = (float)ci;
        const double xr = cr - 1.0, xi = ci, den = are * are + aim * aim; const double fr = (xr * are + xi * aim) / den, fi = (xi * are - xr * aim) / den;
        float* bb = (float*)(par + PAR_BBAR) + (size_t)idx * NQ * 2;
        for (int q = 0; q < NQ; ++q) { const double br = a.in[10][(size_t)idx * NQ + q], bi = a.in[11][(size_t)idx * NQ + q]; bb[2 * q] = (float)(fr * br - fi * bi); bb[2 * q + 1] = (float)(fr * bi + fi * br); }
    }
    if (idx < D) {
        const float* lg = a.in[21]; float v0 = lg[idx], v1 = lg[D + idx], v2 = lg[2 * D + idx], v3 = lg[3 * D + idx];
        const float mx = fmaxf(fmaxf(v0, v1), fmaxf(v2, v3));
        v0 = expf(v0 - mx); v1 = expf(v1 - mx); v2 = expf(v2 - mx); v3 = expf(v3 - mx);
        ((float*)(par + PAR_LB))[idx] = (v1 + v2) / (v0 + v1 + v2 + v3);
    }
}

__device__ __forceinline__ float wave_sum(float v) {
#pragma unroll
    for (int o = 1; o < 64; o <<= 1) v += __shfl_xor(v, o);
    return v;
}
__global__ void __launch_bounds__(256) k_ln(Args a) {
    unsigned char* ws = a.ws; const int L = a.layer;
    const float* Z = (const float*)(ws + WS_Z); float* Xo = a.a2 ? a.out : (float*)(ws + WS_X); bf16_t* XB = (bf16_t*)(ws + WS_XB);
    const float* gam = a.in[a.a1 ? 26 : 24] + (size_t)L * D; const float* bet = a.in[a.a1 ? 27 : 25] + (size_t)L * D;
    const int lane = threadIdx.x & 63, gw = blockIdx.x * 4 + (threadIdx.x >> 6), ngw = gridDim.x * 4;
    for (int r = gw; r < M; r += ngw) {
        const f32x4* zr = (const f32x4*)(Z + (size_t)r * D) + lane; f32x4 v[8]; float s = 0.f;
#pragma unroll
        for (int j = 0; j < 8; ++j) { v[j] = zr[64 * j]; s += (v[j].x + v[j].y) + (v[j].z + v[j].w); }
        const float mean = wave_sum(s) * (1.f / D); float s2 = 0.f;
#pragma unroll
        for (int j = 0; j < 8; ++j) { v[j] = v[j] - mean; s2 += (v[j].x * v[j].x + v[j].y * v[j].y) + (v[j].z * v[j].z + v[j].w * v[j].w); }
        const float rstd = 1.f / sqrtf(wave_sum(s2) * (1.f / D) + LN_EPS);
        f32x4* xo = (f32x4*)(Xo + (size_t)r * D) + lane; u32x2* xb = (u32x2*)(XB + (size_t)r * D) + lane;
#pragma unroll
        for (int j = 0; j < 8; ++j) { const f32x4 gg = ((const f32x4*)gam)[lane + 64 * j], bb = ((const f32x4*)bet)[lane + 64 * j]; const f32x4 y = v[j] * rstd * gg + bb;
            xo[64 * j] = y; u32x2 w; w.x = pk2(y.x, y.y); w.y = pk2(y.z, y.w); xb[64 * j] = w; }
    }
}

__global__ void k_params2(Args a) {
    unsigned char* par = a.ws + WS_PAR;
    const int idx = blockIdx.x * blockDim.x + threadIdx.x;
    if (idx < 2 * NG * 8 * 64) {
        const int lane = idx & 63, n8 = (idx >> 6) & 7, jg = idx >> 9; const int j = jg / NG, g = jg % NG; const int G4 = lane >> 4, c = lane & 15;
        const int pp = 16 * n8 + c, p = pp & 63, im = pp >> 6; const int sidx = (j * NG + g) * NP + p;
        const double are = a.in[7][sidx], aim = a.in[8][sidx], dt = exp((double)a.in[9][j * NG + g]);
        const double e = exp(are * dt), cr = e * cos(aim * dt), ci = e * sin(aim * dt);
        const double xr = cr - 1.0, xi = ci, den = are * are + aim * aim; const double fr = (xr * are + xi * aim) / den, fi = (xi * are - xr * aim) / den;
        unsigned w[4];
#pragma unroll
        for (int e2 = 0; e2 < 4; ++e2) { float v[2];
#pragma unroll
            for (int h = 0; h < 2; ++h) { const int q = (8 * G4 + 2 * e2 + h) & 15; const double br = a.in[10][(size_t)sidx * NQ + q], bi = a.in[11][(size_t)sidx * NQ + q];
                v[h] = (float)(im ? (fr * bi + fi * br) : (fr * br - fi * bi)); }
            w[e2] = pk2(v[0], v[1]); }
        ((u32x4*)(par + PAR_BFRAG))[idx] = (u32x4){w[0], w[1], w[2], w[3]};
    } else if (idx < 2 * NG * 8 * 64 + 2 * NG * 4 * 64) {
        const int id2 = idx - 2 * NG * 8 * 64; const int lane = id2 & 63, kk = (id2 >> 6) & 3, jg = id2 >> 8; const int G4 = lane >> 4, c = lane & 15;
        unsigned w[4];
#pragma unroll
        for (int e2 = 0; e2 < 4; ++e2) { float v[2];
#pragma unroll
            for (int h = 0; h < 2; ++h) { const int pp = 32 * kk + 8 * G4 + 2 * e2 + h; const size_t ci = ((size_t)jg * NQ + c) * NP + (pp & 63);
                v[h] = pp < 64 ? a.in[12][ci] : -a.in[13][ci]; }
            w[e2] = pk2(v[0], v[1]); }
        ((u32x4*)(par + PAR_CFRAG))[id2] = (u32x4){w[0], w[1], w[2], w[3]};
    }
}

__device__ __forceinline__ f32x4 mfma_t(bf16x8 a, bf16x8 b, f32x4 c) {
    asm volatile("s_nop 4" : "+v"(a), "+v"(b), "+v"(c));
    f32x4 d = __builtin_amdgcn_mfma_f32_16x16x32_bf16(a, b, c, 0, 0, 0);
    asm volatile("s_nop 7\n\ts_nop 7" : "+v"(d) : "v"(a), "v"(b));
    return d;
}
#define MFMA_PRE1(x) asm volatile("s_nop 4" : "+v"(x))
#define MFMA_POST4(a, b, c, d) asm volatile("s_nop 7\n\ts_nop 7" : "+v"(a), "+v"(b), "+v"(c), "+v"(d))
#define MFMA_POST8(a, b, c, d, e, f, g, h) asm volatile("s_nop 7\n\ts_nop 7" : "+v"(a), "+v"(b), "+v"(c), "+v"(d), "+v"(e), "+v"(f), "+v"(g), "+v"(h))
#define MFMA_POST1(a) asm volatile("s_nop 7\n\ts_nop 7" : "+v"(a))
constexpr int SSM_BUS = 132;
constexpr int SSM_WLDS = 16 * SSM_BUS * 4;
__device__ __forceinline__ void ssm_item(const Args& a, LAS unsigned char* wl, int j, int L, bool samp, int n, int g, int lane) {
    unsigned char* ws = a.ws;
    const int T = samp ? DSEQ : SEQ;
    const size_t rowbase = samp ? (size_t)MP + (size_t)n * DSEQ : (size_t)n * SEQ;
    const float* xbase = (L == 0) ? (samp ? a.in[1] + (size_t)n * DSEQ * D : a.in[0] + rowbase * D) : (const float*)(ws + WS_X) + rowbase * D;
    const int G4 = lane >> 4, c = lane & 15;
    const bf16x8* bfp = (const bf16x8*)(ws + WS_PAR + PAR_BFRAG) + (size_t)(j * NG + g) * 8 * 64 + lane;
    const bf16x8* cfp = (const bf16x8*)(ws + WS_PAR + PAR_CFRAG) + (size_t)(j * NG + g) * 4 * 64 + lane;
    bf16x8 Bf[8], Cf[4];
#pragma unroll
    for (int i = 0; i < 8; ++i) Bf[i] = bfp[i * 64];
#pragma unroll
    for (int i = 0; i < 4; ++i) Cf[i] = cfp[i * 64];
    const float* ab = (const float*)(ws + WS_PAR + PAR_ABAR) + ((size_t)(j * NG + g) * NP + lane) * 2; const float ar = ab[0], ai = ab[1];
    const float dsk = a.in[14][(size_t)j * D + g * NQ + c];
    float hr = 0.f, hi = 0.f;
    if (samp) { hr = a.in[2][((size_t)(j * DB + n) * NG + g) * NP + lane]; hi = a.in[3][((size_t)(j * DB + n) * NG + g) * NP + lane]; }
    LAS float* BUs = (LAS float*)wl;
    bf16_t* Y = (bf16_t*)(ws + WS_Y);
    const float* up = xbase + (size_t)c * D + g * NQ + 8 * (G4 & 1);
    f32x4 u0 = *(const f32x4*)up, u1 = *(const f32x4*)(up + 4);
    for (int t0 = 0; t0 < T; t0 += 16) {
        bf16x8 af;
#pragma unroll
        for (int e = 0; e < 8; ++e) { const float u = e < 4 ? u0[e] : u1[e - 4]; const unsigned hb = f2bf(u); const unsigned lb = f2bf(u - __builtin_bit_cast(float, hb << 16)); af[e] = (short)(G4 < 2 ? hb : lb); }
        if (t0 + 16 < T) { const float* un = up + (size_t)(t0 + 16) * D; u0 = *(const f32x4*)un; u1 = *(const f32x4*)(un + 4); }
        float us[4];
#pragma unroll
        for (int i = 0; i < 4; ++i) us[i] = xbase[(size_t)(t0 + 4 * G4 + i) * D + g * NQ + c];
        MFMA_PRE1(af);
        f32x4 dd[8];
#pragma unroll
        for (int n8 = 0; n8 < 8; ++n8) dd[n8] = mfma_t(af, Bf[n8], (f32x4){0.f, 0.f, 0.f, 0.f});
        MFMA_POST8(dd[0], dd[1], dd[2], dd[3], dd[4], dd[5], dd[6], dd[7]);
#pragma unroll
        for (int n8 = 0; n8 < 8; ++n8)
#pragma unroll
            for (int i = 0; i < 4; ++i) BUs[(4 * G4 + i) * SSM_BUS + 16 * n8 + c] = dd[n8][i];
        asm volatile("s_waitcnt lgkmcnt(0)" ::: "memory");
#pragma unroll
        for (int t = 0; t < 16; ++t) { const float br = BUs[t * SSM_BUS + lane], bi = BUs[t * SSM_BUS + 64 + lane];
            const float nr = fmaf(ar, hr, fmaf(-ai, hi, br)), ni = fmaf(ar, hi, fmaf(ai, hr, bi)); hr = nr; hi = ni;
            BUs[t * SSM_BUS + lane] = hr; BUs[t * SSM_BUS + 64 + lane] = hi; }
        asm volatile("s_waitcnt lgkmcnt(0)" ::: "memory");
        f32x4 y = (f32x4){0.f, 0.f, 0.f, 0.f};
        u32x4 hw[4];
#pragma unroll
        for (int kk = 0; kk < 4; ++kk) { const LAS f32x4* hp = (const LAS f32x4*)(BUs + c * SSM_BUS + 32 * kk + 8 * G4); const f32x4 h0 = hp[0], h1 = hp[1];
            hw[kk].x = pk2(h0[0], h0[1]); hw[kk].y = pk2(h0[2], h0[3]); hw[kk].z = pk2(h1[0], h1[1]); hw[kk].w = pk2(h1[2], h1[3]); }
        MFMA_POST4(hw[0], hw[1], hw[2], hw[3]);
#pragma unroll
        for (int kk = 0; kk < 4; ++kk) y = mfma_t(__builtin_bit_cast(bf16x8, hw[kk]), Cf[kk], y);
        MFMA_POST1(y);
#pragma unroll
        for (int i = 0; i < 4; ++i) Y[(rowbase + t0 + 4 * G4 + i) * D + g * NQ + c] = (bf16_t)f2bf(gelu_tanh(y[i] + dsk * us[i]));
        asm volatile("s_waitcnt lgkmcnt(0)" ::: "memory");
    }
    const size_t so = ((size_t)(j * (samp ? DB : NB) + n) * NG + g) * NP + lane;
    a.out[(samp ? O_SRS : O_SRP) + so] = hr; a.out[(samp ? O_SIS : O_SIP) + so] = hi;
}
__device__ __forceinline__ void ph_ssm(const Args& a, LAS unsigned char* lds, int j, int L, int nblk, int b) {
    const int wave = __builtin_amdgcn_readfirstlane(threadIdx.x >> 6), lane = threadIdx.x & 63;
    LAS unsigned char* wl = lds + wave * SSM_WLDS;
    if (wave < 2) { for (int it = b * 2 + wave; it < NB * NG; it += nblk * 2) ssm_item(a, wl, j, L, false, it / NG, it % NG, lane); }
    else { for (int it = b * 6 + (wave - 2); it < DB * NG; it += nblk * 6) ssm_item(a, wl, j, L, true, it / NG, it % NG, lane); }
}
__global__ void __launch_bounds__(512, 2) k_ssm2(Args a) {
    extern __shared__ __attribute__((aligned(16))) unsigned char lds_raw[];
    ph_ssm(a, (LAS unsigned char*)lds_raw, a.a1, a.layer, gridDim.x, blockIdx.x);
}


typedef short s16x4 __attribute__((ext_vector_type(4)));
constexpr int AT_KS = 136;
constexpr int AT_TILE = 64 * AT_KS * 2;
constexpr int AT_LDS_K = 0, AT_LDS_V = 2 * AT_TILE, AT_LDS_TAB = 4 * AT_TILE, AT_LDS_BYTES = AT_LDS_TAB + 2 * 260 * 4;
template <bool SAMP>
__device__ __forceinline__ void attn_unit(const Args& a, LAS unsigned char* lds, int n, int cch, int hp) {
    unsigned char* ws = a.ws;
    const bf16_t* Qb = (const bf16_t*)(ws + WS_H); const bf16_t* Kb = Qb + (size_t)M * D; const bf16_t* Vb = Kb + (size_t)M * D; bf16_t* Y = (bf16_t*)(ws + WS_Y);
    const int tid = threadIdx.x, wave = __builtin_amdgcn_readfirstlane(tid >> 6), lane = tid & 63, G4 = lane >> 4, c = lane & 15, hh = wave >> 2, w4 = wave & 3;
    LAS float* tabs = (LAS float*)(lds + AT_LDS_TAB);
    const int srow = tid >> 4, scc = tid & 15;
    const int t0 = (!SAMP && cch < 8) ? 8 - cch : 0;
    const size_t qrow0 = SAMP ? (size_t)MP + (size_t)n * 64 : (size_t)n * SEQ + (size_t)cch * 64;
    const int h = 2 * hp + hh;
    __syncthreads();
    for (int i = tid; i < 2 * 257; i += 512) { const int th = i / 257, ti = i - th * 257; tabs[th * 260 + ti] = a.in[18][(size_t)(2 * hp + th) * 257 + ti]; }
    bf16x8 Qf[4];
    { const bf16_t* qp = Qb + (qrow0 + 16 * w4 + c) * D + h * HD + 8 * G4;
#pragma unroll
      for (int kk = 0; kk < 4; ++kk) Qf[kk] = *(const bf16x8*)(qp + 32 * kk); }
    f32x4 st[8];
    auto load_tile = [&](int tau) {
#pragma unroll
        for (int p = 0; p < 8; ++p) { const int r = srow + 32 * p, kv = r >> 7, th = (r >> 6) & 1, key = r & 63; const int hd = 2 * hp + th;
            const size_t krow = SAMP ? (size_t)MP + (size_t)n * 64 + key : (size_t)n * SEQ + (size_t)(cch - 8 + tau) * 64 + key;
            const bf16_t* src = (kv ? Vb : Kb) + krow * D + hd * HD + 8 * scc; st[p] = __builtin_bit_cast(f32x4, *(const u32x4*)src); }
    };
    auto store_tile = [&]() {
#pragma unroll
        for (int p = 0; p < 8; ++p) { const int r = srow + 32 * p, kv = r >> 7, th = (r >> 6) & 1, key = r & 63;
            *(LAS u32x4*)(lds + (kv ? AT_LDS_V : AT_LDS_K) + th * AT_TILE + (key * AT_KS + 8 * scc) * 2) = __builtin_bit_cast(u32x4, st[p]); }
    };
    auto stage_f32 = [&](int tau) {
#pragma unroll
        for (int hf = 0; hf < 2; ++hf) {
#pragma unroll
            for (int p4 = 0; p4 < 4; ++p4) { const int p = 4 * hf + p4; const int r = srow + 32 * p, kv = r >> 7, th = (r >> 6) & 1, key = r & 63; const int hd = 2 * hp + th;
                const float* src = a.in[kv ? 5 : 4] + (((size_t)n * 512 + (size_t)tau * 64 + key) * NH + hd) * HD + 8 * scc;
                st[2 * p4] = *(const f32x4*)src; st[2 * p4 + 1] = *(const f32x4*)(src + 4); }
#pragma unroll
            for (int p4 = 0; p4 < 4; ++p4) { const int p = 4 * hf + p4; const int r = srow + 32 * p, kv = r >> 7, th = (r >> 6) & 1, key = r & 63;
                const f32x4 x0 = st[2 * p4], x1 = st[2 * p4 + 1]; u32x4 w; w.x = pk2(x0[0], x0[1]); w.y = pk2(x0[2], x0[3]); w.z = pk2(x1[0], x1[1]); w.w = pk2(x1[2], x1[3]);
                *(LAS u32x4*)(lds + (kv ? AT_LDS_V : AT_LDS_K) + th * AT_TILE + (key * AT_KS + 8 * scc) * 2) = w; } }
    };
    f32x4 O[8];
#pragma unroll
    for (int i = 0; i < 8; ++i) O[i] = (f32x4){0.f, 0.f, 0.f, 0.f};
    float mrun = -1e30f, lrun = 0.f;
    const int qi = 16 * w4 + c;
    if (SAMP) stage_f32(0); else { load_tile(t0); store_tile(); }
    __syncthreads();
    const float bconst = tabs[hh * 260 + 256];
    const LAS unsigned char* kbase = lds + AT_LDS_K + hh * AT_TILE + (c * AT_KS + 8 * G4) * 2;
    const LAS unsigned char* vbase = lds + AT_LDS_V + hh * AT_TILE + ((4 * G4 + (c >> 2)) * AT_KS + 4 * (c & 3)) * 2;
    for (int tau = t0; tau <= 8; ++tau) {
        if (SAMP ? tau == 7 : tau < 8) load_tile(tau + 1);
        f32x4 sa[4];
#pragma unroll
        for (int sub = 0; sub < 4; ++sub) { sa[sub] = (f32x4){0.f, 0.f, 0.f, 0.f};
#pragma unroll
            for (int kk = 0; kk < 4; ++kk) { const bf16x8 kf = *(const LAS bf16x8*)(kbase + (16 * sub * AT_KS + 32 * kk) * 2); sa[sub] = mfma_t(kf, Qf[kk], sa[sub]); } }
        MFMA_POST4(sa[0], sa[1], sa[2], sa[3]);
        float mloc = -1e30f;
#pragma unroll
        for (int sub = 0; sub < 4; ++sub)
#pragma unroll
            for (int i = 0; i < 4; ++i) { float bias = bconst;
                if (tau >= 6) { int rel = qi - ((tau - 8) * 64 + 16 * sub + 4 * G4 + i); rel = rel > 128 ? 128 : rel; bias = tabs[hh * 260 + rel + 128]; }
                const float sv = sa[sub][i] * 0.08838834764831845f + bias; sa[sub][i] = sv; mloc = fmaxf(mloc, sv); }
        mloc = fmaxf(mloc, __shfl_xor(mloc, 16)); mloc = fmaxf(mloc, __shfl_xor(mloc, 32));
        const float mnew = fmaxf(mrun, mloc), alpha = __expf(mrun - mnew); mrun = mnew;
        float ps = 0.f;
#pragma unroll
        for (int sub = 0; sub < 4; ++sub)
#pragma unroll
            for (int i = 0; i < 4; ++i) { const float p = __expf(sa[sub][i] - mnew); sa[sub][i] = p; ps += p; }
        lrun = lrun * alpha + ps;
        u32x4 pw[2];
#pragma unroll
        for (int s2 = 0; s2 < 2; ++s2) { pw[s2].x = pk2(sa[2 * s2][0], sa[2 * s2][1]); pw[s2].y = pk2(sa[2 * s2][2], sa[2 * s2][3]); pw[s2].z = pk2(sa[2 * s2 + 1][0], sa[2 * s2 + 1][1]); pw[s2].w = pk2(sa[2 * s2 + 1][2], sa[2 * s2 + 1][3]); }
#pragma unroll
        for (int i = 0; i < 8; ++i) O[i] = O[i] * alpha;
        asm volatile("s_nop 4" : "+v"(pw[0]), "+v"(pw[1]), "+v"(O[0]), "+v"(O[1]), "+v"(O[2]), "+v"(O[3]), "+v"(O[4]), "+v"(O[5]), "+v"(O[6]), "+v"(O[7]));
#pragma unroll
        for (int dt = 0; dt < 8; ++dt)
#pragma unroll
            for (int s2 = 0; s2 < 2; ++s2) {
                const s16x4 va = __builtin_amdgcn_ds_read_tr16_b64_v4i16((LAS s16x4*)(vbase + ((32 * s2) * AT_KS + 16 * dt) * 2));
                const s16x4 vb = __builtin_amdgcn_ds_read_tr16_b64_v4i16((LAS s16x4*)(vbase + ((32 * s2 + 16) * AT_KS + 16 * dt) * 2));
                const bf16x8 vf = __builtin_shufflevector(va, vb, 0, 1, 2, 3, 4, 5, 6, 7);
                O[dt] = mfma_t(vf, __builtin_bit_cast(bf16x8, pw[s2]), O[dt]); }
        MFMA_POST8(O[0], O[1], O[2], O[3], O[4], O[5], O[6], O[7]);
        if (tau < 8) { __syncthreads(); if (SAMP && tau < 7) stage_f32(tau + 1); else store_tile(); __syncthreads(); }
    }
    float lt = lrun; lt += __shfl_xor(lt, 16); lt += __shfl_xor(lt, 32);
    const float inv = 1.0f / lt;
    bf16_t* yp = Y + (qrow0 + 16 * w4 + c) * D + h * HD + 4 * G4;
#pragma unroll
    for (int dt = 0; dt < 8; ++dt) { u32x2 w; w.x = pk2(O[dt][0] * inv, O[dt][1] * inv); w.y = pk2(O[dt][2] * inv, O[dt][3] * inv); *(u32x2*)(yp + 16 * dt) = w; }
}
__device__ __forceinline__ void ph_attn(const Args& a, LAS unsigned char* lds, int nblk, int b) {
    for (int u = b; u < 1280; u += nblk) {
        if (u < 1024) attn_unit<false>(a, lds, u >> 8, (u >> 3) & 31, u & 7);
        else { const int u2 = u - 1024; attn_unit<true>(a, lds, u2 >> 3, 8, u2 & 7); }
    }
}
__global__ void __launch_bounds__(512, 2) k_attn2(Args a) {
    extern __shared__ __attribute__((aligned(16))) unsigned char lds_raw[];
    ph_attn(a, (LAS unsigned char*)lds_raw, gridDim.x, blockIdx.x);
}


constexpr int HG_S = 136;
constexpr int HG_T64 = 64 * HG_S * 2;
constexpr int HGZ_QT = 0, HGZ_KT = HG_T64, HGZ_QH = 2 * HG_T64, HGZ_IS = 3 * HG_T64, HGZ_SS = 4 * HG_T64, HGZ_PART = HGZ_SS + 128 * HG_S * 2, HGZ_RED = HGZ_PART + 4096, HGZ_BYTES = HGZ_RED + 512;
constexpr int HGX_KH = 0, HGX_IS = HG_T64, HGX_PART = 2 * HG_T64, HGX_DK = HGX_PART + 4096, HGX_BYTES = HGX_DK + 512;
constexpr size_t SCR_DS = 0;
constexpr size_t SCR_DK = SCR_DS + (size_t)2048 * 16384 * 4;
constexpr size_t SCR_SP = SCR_DK + (size_t)2048 * 128 * 4;
static_assert(SCR_SP + (size_t)2048 * 16384 * 2 <= 252 * MiB, "hgrn scratch");
struct HgPrep { float f[8][2]; float b[8][2]; float r[2]; float b63[2]; };
__device__ __forceinline__ void hg_prep(const float* Fp, LAS float* part, int kp, int tq, HgPrep& P) {
#pragma unroll
    for (int j = 0; j < 8; ++j) { const f32x2 v = *(const f32x2*)(Fp + (size_t)(8 * tq + j) * D + 2 * kp); P.f[j][0] = v[0]; P.f[j][1] = v[1]; }
    float c0 = 0.f, c1 = 0.f;
#pragma unroll
    for (int j = 0; j < 8; ++j) { c0 += __logf(P.f[j][0]); c1 += __logf(P.f[j][1]); P.b[j][0] = c0; P.b[j][1] = c1; }
    *(LAS f32x2*)(part + tq * 128 + 2 * kp) = (f32x2){c0, c1};
    __syncthreads();
    float base0 = 0.f, base1 = 0.f, r0 = 0.f, r1 = 0.f, t0 = 0.f, t1 = 0.f;
#pragma unroll
    for (int q = 0; q < 8; ++q) { const f32x2 p = *(const LAS f32x2*)(part + q * 128 + 2 * kp); if (q < tq) { base0 += p[0]; base1 += p[1]; } if (q < 4) { r0 += p[0]; r1 += p[1]; } t0 += p[0]; t1 += p[1]; }
#pragma unroll
    for (int j = 0; j < 8; ++j) { P.b[j][0] += base0; P.b[j][1] += base1; }
    P.r[0] = r0; P.r[1] = r1; P.b63[0] = t0; P.b63[1] = t1;
}
__device__ __forceinline__ bf16x8 tr2(const LAS unsigned char* p0, const LAS unsigned char* p1) {
    const s16x4 va = __builtin_amdgcn_ds_read_tr16_b64_v4i16((LAS s16x4*)p0), vb = __builtin_amdgcn_ds_read_tr16_b64_v4i16((LAS s16x4*)p1);
    return __builtin_shufflevector(va, vb, 0, 1, 2, 3, 4, 5, 6, 7);
}
__device__ __forceinline__ void hg_decode(int u, bool& samp, int& n, int& h, int& ch, size_t& row0) {
    if (u < 2048) { samp = false; ch = u & 31; h = (u >> 5) & 15; n = u >> 9; row0 = (size_t)n * SEQ + (size_t)ch * 64; }
    else { samp = true; const int u2 = u - 2048; h = u2 & 15; n = u2 >> 4; ch = 0; row0 = (size_t)MP + (size_t)n * 64; }
}
__device__ __forceinline__ void ph_hgrn_x(const Args& a, LAS unsigned char* lds, int nblk, int b) {
    unsigned char* ws = a.ws; const bf16_t* Ib = (const bf16_t*)(ws + WS_H) + (size_t)M * D; const float* F = (const float*)(ws + WS_Z);
    const int tid = threadIdx.x, wave = __builtin_amdgcn_readfirstlane(tid >> 6), lane = tid & 63, G4 = lane >> 4, c = lane & 15, kp = tid & 63, tq = tid >> 6;
    LAS float* part = (LAS float*)(lds + HGX_PART); LAS float* dk = (LAS float*)(lds + HGX_DK);
    for (int u = b; u < 2560; u += nblk) {
        bool samp; int n, h, ch; size_t row0; hg_decode(u, samp, n, h, ch, row0);
        __syncthreads();
        HgPrep P; hg_prep(F + row0 * D + h * 128, part, kp, tq, P);
#pragma unroll
        for (int j = 0; j < 8; ++j) { const float k0 = (1.0f - P.f[j][0]) * __expf(P.b63[0] - P.b[j][0]), k1 = (1.0f - P.f[j][1]) * __expf(P.b63[1] - P.b[j][1]);
            *(LAS unsigned*)(lds + HGX_KH + ((8 * tq + j) * HG_S + 2 * kp) * 2) = pk2(k0, k1); }
        if (tq == 0) { const float d0 = __expf(P.b63[0]), d1 = __expf(P.b63[1]); *(LAS f32x2*)(dk + 2 * kp) = (f32x2){d0, d1};
            if (!samp) *(f32x2*)((float*)(ws + WS_SCR + SCR_DK) + (size_t)u * 128 + 2 * kp) = (f32x2){d0, d1}; }
        { const int r = tid >> 3, cq = tid & 7; const u32x4* src = (const u32x4*)(Ib + (row0 + r) * D + h * 128 + 16 * cq); const u32x4 v0 = src[0], v1 = src[1];
          LAS u32x4* dst = (LAS u32x4*)(lds + HGX_IS + (r * HG_S + 16 * cq) * 2); dst[0] = v0; dst[1] = v1; }
        __syncthreads();
        const int mk = wave;
        const LAS unsigned char* ka = lds + HGX_KH + ((8 * G4 + (c >> 2)) * HG_S + 16 * mk + 4 * (c & 3)) * 2;
        const LAS unsigned char* ia = lds + HGX_IS + ((8 * G4 + (c >> 2)) * HG_S + 4 * (c & 3)) * 2;
        bf16x8 af[2];
#pragma unroll
        for (int kt = 0; kt < 2; ++kt) af[kt] = tr2(ka + (32 * kt) * HG_S * 2, ka + (32 * kt + 4) * HG_S * 2);
        float dkv[4];
#pragma unroll
        for (int i = 0; i < 4; ++i) dkv[i] = dk[16 * mk + 4 * G4 + i];
#pragma unroll
        for (int nv = 0; nv < 8; ++nv) { f32x4 acc = (f32x4){0.f, 0.f, 0.f, 0.f};
#pragma unroll
            for (int kt = 0; kt < 2; ++kt) { const bf16x8 bfr = tr2(ia + ((32 * kt) * HG_S + 16 * nv) * 2, ia + ((32 * kt + 4) * HG_S + 16 * nv) * 2); acc = mfma_t(af[kt], bfr, acc); }
            if (!samp) { float* dst = (float*)(ws + WS_SCR + SCR_DS) + (size_t)u * 16384 + (size_t)(16 * mk + 4 * G4) * 128 + 16 * nv + c;
#pragma unroll
                for (int i = 0; i < 4; ++i) dst[i * 128] = acc[i]; }
            else { const size_t so = (((size_t)n * NH + h) * 128 + 16 * mk + 4 * G4) * 128 + 16 * nv + c;
#pragma unroll
                for (int i = 0; i < 4; ++i) a.out[O_HS + so + i * 128] = dkv[i] * a.in[6][so + i * 128] + acc[i]; } }
    }
}
__device__ __forceinline__ void ph_hgrn_y(const Args& a, int nblk, int b) {
    unsigned char* ws = a.ws; const float* DS = (const float*)(ws + WS_SCR + SCR_DS); const float* DK = (const float*)(ws + WS_SCR + SCR_DK); bf16_t* SP = (bf16_t*)(ws + WS_SCR + SCR_SP);
    const int nth = nblk * 512;
    for (int e4 = b * 512 + threadIdx.x; e4 < 64 * 4096; e4 += nth) {
        const int pr = e4 >> 12, off = (e4 & 4095) * 4, k = off >> 7;
        f32x4 S = (f32x4){0.f, 0.f, 0.f, 0.f};
        for (int ch = 0; ch < 32; ++ch) { const size_t u = (size_t)pr * 32 + ch;
            u32x2 w; w.x = pk2(S[0], S[1]); w.y = pk2(S[2], S[3]); *(u32x2*)(SP + u * 16384 + off) = w;
            const f32x4 d = *(const f32x4*)(DS + u * 16384 + off); const float dk = DK[u * 128 + k]; S = S * dk + d; }
        *(f32x4*)(a.out + O_HP + (size_t)pr * 16384 + off) = S;
    }
}
__device__ __forceinline__ void ph_hgrn_z(const Args& a, LAS unsigned char* lds, int nblk, int b) {
    unsigned char* ws = a.ws; const bf16_t* Qb = (const bf16_t*)(ws + WS_H); const bf16_t* Ib = Qb + (size_t)M * D; const bf16_t* Gb = Ib + (size_t)M * D; const float* F = (const float*)(ws + WS_Z);
    bf16_t* Y = (bf16_t*)(ws + WS_Y); const bf16_t* SP = (const bf16_t*)(ws + WS_SCR + SCR_SP);
    const int tid = threadIdx.x, wave = __builtin_amdgcn_readfirstlane(tid >> 6), lane = tid & 63, G4 = lane >> 4, c = lane & 15, kp = tid & 63, tq = tid >> 6;
    LAS float* part = (LAS float*)(lds + HGZ_PART); LAS float* red = (LAS float*)(lds + HGZ_RED);
    const int mt = wave & 3, nvh = wave >> 2;
    for (int u = b; u < 2560; u += nblk) {
        bool samp; int n, h, ch; size_t row0; hg_decode(u, samp, n, h, ch, row0);
        __syncthreads();
        HgPrep P; hg_prep(F + row0 * D + h * 128, part, kp, tq, P);
#pragma unroll
        for (int j = 0; j < 8; ++j) { const int t = 8 * tq + j; const unsigned qw = *(const unsigned*)(Qb + (row0 + t) * D + h * 128 + 2 * kp);
            const float q0 = __builtin_bit_cast(float, qw << 16), q1 = __builtin_bit_cast(float, qw & 0xffff0000u);
            const float e0 = __expf(P.b[j][0] - P.r[0]), e1 = __expf(P.b[j][1] - P.r[1]);
            *(LAS unsigned*)(lds + HGZ_QT + (t * HG_S + 2 * kp) * 2) = pk2(q0 * e0, q1 * e1);
            *(LAS unsigned*)(lds + HGZ_KT + (t * HG_S + 2 * kp) * 2) = pk2((1.0f - P.f[j][0]) * __expf(P.r[0] - P.b[j][0]), (1.0f - P.f[j][1]) * __expf(P.r[1] - P.b[j][1]));
            *(LAS unsigned*)(lds + HGZ_QH + (t * HG_S + 2 * kp) * 2) = pk2(q0 * __expf(P.b[j][0]), q1 * __expf(P.b[j][1])); }
        { const int r = tid >> 3, cq = tid & 7; const u32x4* src = (const u32x4*)(Ib + (row0 + r) * D + h * 128 + 16 * cq); const u32x4 v0 = src[0], v1 = src[1];
          LAS u32x4* dst = (LAS u32x4*)(lds + HGZ_IS + (r * HG_S + 16 * cq) * 2); dst[0] = v0; dst[1] = v1; }
        { const int r = tid >> 2, cq = tid & 3; LAS u32x4* dst = (LAS u32x4*)(lds + HGZ_SS + (r * HG_S + 32 * cq) * 2);
          if (!samp) { const u32x4* src = (const u32x4*)(SP + (size_t)u * 16384 + r * 128 + 32 * cq);
#pragma unroll
              for (int i = 0; i < 4; ++i) dst[i] = src[i]; }
          else { const f32x4* src = (const f32x4*)(a.in[6] + (((size_t)n * NH + h) * 128 + r) * 128 + 32 * cq);
#pragma unroll
              for (int i = 0; i < 4; ++i) { const f32x4 x0 = src[2 * i], x1 = src[2 * i + 1]; u32x4 w; w.x = pk2(x0[0], x0[1]); w.y = pk2(x0[2], x0[3]); w.z = pk2(x1[0], x1[1]); w.w = pk2(x1[2], x1[3]); dst[i] = w; } } }
        __syncthreads();
        bf16x8 Qf[4];
#pragma unroll
        for (int kk = 0; kk < 4; ++kk) Qf[kk] = *(const LAS bf16x8*)(lds + HGZ_QT + ((16 * mt + c) * HG_S + 32 * kk + 8 * G4) * 2);
        f32x4 At[4];
#pragma unroll
        for (int ns = 0; ns < 4; ++ns) { At[ns] = (f32x4){0.f, 0.f, 0.f, 0.f};
            if (ns <= mt) {
#pragma unroll
                for (int kk = 0; kk < 4; ++kk) { const bf16x8 kf = *(const LAS bf16x8*)(lds + HGZ_KT + ((16 * ns + c) * HG_S + 32 * kk + 8 * G4) * 2); At[ns] = mfma_t(kf, Qf[kk], At[ns]); }
                if (ns == mt) {
#pragma unroll
                    for (int i = 0; i < 4; ++i) if (4 * G4 + i > c) At[ns][i] = 0.f; } } }
        f32x4 o[4];
#pragma unroll
        for (int j = 0; j < 4; ++j) o[j] = (f32x4){0.f, 0.f, 0.f, 0.f};
        const LAS unsigned char* ia = lds + HGZ_IS + ((4 * G4 + (c >> 2)) * HG_S + 64 * nvh + 4 * (c & 3)) * 2;
#pragma unroll
        for (int ks = 0; ks < 2; ++ks) if (2 * ks <= mt) {
            u32x4 pw; pw.x = pk2(At[2 * ks][0], At[2 * ks][1]); pw.y = pk2(At[2 * ks][2], At[2 * ks][3]); pw.z = pk2(At[2 * ks + 1][0], At[2 * ks + 1][1]); pw.w = pk2(At[2 * ks + 1][2], At[2 * ks + 1][3]);
#pragma unroll
            for (int j = 0; j < 4; ++j) { const bf16x8 vf = tr2(ia + ((32 * ks) * HG_S + 16 * j) * 2, ia + ((32 * ks + 16) * HG_S + 16 * j) * 2); o[j] = mfma_t(vf, __builtin_bit_cast(bf16x8, pw), o[j]); } }
        const LAS unsigned char* sa = lds + HGZ_SS + ((8 * G4 + (c >> 2)) * HG_S + 64 * nvh + 4 * (c & 3)) * 2;
#pragma unroll
        for (int kk = 0; kk < 4; ++kk) { const bf16x8 qh = *(const LAS bf16x8*)(lds + HGZ_QH + ((16 * mt + c) * HG_S + 32 * kk + 8 * G4) * 2);
#pragma unroll
            for (int j = 0; j < 4; ++j) { const bf16x8 sf = tr2(sa + ((32 * kk) * HG_S + 16 * j) * 2, sa + ((32 * kk + 4) * HG_S + 16 * j) * 2); o[j] = mfma_t(sf, qh, o[j]); } }
        float ss = 0.f;
#pragma unroll
        for (int j = 0; j < 4; ++j)
#pragma unroll
            for (int i = 0; i < 4; ++i) ss += o[j][i] * o[j][i];
        ss += __shfl_xor(ss, 16); ss += __shfl_xor(ss, 32);
        if (G4 == 0) red[nvh * 64 + 16 * mt + c] = ss;
        __syncthreads();
        const float tot = red[16 * mt + c] + red[64 + 16 * mt + c]; const float sc = 1.0f / sqrtf(tot * (1.0f / 128.0f) + RMS_EPS);
        const size_t yo = (row0 + 16 * mt + c) * D + h * 128 + 64 * nvh + 4 * G4;
#pragma unroll
        for (int j = 0; j < 4; ++j) { const u32x2 gw = *(const u32x2*)(Gb + yo + 16 * j); const f32x4 ng = *(const f32x4*)(a.in[22] + 64 * nvh + 16 * j + 4 * G4);
            const float g0 = __builtin_bit_cast(float, gw.x << 16), g1 = __builtin_bit_cast(float, gw.x & 0xffff0000u), g2 = __builtin_bit_cast(float, gw.y << 16), g3 = __builtin_bit_cast(float, gw.y & 0xffff0000u);
            u32x2 w; w.x = pk2(o[j][0] * sc * ng[0] * g0 * sigmoidf_(g0), o[j][1] * sc * ng[1] * g1 * sigmoidf_(g1)); w.y = pk2(o[j][2] * sc * ng[2] * g2 * sigmoidf_(g2), o[j][3] * sc * ng[3] * g3 * sigmoidf_(g3));
            *(u32x2*)(Y + yo + 16 * j) = w; }
    }
}
template <int WHICH> __global__ void __launch_bounds__(512, 2) k_hgrn2(Args a) {
    extern __shared__ __attribute__((aligned(16))) unsigned char lds_raw[];
    if constexpr (WHICH == 0) ph_hgrn_x(a, (LAS unsigned char*)lds_raw, gridDim.x, blockIdx.x);
    else if constexpr (WHICH == 1) ph_hgrn_y(a, gridDim.x, blockIdx.x);
    else ph_hgrn_z(a, (LAS unsigned char*)lds_raw, gridDim.x, blockIdx.x);
}

__global__ void __launch_bounds__(64) k_ssm_naive(Args a) {
    __shared__ float hre[64], him[64];
    unsigned char* ws = a.ws; const int j = a.a1, L = a.layer; const int p = threadIdx.x;
    const float* X = (const float*)(ws + WS_X);
    const int item = blockIdx.x; int n, g, T; const float* xbase; size_t rowbase; bool samp;
    if (item < NB * NG) { samp = false; n = item / NG; g = item % NG; T = SEQ; rowbase = (size_t)n * SEQ; xbase = (L == 0 ? a.in[0] : X) + rowbase * D; }
    else { samp = true; const int it = item - NB * NG; n = it / NG; g = it % NG; T = DSEQ; rowbase = (size_t)MP + (size_t)n * DSEQ; xbase = (L == 0 ? a.in[1] + (size_t)n * DSEQ * D : X + rowbase * D); }
    const float* ab = (const float*)(ws + WS_PAR + PAR_ABAR) + ((size_t)(j * NG + g) * NP + p) * 2; const float ar = ab[0], ai = ab[1];
    const float* bb = (const float*)(ws + WS_PAR + PAR_BBAR) + ((size_t)(j * NG + g) * NP + p) * NQ * 2;
    float br[NQ], bi[NQ];
#pragma unroll
    for (int q = 0; q < NQ; ++q) { br[q] = bb[2 * q]; bi[q] = bb[2 * q + 1]; }
    const int q_ = p & 15, part = p >> 4; float cr[16], ci[16];
    const float* cre = a.in[12] + ((size_t)(j * NG + g) * NQ + q_) * NP + part * 16; const float* cim = a.in[13] + ((size_t)(j * NG + g) * NQ + q_) * NP + part * 16;
#pragma unroll
    for (int i = 0; i < 16; ++i) { cr[i] = cre[i]; ci[i] = cim[i]; }
    const float dsk = a.in[14][(size_t)j * D + g * NQ + q_];
    float hr = 0.f, hi = 0.f;
    if (samp) { hr = a.in[2][((size_t)(j * DB + n) * NG + g) * NP + p]; hi = a.in[3][((size_t)(j * DB + n) * NG + g) * NP + p]; }
    bf16_t* Y = (bf16_t*)(ws + WS_Y);
    for (int t = 0; t < T; ++t) {
        const float* ur = xbase + (size_t)t * D + g * NQ; float sr = 0.f, si = 0.f;
#pragma unroll
        for (int q = 0; q < NQ; ++q) { const float u = ur[q]; sr += br[q] * u; si += bi[q] * u; }
        const float nr = ar * hr - ai * hi + sr, ni = ar * hi + ai * hr + si; hr = nr; hi = ni;
        __syncthreads(); hre[p] = hr; him[p] = hi; __syncthreads();
        float y = 0.f;
#pragma unroll
        for (int i = 0; i < 16; ++i) y += cr[i] * hre[part * 16 + i] - ci[i] * him[part * 16 + i];
        y += __shfl_xor(y, 16); y += __shfl_xor(y, 32);
        if (part == 0) { y += dsk * ur[q_]; Y[(rowbase + t) * D + g * NQ + q_] = (bf16_t)f2bf(gelu_tanh(y)); }
    }
    float* ore = a.out + (samp ? O_SRS : O_SRP) + ((size_t)(j * (samp ? DB : NB) + n) * NG + g) * NP + p;
    float* oim = a.out + (samp ? O_SIS : O_SIP) + ((size_t)(j * (samp ? DB : NB) + n) * NG + g) * NP + p;
    *ore = hr; *oim = hi;
}

__global__ void __launch_bounds__(64) k_attn_naive(Args a) {
    unsigned char* ws = a.ws; const bf16_t* Qb = (const bf16_t*)(ws + WS_H); const bf16_t* Kb = Qb + (size_t)M * D; const bf16_t* Vb = Kb + (size_t)M * D; bf16_t* Y = (bf16_t*)(ws + WS_Y);
    const int unit = blockIdx.x; const int i = threadIdx.x; int n, c, h; bool samp; size_t qrow;
    if (unit < NB * 32 * NH) { samp = false; n = unit / (32 * NH); c = (unit / NH) % 32; h = unit % NH; qrow = (size_t)n * SEQ + c * 64 + i; }
    else { samp = true; const int u2 = unit - NB * 32 * NH; n = u2 / NH; h = u2 % NH; c = 8; qrow = (size_t)MP + n * DSEQ + i; }
    float q[HD], o[HD];
#pragma unroll
    for (int d = 0; d < HD; ++d) { q[d] = bf2f(Qb[qrow * D + h * HD + d]) * 0.08838834764831845f; o[d] = 0.f; }
    const float* tab = a.in[18] + (size_t)h * 257;
    float mx = -1e30f, l = 0.f;
    const int t0 = samp ? 0 : (c >= 8 ? 0 : 8 - c);
    for (int tau = t0; tau <= 8; ++tau) {
        for (int kk = 0; kk < 64; ++kk) {
            float s = 0.f;
            int rel = i - ((tau - 8) * 64 + kk); rel = rel > 128 ? 128 : (rel < -128 ? -128 : rel);
            const float bias = tab[rel + 128];
            if (samp && tau < 8) {
                const float* kr = a.in[4] + (((size_t)n * 512 + tau * 64 + kk) * NH + h) * HD; const float* vr = a.in[5] + (((size_t)n * 512 + tau * 64 + kk) * NH + h) * HD;
#pragma unroll
                for (int d = 0; d < HD; ++d) s += q[d] * kr[d];
                s += bias; const float mn = fmaxf(mx, s), sc = __expf(mx - mn), pw = __expf(s - mn); l = l * sc + pw; mx = mn;
#pragma unroll
                for (int d = 0; d < HD; ++d) o[d] = o[d] * sc + pw * vr[d];
            } else {
                const size_t krow = samp ? (size_t)MP + n * DSEQ + kk : (size_t)n * SEQ + (size_t)(c - 8 + tau) * 64 + kk;
                const bf16_t* kr = Kb + krow * D + h * HD; const bf16_t* vr = Vb + krow * D + h * HD;
#pragma unroll
                for (int d = 0; d < HD; ++d) s += q[d] * bf2f(kr[d]);
                s += bias; const float mn = fmaxf(mx, s), sc = __expf(mx - mn), pw = __expf(s - mn); l = l * sc + pw; mx = mn;
#pragma unroll
                for (int d = 0; d < HD; ++d) o[d] = o[d] * sc + pw * bf2f(vr[d]);
            }
        }
    }
    const float inv = 1.f / l;
#pragma unroll
    for (int d = 0; d < HD; ++d) Y[qrow * D + h * HD + d] = (bf16_t)f2bf(o[d] * inv);
}

__global__ void __launch_bounds__(128) k_hgrn_naive(Args a) {
    __shared__ float fs[128], qs[128], red[2];
    unsigned char* ws = a.ws; const bf16_t* Qb = (const bf16_t*)(ws + WS_H); const bf16_t* Ib = Qb + (size_t)M * D; const bf16_t* Gb = Ib + (size_t)M * D; const float* F = (const float*)(ws + WS_Z);
    bf16_t* Y = (bf16_t*)(ws + WS_Y);
    const int unit = blockIdx.x, v = threadIdx.x; int n, h, T; bool samp; size_t rowbase;
    if (unit < NB * NH) { samp = false; n = unit / NH; h = unit % NH; T = SEQ; rowbase = (size_t)n * SEQ; }
    else { samp = true; const int u2 = unit - NB * NH; n = u2 / NH; h = u2 % NH; T = DSEQ; rowbase = (size_t)MP + n * DSEQ; }
    float S[128];
#pragma unroll
    for (int k = 0; k < 128; ++k) S[k] = samp ? a.in[6][(((size_t)n * NH + h) * 128 + k) * 128 + v] : 0.f;
    const float ng = a.in[22][v];
    for (int t = 0; t < T; ++t) {
        const size_t ro = (rowbase + t) * D + h * 128;
        __syncthreads(); fs[v] = F[ro + v]; qs[v] = bf2f(Qb[ro + v]); __syncthreads();
        const float iv = bf2f(Ib[ro + v]); float o = 0.f;
#pragma unroll
        for (int k = 0; k < 128; ++k) { const float f = fs[k]; S[k] = f * S[k] + (1.0f - f) * iv; o += qs[k] * S[k]; }
        const float ss = wave_sum(o * o); if ((v & 63) == 0) red[v >> 6] = ss; __syncthreads();
        const float ms = (red[0] + red[1]) * (1.f / 128.f);
        const float gv = bf2f(Gb[ro + v]);
        Y[ro + v] = (bf16_t)f2bf(o * (1.0f / sqrtf(ms + RMS_EPS)) * ng * gv * sigmoidf_(gv));
    }
    float* so = a.out + (samp ? O_HS : O_HP) + (((size_t)n * NH + h) * 128) * 128 + v;
#pragma unroll
    for (int k = 0; k < 128; ++k) so[(size_t)k * 128] = S[k];
}

template <int W> static void launch_gemm(const Args& a, hipStream_t st) {
    static bool attr = false; if (!attr) { (void)hipFuncSetAttribute((const void*)k_gemm<W>, hipFuncAttributeMaxDynamicSharedMemorySize, pg8::STAGE_BYTES); attr = true; }
    hipLaunchKernelGGL((k_gemm<W>), dim3(256), dim3(512), pg8::STAGE_BYTES, st, a);
}
extern "C" void kernel_launch(void* const* d_in, const int* in_sizes, int n_in, void* d_out, int out_size, void* d_ws, size_t ws_size, hipStream_t stream) {
    if (n_in != 30 || (size_t)out_size != O_END || ws_size < WS_END) { fprintf(stderr, "kernel_launch: unexpected shapes (n_in %d out %d ws %zu, need %zu)\n", n_in, out_size, ws_size, (size_t)WS_END); return; }
    Args a{}; for (int i = 0; i < 30; ++i) a.in[i] = (const float*)d_in[i]; a.out = (float*)d_out; a.ws = (unsigned char*)d_ws;
    unsigned char* ws = (unsigned char*)d_ws;
    auto conv = [&](const float* W, bf16_t* WT, int K, int N, int mode) { hipLaunchKernelGGL(k_convert_w, dim3((K / 32) * (N / 32)), dim3(256), 0, stream, W, WT, K, N, mode); };
    for (int j = 0; j < 2; ++j) { bf16_t* wt = (bf16_t*)(ws + WS_WSSM) + (size_t)j * 4096 * D; conv(a.in[15] + (size_t)j * D * D, wt, D, D, 1); conv(a.in[16] + (size_t)j * D * D, wt, D, D, 2); }
    conv(a.in[17], (bf16_t*)(ws + WS_WQKV), D, 3 * D, 0); conv(a.in[19], (bf16_t*)(ws + WS_WAO), D, D, 0);
    conv(a.in[20], (bf16_t*)(ws + WS_WHIN), D, 4 * D, 0); conv(a.in[23], (bf16_t*)(ws + WS_WHO), D, D, 0);
    for (int l = 0; l < 4; ++l) { conv(a.in[28] + (size_t)l * D * FF, (bf16_t*)(ws + WS_WF1) + (size_t)l * FF * D, D, FF, 0); conv(a.in[29] + (size_t)l * FF * D, (bf16_t*)(ws + WS_WF2) + (size_t)l * D * FF, FF, D, 0); }
    hipLaunchKernelGGL(k_params, dim3(64), dim3(256), 0, stream, a);
    hipLaunchKernelGGL(k_params2, dim3((2 * NG * 8 * 64 + 2 * NG * 4 * 64) / 256), dim3(256), 0, stream, a);
    for (int L = 0; L < 4; ++L) {
        a.layer = L; const int kind = L % 3, j = L / 3;
        if (kind == 0) { a.a1 = j; { static bool at = false; if (!at) { (void)hipFuncSetAttribute((const void*)k_ssm2, hipFuncAttributeMaxDynamicSharedMemorySize, 8 * SSM_WLDS); at = true; } }
            hipLaunchKernelGGL(k_ssm2, dim3(256), dim3(512), 8 * SSM_WLDS, stream, a); launch_gemm<0>(a, stream); }
        else if (kind == 1) { launch_gemm<1>(a, stream); { static bool at = false; if (!at) { (void)hipFuncSetAttribute((const void*)k_attn2, hipFuncAttributeMaxDynamicSharedMemorySize, AT_LDS_BYTES); at = true; } }
            hipLaunchKernelGGL(k_attn2, dim3(256), dim3(512), AT_LDS_BYTES, stream, a); launch_gemm<2>(a, stream); }
        else { launch_gemm<3>(a, stream); { static bool at = false; if (!at) { (void)hipFuncSetAttribute((const void*)k_hgrn2<0>, hipFuncAttributeMaxDynamicSharedMemorySize, HGZ_BYTES); (void)hipFuncSetAttribute((const void*)k_hgrn2<2>, hipFuncAttributeMaxDynamicSharedMemorySize, HGZ_BYTES); at = true; } }
            hipLaunchKernelGGL(k_hgrn2<0>, dim3(256), dim3(512), HGX_BYTES, stream, a); hipLaunchKernelGGL(k_hgrn2<1>, dim3(256), dim3(512), 0, stream, a); hipLaunchKernelGGL(k_hgrn2<2>, dim3(256), dim3(512), HGZ_BYTES, stream, a); launch_gemm<4>(a, stream); }
        a.a1 = 0; a.a2 = 0; hipLaunchKernelGGL(k_ln, dim3(1024), dim3(256), 0, stream, a);
        launch_gemm<5>(a, stream); launch_gemm<6>(a, stream);
        a.a1 = 1; a.a2 = (L == 3) ? 1 : 0; hipLaunchKernelGGL(k_ln, dim3(1024), dim3(256), 0, stream, a);
    }
}
```

```cpp
#include <hip/hip_runtime.h>
#include <cstdio>
#include <cstdint>

#define LAS __attribute__((address_space(3)))
typedef unsigned short bf16_t;
typedef short bf16x8 __attribute__((ext_vector_type(8)));
typedef float f32x4 __attribute__((ext_vector_type(4)));
typedef float f32x2 __attribute__((ext_vector_type(2)));
typedef unsigned u32x4 __attribute__((ext_vector_type(4)));
typedef unsigned u32x2 __attribute__((ext_vector_type(2)));

constexpr int D = 2048, SEQ = 2048, NB = 4, DB = 32, DSEQ = 64, FF = 8192;
constexpr int MP = NB * SEQ, MS = DB * DSEQ, M = MP + MS;
constexpr int NG = 128, NP = 64, NQ = 16;
constexpr int NH = 16, HD = 128;
constexpr float ALPHA = 1.6817928305074290f;
constexpr float LN_EPS = 1e-5f, RMS_EPS = 1e-6f;
constexpr size_t O_YP = 0, O_YS = O_YP + (size_t)MP * D, O_SRP = O_YS + (size_t)MS * D, O_SIP = O_SRP + 2 * NB * NG * NP,
                 O_KP = O_SIP + 2 * NB * NG * NP, O_VP = O_KP + (size_t)NB * 512 * D, O_HP = O_VP + (size_t)NB * 512 * D,
                 O_SRS = O_HP + (size_t)NB * NH * 128 * 128, O_SIS = O_SRS + 2 * DB * NG * NP, O_KS = O_SIS + 2 * DB * NG * NP,
                 O_VS = O_KS + (size_t)MS * D, O_HS = O_VS + (size_t)MS * D, O_END = O_HS + (size_t)DB * NH * 128 * 128;

constexpr size_t MiB = 1u << 20;
constexpr size_t WS_CTL = 0;
constexpr size_t WS_WSSM = 1 * MiB;
constexpr size_t WS_WQKV = WS_WSSM + 32 * MiB;
constexpr size_t WS_WAO = WS_WQKV + 24 * MiB;
constexpr size_t WS_WHIN = WS_WAO + 8 * MiB;
constexpr size_t WS_WHO = WS_WHIN + 32 * MiB;
constexpr size_t WS_WF1 = WS_WHO + 8 * MiB;
constexpr size_t WS_WF2 = WS_WF1 + 128 * MiB;
constexpr size_t WS_X = WS_WF2 + 128 * MiB;
constexpr size_t WS_XB = WS_X + 80 * MiB;
constexpr size_t WS_Z = WS_XB + 40 * MiB;
constexpr size_t WS_H = WS_Z + 80 * MiB;
constexpr size_t WS_Y = WS_H + 160 * MiB;
constexpr size_t WS_PAR = WS_Y + 40 * MiB;
constexpr size_t WS_SCR = WS_PAR + 8 * MiB;
constexpr size_t WS_END = WS_SCR + 252 * MiB;
constexpr size_t SCR_PART = 200 * MiB;
constexpr size_t PAR_ABAR = 0;
constexpr size_t PAR_BBAR = PAR_ABAR + 2 * NG * NP * 2 * 4;
constexpr size_t PAR_LB = PAR_BBAR + (size_t)2 * NG * NP * NQ * 2 * 4;
constexpr size_t PAR_BFRAG = PAR_LB + D * 4;
constexpr size_t PAR_CFRAG = PAR_BFRAG + (size_t)2 * NG * 8 * 64 * 16;
constexpr size_t PAR_END = PAR_CFRAG + (size_t)2 * NG * 4 * 64 * 16;
static_assert(PAR_END <= 8 * MiB, "params region");

__device__ __forceinline__ unsigned f2bf(float f) { unsigned u = __builtin_bit_cast(unsigned, f); return (u + 0x7fffu + ((u >> 16) & 1u)) >> 16; }
typedef __bf16 bf16x2_t __attribute__((ext_vector_type(2)));
__device__ __forceinline__ unsigned pk2(float lo, float hi) { const f32x2 v = {lo, hi}; return __builtin_bit_cast(unsigned, __builtin_convertvector(v, bf16x2_t)); }
typedef _Float16 f16x2_t __attribute__((ext_vector_type(2)));
__device__ __forceinline__ unsigned pkh2(float lo, float hi) { const f32x2 v = {lo, hi}; return __builtin_bit_cast(unsigned, __builtin_convertvector(v, f16x2_t)); }
__device__ __forceinline__ f32x2 uph2(unsigned w) { return __builtin_convertvector(__builtin_bit_cast(f16x2_t, w), f32x2); }
__device__ __forceinline__ float bf2f(bf16_t b) { return __builtin_bit_cast(float, (unsigned)b << 16); }
__device__ __forceinline__ float sigmoidf_(float x) { return 1.0f / (1.0f + __expf(-x)); }
__device__ __forceinline__ float gelu_tanh(float x) { const float t = 1.5957691216057308f * (x + 0.044715f * x * x * x); return x / (1.0f + __expf(-t)); }

__device__ __forceinline__ int tid_fresh() { int t = threadIdx.x; asm volatile("" : "+v"(t)); return t; }
namespace pg8 {
constexpr int BM = 256, BK = 64, HALF = 128, HTB = HALF * BK * 2, STAGE_BYTES = 8 * HTB, NXCD = 8, WGM = 8;
__host__ __device__ __forceinline__ int lds_byte(int r, int c) { const int st = (r >> 4) * 2 + (c >> 5), rr = r & 15, cc = c & 31, ob = rr * 64 + cc * 2; return st * 1024 + (ob ^ (((ob >> 9) & 1) << 5)); }
__host__ __device__ __forceinline__ void stage_rc(int b, int& R, int& C) { const int st = b / 1024, sb = b % 1024, swz = sb ^ (((sb >> 9) & 1) << 5); R = (st >> 1) * 16 + swz / 64; C = (st & 1) * 32 + (swz % 64) / 2; }
__host__ __device__ __forceinline__ int perm32(int rho) { const int n = rho >> 4, i = rho & 15; return 8 * (i >> 2) + 4 * n + (i & 3); }

struct Unit { int pm, pn, k0, nt, part; };
struct Gemm { const bf16_t* A; const bf16_t* Bt; int lda, ldb; };

struct StaticOrder {
    int nM, nN, nwg, G, c, nt;
    __host__ __device__ void init(int M_, int N_, int K_, int G_, int c_) { nM = M_ / BM; nN = N_ / BM; nwg = nM * nN; G = G_; c = c_; nt = K_ / BK; }
    __host__ __device__ bool next(int i, Unit& u) const {
        const long L = (long)i * G + c; if (L >= nwg) return false;
        int wgid = (int)L; { const int q = nwg / NXCD, r = nwg % NXCD, xcd = wgid % NXCD, off = wgid / NXCD; wgid = (xcd < r ? xcd * (q + 1) : r * (q + 1) + (xcd - r) * q) + off; }
        const int nig = WGM * nN, gid = wgid / nig, fm = gid * WGM, gsz = (nM - fm) < WGM ? (nM - fm) : WGM;
        u.pm = fm + ((wgid % nig) % gsz); u.pn = (wgid % nig) / gsz; u.k0 = 0; u.nt = nt; u.part = 0; return true;
    }
    __device__ __forceinline__ void a_ready(const Unit&) const {}
    __device__ __forceinline__ void done(const Unit&) const {}
};

struct BStatOrder {
    int x, j, tpx, nM, nt;
    __host__ __device__ void init(int M_, int N_, int K_, int c_) { x = c_ & 7; j = c_ >> 3; tpx = N_ / BM / 8; nM = M_ / BM; nt = K_ / BK; }
    __host__ __device__ bool next(int r, Unit& u) const {
        const int q = r * 32 + j; if (q >= nM * tpx) return false;
        u.pm = q / tpx; u.pn = x * tpx + (q - u.pm * tpx); u.k0 = 0; u.nt = nt; u.part = 0; return true;
    }
    __device__ __forceinline__ void a_ready(const Unit&) const {}
    __device__ __forceinline__ void done(const Unit&) const {}
};
struct SplitOrder {
    int x, i, ntf;
    __host__ __device__ void init(int K_, int c_) { x = c_ & 7; i = c_ >> 3; ntf = K_ / BK; }
    __host__ __device__ bool next(int r, Unit& u) const {
        const int gidx = 4 * x + (i >> 3);
        if (r == 0) { u.pm = gidx; u.pn = i & 7; u.k0 = 0; u.nt = ntf; u.part = 0; return true; }
        if (r == 1) { const int part = gidx & 3; u.pm = 32 + (gidx >> 2); u.pn = i & 7; u.nt = ntf >> 2; u.k0 = part * (ntf >> 2) * BK; u.part = part; return true; }
        return false;
    }
    __device__ __forceinline__ void a_ready(const Unit&) const {}
    __device__ __forceinline__ void done(const Unit&) const {}
};
__device__ __forceinline__ unsigned cvt_pk_bf16(float lo, float hi) { return pk2(lo, hi); }

template <class Epi, class Sched, bool ABLK = false, bool ALIGN_EPI = true, bool SP2 = true>
__device__ __forceinline__ void gemm_phase(LAS unsigned char* lds, const Gemm g, const Sched& S, const Epi& E) {
    const int tid = tid_fresh(), wid = __builtin_amdgcn_readfirstlane(tid >> 6), lane = tid & 63, wr = wid >> 2, wc = wid & 3, fr = lane & 15, fq = lane >> 4;
    unsigned voffA[2], voffB[2];
#pragma unroll
    for (int i = 0; i < 2; ++i) { int R, C; stage_rc(tid * 16 + i * 8192, R, C); const int r32 = Epi::PERM ? perm32(R & 31) : (R & 31);
        const int Rb = Epi::ADJ ? 64 * (R >> 5) + r32 : (R & ~31) + r32;
        voffA[i] = (unsigned)(R * (ABLK ? 64 : g.lda) + C) * 2u; voffB[i] = (unsigned)(Rb * g.ldb + C) * 2u; }
    const size_t kstep = (size_t)(BK * 2);
    const size_t hstepA = (size_t)HALF * (ABLK ? 64 : g.lda) * 2, hstepB = (size_t)(Epi::ADJ ? 32 : HALF) * g.ldb * 2;
    const size_t tstepB = (size_t)BM * g.ldb * 2;
    const unsigned ldsw = (unsigned)wid * 1024u;
    const int aoff = lds_byte(wr * 64 + fr, fq * 8), boff = lds_byte(wc * 32 + fr, fq * 8);
#define PG8_SA(b, h) (((b) * 2 + (h)) * HTB)
#define PG8_SB(b, h) ((4 + (b) * 2 + (h)) * HTB)
#define PG8_STAGE(bufoff, gbase, voff) do { _Pragma("unroll") for (int _i = 0; _i < 2; ++_i) \
        __builtin_amdgcn_global_load_lds((const unsigned*)((const char*)(gbase) + (voff)[_i]), (LAS unsigned*)(lds + (bufoff) + ldsw + _i * 8192), 16, 0, 0); } while (0)
#define PG8_LDA(dst, b, h) do { _Pragma("unroll") for (int m = 0; m < 4; ++m) _Pragma("unroll") for (int k = 0; k < 2; ++k) dst[m][k] = *(const LAS bf16x8*)(lds + PG8_SA(b, h) + aoff + m * 2048 + k * 1024); } while (0)
#define PG8_LDB(dst, b, h) do { _Pragma("unroll") for (int n = 0; n < 2; ++n) _Pragma("unroll") for (int k = 0; k < 2; ++k) dst[n][k] = *(const LAS bf16x8*)(lds + PG8_SB(b, h) + boff + n * 2048 + k * 1024); } while (0)
#define PG8_MMA(ai, bj, At, Bt) do { __builtin_amdgcn_s_setprio(1); _Pragma("unroll") for (int m = 0; m < 4; ++m) _Pragma("unroll") for (int n = 0; n < 2; ++n) _Pragma("unroll") for (int k = 0; k < 2; ++k) \
        acc[ai][bj][m][n] = __builtin_amdgcn_mfma_f32_16x16x32_bf16(Bt[n][k], At[m][k], acc[ai][bj][m][n], 0, 0, 0); __builtin_amdgcn_s_setprio(0); } while (0)
#define PG8_WAIT_V(n) asm volatile("s_waitcnt vmcnt(" #n ")" ::: "memory")
#define PG8_WAIT_L(n) asm volatile("s_waitcnt lgkmcnt(" #n ")" ::: "memory")
#define PG8_BAR __builtin_amdgcn_s_barrier()
#define PG8_SCHED __builtin_amdgcn_sched_barrier(0)
    Unit cur, nxt; int ui = 0;
    if (!S.next(0, cur)) return;
    f32x4 acc[2][2][4][2];
#pragma unroll
    for (int a = 0; a < 2; ++a)
#pragma unroll
        for (int b = 0; b < 2; ++b)
#pragma unroll
            for (int m = 0; m < 4; ++m)
#pragma unroll
                for (int n = 0; n < 2; ++n) acc[a][b][m][n] = (f32x4){0.f, 0.f, 0.f, 0.f};
    bf16x8 At[4][2], B0[2][2], B1[2][2];
    auto a_unit = [&](const Unit& u) -> const char* { return ABLK ? (const char*)g.A + (size_t)u.pm * ((size_t)g.lda / 64) * 32768 : (const char*)g.A + (size_t)u.pm * 2 * hstepA; };
    auto a_tile = [&](const char* ub, int tau) -> const char* { return ub + (size_t)tau * (ABLK ? (size_t)32768 : kstep); };
    const char* uA = a_unit(cur); int tbA = cur.k0 / BK;
    const char* cA = a_tile(uA, tbA); const char* cB = (const char*)g.Bt + (size_t)cur.pn * tstepB + (size_t)cur.k0 * 2;
    S.a_ready(cur);
    if constexpr (SP2) {
        PG8_STAGE(PG8_SB(0, 0), cB, voffB); PG8_STAGE(PG8_SB(0, 1), cB + hstepB, voffB); PG8_STAGE(PG8_SA(0, 0), cA, voffA); PG8_STAGE(PG8_SA(0, 1), cA + hstepA, voffA);
        if (wr == 1) PG8_BAR;
        PG8_WAIT_V(2); PG8_BAR;
        PG8_STAGE(PG8_SB(1, 0), cB + kstep, voffB); PG8_STAGE(PG8_SA(1, 0), a_tile(uA, tbA + 1), voffA); PG8_STAGE(PG8_SB(1, 1), cB + hstepB + kstep, voffB);
        PG8_WAIT_V(6); PG8_BAR;
    } else {
        PG8_STAGE(PG8_SB(0, 0), cB, voffB); PG8_STAGE(PG8_SA(0, 0), cA, voffA); PG8_STAGE(PG8_SB(0, 1), cB + hstepB, voffB); PG8_STAGE(PG8_SA(0, 1), cA + hstepA, voffA);
        if (wr == 1) PG8_BAR;
        PG8_WAIT_V(4); PG8_BAR;
        PG8_STAGE(PG8_SB(1, 0), cB + kstep, voffB); PG8_STAGE(PG8_SA(1, 0), a_tile(uA, tbA + 1), voffA); PG8_STAGE(PG8_SB(1, 1), cB + hstepB + kstep, voffB);
        PG8_WAIT_V(6); PG8_BAR;
    }
    for (;;) {
        const bool has_next = S.next(ui + 1, nxt);
        const int nt = cur.nt;
        const char* nuA = has_next ? a_unit(nxt) : uA; const int ntbA = has_next ? nxt.k0 / BK : tbA; const char* nB = has_next ? (const char*)g.Bt + (size_t)nxt.pn * tstepB + (size_t)nxt.k0 * 2 : cB;
        for (int t = 0; t < nt; t += 2) {
            const bool last = (t == nt - 2);
            const char* a1 = a_tile(uA, tbA + t + 1);
            const char* a2 = last ? a_tile(nuA, ntbA) : a_tile(uA, tbA + t + 2); const char* b2 = last ? nB : cB + (size_t)(t + 2) * kstep;
            const char* a3 = last ? a_tile(nuA, ntbA + 1) : a_tile(uA, tbA + t + 3); const char* b3 = b2 + kstep;
            if (last && has_next) S.a_ready(nxt);
            if constexpr (SP2) {
            PG8_LDB(B0, 0, 0); PG8_LDB(B1, 0, 1); PG8_SCHED; PG8_LDA(At, 0, 0); PG8_STAGE(PG8_SA(1, 1), a1 + hstepA, voffA);
            PG8_WAIT_V(8); PG8_WAIT_L(0); PG8_BAR; PG8_MMA(0, 0, At, B0); PG8_MMA(0, 1, At, B1); PG8_BAR; PG8_SCHED;
            PG8_LDA(At, 0, 1); PG8_STAGE(PG8_SB(0, 0), b2, voffB); PG8_STAGE(PG8_SB(0, 1), b2 + hstepB, voffB); PG8_STAGE(PG8_SA(0, 0), a2, voffA);
            PG8_WAIT_V(8); PG8_WAIT_L(0); PG8_BAR; PG8_MMA(1, 0, At, B0); PG8_MMA(1, 1, At, B1); PG8_BAR; PG8_SCHED;
            PG8_LDB(B0, 1, 0); PG8_LDB(B1, 1, 1); PG8_SCHED; PG8_LDA(At, 1, 0); PG8_STAGE(PG8_SA(0, 1), a2 + hstepA, voffA);
            PG8_WAIT_V(8); PG8_WAIT_L(0); PG8_BAR; PG8_MMA(0, 0, At, B0); PG8_MMA(0, 1, At, B1); PG8_BAR; PG8_SCHED;
            PG8_LDA(At, 1, 1); PG8_STAGE(PG8_SB(1, 0), b3, voffB); PG8_STAGE(PG8_SB(1, 1), b3 + hstepB, voffB); PG8_STAGE(PG8_SA(1, 0), a3, voffA);
            PG8_WAIT_V(8); PG8_WAIT_L(0); PG8_BAR; PG8_MMA(1, 0, At, B0); PG8_MMA(1, 1, At, B1); PG8_BAR; PG8_SCHED;
            } else {
            PG8_LDB(B0, 0, 0); PG8_SCHED; PG8_LDA(At, 0, 0); PG8_STAGE(PG8_SA(1, 1), a1 + hstepA, voffA);
            PG8_WAIT_L(8); PG8_BAR; PG8_WAIT_L(0); PG8_MMA(0, 0, At, B0); PG8_BAR; PG8_SCHED;
            PG8_LDB(B1, 0, 1); PG8_STAGE(PG8_SB(0, 0), b2, voffB);
            PG8_BAR; PG8_WAIT_L(0); PG8_MMA(0, 1, At, B1); PG8_BAR;
            PG8_LDA(At, 0, 1); PG8_STAGE(PG8_SA(0, 0), a2, voffA);
            PG8_BAR; PG8_WAIT_L(0); PG8_MMA(1, 0, At, B0); PG8_BAR; PG8_SCHED;
            PG8_STAGE(PG8_SB(0, 1), b2 + hstepB, voffB);
            PG8_WAIT_V(6); PG8_BAR; PG8_MMA(1, 1, At, B1); PG8_BAR;
            PG8_LDB(B0, 1, 0); PG8_SCHED; PG8_LDA(At, 1, 0); PG8_STAGE(PG8_SA(0, 1), a2 + hstepA, voffA);
            PG8_WAIT_L(8); PG8_BAR; PG8_WAIT_L(0); PG8_MMA(0, 0, At, B0); PG8_BAR; PG8_SCHED;
            PG8_LDB(B1, 1, 1); PG8_STAGE(PG8_SB(1, 0), b3, voffB);
            PG8_BAR; PG8_WAIT_L(0); PG8_MMA(0, 1, At, B1); PG8_BAR;
            PG8_LDA(At, 1, 1); PG8_STAGE(PG8_SA(1, 0), a3, voffA);
            PG8_BAR; PG8_WAIT_L(0); PG8_MMA(1, 0, At, B0); PG8_BAR; PG8_SCHED;
            PG8_STAGE(PG8_SB(1, 1), b3 + hstepB, voffB);
            PG8_WAIT_V(6); PG8_BAR; PG8_MMA(1, 1, At, B1); PG8_BAR;
            }
        }
        if constexpr (ALIGN_EPI) { if (wr == 0) PG8_BAR; }
        E(acc, cur, wr, wc, fr, fq); S.done(cur);
        if (!has_next) break;
#pragma unroll
        for (int a = 0; a < 2; ++a)
#pragma unroll
            for (int b = 0; b < 2; ++b)
#pragma unroll
                for (int m = 0; m < 4; ++m)
#pragma unroll
                    for (int n = 0; n < 2; ++n) acc[a][b][m][n] = (f32x4){0.f, 0.f, 0.f, 0.f};
        cur = nxt; uA = nuA; tbA = ntbA; cB = nB; ++ui;
        if constexpr (ALIGN_EPI) { if (wr == 1) PG8_BAR; }
    }
    PG8_WAIT_V(0);
    if constexpr (!ALIGN_EPI) { if (wr == 0) PG8_BAR; }
    PG8_BAR;
#undef PG8_SA
#undef PG8_SB
#undef PG8_STAGE
#undef PG8_LDA
#undef PG8_LDB
#undef PG8_MMA
#undef PG8_WAIT_V
#undef PG8_WAIT_L
#undef PG8_BAR
#undef PG8_SCHED
}
}

using pg8::Unit;
struct ResSrc { const float* xp; const float* xs; const bf16_t* xb;
    __device__ __forceinline__ f32x4 ld4(int r, int col) const {
        if (xb) { const u32x2 w = *(const u32x2*)(xb + (size_t)r * D + col);
            return (f32x4){__builtin_bit_cast(float, w.x << 16), __builtin_bit_cast(float, w.x & 0xffff0000u), __builtin_bit_cast(float, w.y << 16), __builtin_bit_cast(float, w.y & 0xffff0000u)}; }
        return *(const f32x4*)((r < MP ? xp + (size_t)r * D : xs + (size_t)(r - MP) * D) + col); } };

__device__ __forceinline__ u32x4 ror8(u32x4 v) { u32x4 r;
#pragma unroll
    for (int i = 0; i < 4; ++i) r[i] = (unsigned)__builtin_amdgcn_mov_dpp((int)v[i], 0x128, 0xf, 0xf, true);
    return r; }
__device__ __forceinline__ void store_pair(unsigned char* own, size_t stride8, int hi_off, u32x4 lo, u32x4 hi, bool upper) {
    const u32x4 tlo = ror8(lo), thi = ror8(hi);
    const u32x4 A = upper ? thi : lo, B = upper ? hi : tlo;
    unsigned char* pa = upper ? own - stride8 + hi_off : own;
    unsigned char* pb = upper ? own + hi_off : own + stride8;
    *(u32x4*)pa = A; *(u32x4*)pb = B;
}
__device__ __forceinline__ void store_pair_f(float* own, size_t stride8_elems, f32x4 lo, f32x4 hi, bool upper) {
    store_pair((unsigned char*)own, stride8_elems * 4, 64, __builtin_bit_cast(u32x4, lo), __builtin_bit_cast(u32x4, hi), upper);
}
struct EpiSsmGate {
    static constexpr bool PERM = true, ADJ = false;
    bf16_t* Z;
    __device__ __forceinline__ void operator()(const f32x4 (&acc)[2][2][4][2], const Unit& u, int wr, int wc, int fr, int fq) const {
        const int row0 = u.pm * 256 + wr * 64 + fr, ch0 = u.pn * 128 + wc * 32 + 8 * fq;
#pragma unroll
        for (int ai = 0; ai < 2; ++ai)
#pragma unroll
            for (int m = 0; m < 4; ++m) { f32x4 z[2];
#pragma unroll
                for (int n = 0; n < 2; ++n) { const f32x4 o = acc[ai][0][m][n], gt = acc[ai][1][m][n];
#pragma unroll
                    for (int j = 0; j < 4; ++j) z[n][j] = o[j] * sigmoidf_(gt[j]); }
                u32x4 w; w.x = pk2(z[0][0], z[0][1]); w.y = pk2(z[0][2], z[0][3]); w.z = pk2(z[1][0], z[1][1]); w.w = pk2(z[1][2], z[1][3]);
                *(u32x4*)(Z + (size_t)(row0 + ai * 128 + m * 16) * D + ch0) = w; }
    }
};
struct EpiRes {
    static constexpr bool PERM = true, ADJ = true;
    bf16_t* Z; bf16_t* P;
    __device__ __forceinline__ void operator()(const f32x4 (&acc)[2][2][4][2], const Unit& u, int wr, int wc, int fr, int fq) const {
        const int row0 = u.pm * 256 + wr * 64 + fr, col0 = u.pn * 256 + wc * 64 + 8 * fq;
        bf16_t* base = u.part == 0 ? Z + (size_t)row0 * D + col0 : P + ((size_t)(u.part - 1) * MS + (row0 - MP)) * D + col0;
#pragma unroll
        for (int ai = 0; ai < 2; ++ai)
#pragma unroll
            for (int m = 0; m < 4; ++m) { u32x4 w[2];
#pragma unroll
                for (int bj = 0; bj < 2; ++bj) { const f32x4 v0 = acc[ai][bj][m][0], v1 = acc[ai][bj][m][1]; w[bj].x = pk2(v0[0], v0[1]); w[bj].y = pk2(v0[2], v0[3]); w[bj].z = pk2(v1[0], v1[1]); w[bj].w = pk2(v1[2], v1[3]); }
                store_pair((unsigned char*)(base + (size_t)(ai * 128 + m * 16) * D), (size_t)8 * D * 2, 64, w[0], w[1], fr >= 8); }
    }
};
struct EpiFfn1 {
    static constexpr bool PERM = true, ADJ = true;
    bf16_t* H;
    __device__ __forceinline__ void operator()(const f32x4 (&acc)[2][2][4][2], const Unit& u, int wr, int wc, int fr, int fq) const {
#pragma unroll
        for (int ai = 0; ai < 2; ++ai)
#pragma unroll
            for (int m = 0; m < 4; ++m) { unsigned char* rowp = (unsigned char*)(H + ((size_t)(u.pm * (FF / 64) + u.pn * 4 + wc) * 256 + (wr * 64 + fr + ai * 128 + m * 16)) * 64 + 8 * fq); u32x4 w[2];
#pragma unroll
                for (int bj = 0; bj < 2; ++bj) { f32x4 v0 = acc[ai][bj][m][0], v1 = acc[ai][bj][m][1];
#pragma unroll
                    for (int j = 0; j < 4; ++j) { const float a = fmaxf(v0[j], 0.f), b = fmaxf(v1[j], 0.f); v0[j] = a * a; v1[j] = b * b; }
                    w[bj].x = pk2(v0[0], v0[1]); w[bj].y = pk2(v0[2], v0[3]); w[bj].z = pk2(v1[0], v1[1]); w[bj].w = pk2(v1[2], v1[3]); }
                store_pair(rowp, (size_t)8 * 64 * 2, 64, w[0], w[1], fr >= 8); }
    }
};
struct EpiQkv {
    static constexpr bool PERM = true, ADJ = true;
    bf16_t* QKV; float* out;
    __device__ __forceinline__ void operator()(const f32x4 (&acc)[2][2][4][2], const Unit& u, int wr, int wc, int fr, int fq) const {
        const int t = u.pn >> 3; const int colt = (u.pn & 7) * 256;
        const int col0 = colt + wc * 64 + 8 * fq;
        bf16_t* base = QKV + (size_t)t * M * D;
        float* fdst = nullptr;
        if (t >= 1) {
            if (u.pm < 32) { if ((u.pm & 7) >= 6) { const int n = u.pm >> 3; fdst = out + (t == 1 ? O_KP : O_VP) + ((size_t)n * 512 + (size_t)((u.pm & 7) - 6) * 256) * D; } }
            else fdst = out + (t == 1 ? O_KS : O_VS) + (size_t)(u.pm - 32) * 256 * D;
        }
#pragma unroll
        for (int ai = 0; ai < 2; ++ai)
#pragma unroll
            for (int m = 0; m < 4; ++m) { const int rl = wr * 64 + fr + ai * 128 + m * 16; u32x4 w[2];
#pragma unroll
                for (int bj = 0; bj < 2; ++bj) { const f32x4 v0 = acc[ai][bj][m][0], v1 = acc[ai][bj][m][1];
                    w[bj].x = pk2(v0[0], v0[1]); w[bj].y = pk2(v0[2], v0[3]); w[bj].z = pk2(v1[0], v1[1]); w[bj].w = pk2(v1[2], v1[3]);
                    if (fdst) { float* fp = fdst + (size_t)rl * D + col0 + bj * 32; *(f32x4*)fp = v0; *(f32x4*)(fp + 4) = v1; } }
                store_pair((unsigned char*)(base + (size_t)(u.pm * 256 + rl) * D + col0), (size_t)8 * D * 2, 64, w[0], w[1], fr >= 8); }
    }
};
struct EpiHgrnIn {
    static constexpr bool PERM = true, ADJ = true;
    bf16_t* QIG; unsigned short* F; const float* lb;
    __device__ __forceinline__ void operator()(const f32x4 (&acc)[2][2][4][2], const Unit& u, int wr, int wc, int fr, int fq) const {
        const int t = u.pn >> 3; const int colt = (u.pn & 7) * 256;
        const int row0 = u.pm * 256 + wr * 64 + fr, col0 = colt + wc * 64 + 8 * fq;
        if (t == 1) {
            f32x4 l[2][2];
#pragma unroll
            for (int bj = 0; bj < 2; ++bj) { l[bj][0] = 1.0f - *(const f32x4*)(lb + col0 + bj * 32); l[bj][1] = 1.0f - *(const f32x4*)(lb + col0 + bj * 32 + 4); }
#pragma unroll
            for (int ai = 0; ai < 2; ++ai)
#pragma unroll
                for (int m = 0; m < 4; ++m) { u32x4 w[2];
#pragma unroll
                    for (int bj = 0; bj < 2; ++bj) { f32x4 v0 = acc[ai][bj][m][0], v1 = acc[ai][bj][m][1];
#pragma unroll
                        for (int j = 0; j < 4; ++j) { v0[j] = l[bj][0][j] * sigmoidf_(-v0[j]); v1[j] = l[bj][1][j] * sigmoidf_(-v1[j]); }
                        w[bj].x = pkh2(v0[0], v0[1]); w[bj].y = pkh2(v0[2], v0[3]); w[bj].z = pkh2(v1[0], v1[1]); w[bj].w = pkh2(v1[2], v1[3]); }
                    store_pair((unsigned char*)(F + (size_t)(row0 + ai * 128 + m * 16) * D + col0), (size_t)8 * D * 2, 64, w[0], w[1], fr >= 8); }
        } else {
            bf16_t* base = QIG + (size_t)(t == 0 ? 0 : t - 1) * M * D;
#pragma unroll
            for (int ai = 0; ai < 2; ++ai)
#pragma unroll
                for (int m = 0; m < 4; ++m) { u32x4 w[2];
#pragma unroll
                    for (int bj = 0; bj < 2; ++bj) { const f32x4 v0 = acc[ai][bj][m][0], v1 = acc[ai][bj][m][1]; w[bj].x = pk2(v0[0], v0[1]); w[bj].y = pk2(v0[2], v0[3]); w[bj].z = pk2(v1[0], v1[1]); w[bj].w = pk2(v1[2], v1[3]); }
                    store_pair((unsigned char*)(base + (size_t)(row0 + ai * 128 + m * 16) * D + col0), (size_t)8 * D * 2, 64, w[0], w[1], fr >= 8); }
        }
    }
};

struct Args { const float* in[30]; float* out; unsigned char* ws; };


__device__ __forceinline__ float wave_sum(float v) {
#pragma unroll
    for (int o = 1; o < 64; o <<= 1) v += __shfl_xor(v, o);
    return v;
}

#define XB_TMO      128
#define XB_XCNT(j)  (256  + 64 * (j))
#define XB_XSUB(j)  (1280 + 64 * (j))
#define XB_XGEN(j)  (2304 + 64 * (j))
#define XB_TOP      3328
#define XB_TOPGEN   3392
#define XCD_BAR_WORDS 3456
#define XB_SPIN_CAP (1u << 18)
__device__ __forceinline__ unsigned xb_ld(unsigned* p)              { return __hip_atomic_load(p, __ATOMIC_RELAXED, __HIP_MEMORY_SCOPE_AGENT); }
__device__ __forceinline__ unsigned xb_add(unsigned* p, unsigned v) { return __hip_atomic_fetch_add(p, v, __ATOMIC_RELAXED, __HIP_MEMORY_SCOPE_AGENT); }
__device__ __forceinline__ unsigned xb_xcc_id() { return (unsigned)__builtin_amdgcn_s_getreg((3 << 11) | 20) & 0xFu; }
#define XB_SPIN(cond, bar) do { unsigned _sp = 0; while (cond) { __builtin_amdgcn_s_sleep(1); \
    if ((++_sp & 255u) == 0u) { if (xb_ld(&(bar)[XB_TMO])) break; if (_sp > XB_SPIN_CAP) { atomicAdd(&(bar)[XB_TMO], 1u); break; } } } } while (0)
struct XcdBarrier { unsigned* bar; unsigned x; volatile LAS unsigned* st; };
__device__ __forceinline__ XcdBarrier xcd_barrier_post(unsigned* bar, volatile LAS unsigned* st) {
    XcdBarrier b; b.bar = bar; b.x = xb_xcc_id(); b.st = st;
    if (threadIdx.x == 0) (void)xb_add(&bar[XB_XCNT(b.x)], 1u);
    return b;
}
__device__ __forceinline__ void xcd_barrier_complete(unsigned* bar, unsigned x, unsigned& nloc, unsigned& nx) {
    const unsigned G = gridDim.x * gridDim.y * gridDim.z;
    unsigned sum, cnt, mine, sp = 0u;
    for (;;) {
        sum = 0u; cnt = 0u; mine = 0u;
#pragma unroll
        for (unsigned j = 0; j < 16; ++j) { const unsigned c = xb_ld(&bar[XB_XCNT(j)]); sum += c; cnt += (c > 0u) ? 1u : 0u; mine = (j == x) ? c : mine; }
        if (sum == G) break;
        __builtin_amdgcn_s_sleep(1);
        if ((++sp & 255u) == 0u) { if (xb_ld(&bar[XB_TMO])) break; if (sp > XB_SPIN_CAP) { atomicAdd(&bar[XB_TMO], 1u); break; } }
    }
    nloc = mine > 0u ? mine : 1u; nx = cnt > 0u ? cnt : 1u;
}
__device__ __forceinline__ void xcd_barrier(const XcdBarrier& b) {
    asm volatile("s_waitcnt vmcnt(0)" ::: "memory");
    __syncthreads();
    if (threadIdx.x == 0) {
        unsigned* bar = b.bar;
        __builtin_amdgcn_s_waitcnt(0);
        unsigned nloc = b.st[0], nx = b.st[1];
        if (nloc == 0u) { xcd_barrier_complete(bar, b.x, nloc, nx); b.st[0] = nloc; b.st[1] = nx; }
        const unsigned old = xb_add(&bar[XB_XSUB(b.x)], 1u);
        const unsigned gen = old / nloc;
        if (old + 1u == (gen + 1u) * nloc) {
            __builtin_amdgcn_fence(__ATOMIC_RELEASE, "agent");
            asm volatile("s_waitcnt vmcnt(0)" ::: "memory");
            const unsigned og = xb_add(&bar[XB_TOP], 1u);
            const unsigned tg = og / nx;
            if (og + 1u == (tg + 1u) * nx) xb_add(&bar[XB_TOPGEN], 1u);
            else XB_SPIN(xb_ld(&bar[XB_TOPGEN]) == tg, bar);
            __builtin_amdgcn_fence(__ATOMIC_ACQUIRE, "agent");
            xb_add(&bar[XB_XGEN(b.x)], 1u);
            asm volatile("s_waitcnt vmcnt(0)" ::: "memory");
        } else {
            XB_SPIN(xb_ld(&bar[XB_XGEN(b.x)]) == gen, bar);
            __builtin_amdgcn_fence(__ATOMIC_ACQUIRE, "agent");
            asm volatile("s_waitcnt vmcnt(0)" ::: "memory");
        }
    }
    __syncthreads();
}

struct ConvItem { const float* src; bf16_t* dst; int N, K; };
constexpr int CONV_ITEMS = (4 * 2048 + 6144 + 2048 + 8192 + 2048 + 8 * 8192) / 2;
constexpr int CONV_LDS = 64 * 65 * 4;
__device__ __forceinline__ ConvItem conv_decode(const Args& a, int it) {
    unsigned char* ws = a.ws; const float* W; bf16_t* WT; int K, N, mode = 0;
    if (it < 4 * 1024) { const int m = it >> 10; it &= 1023; const int jj = m >> 1; mode = 1 + (m & 1); W = a.in[15 + (m & 1)] + (size_t)jj * D * D; WT = (bf16_t*)(ws + WS_WSSM) + (size_t)jj * 4096 * D; K = D; N = D; }
    else if ((it -= 4 * 1024) < 3072) { W = a.in[17]; WT = (bf16_t*)(ws + WS_WQKV); K = D; N = 3 * D; }
    else if ((it -= 3072) < 1024) { W = a.in[19]; WT = (bf16_t*)(ws + WS_WAO); K = D; N = D; }
    else if ((it -= 1024) < 4096) { W = a.in[20]; WT = (bf16_t*)(ws + WS_WHIN); K = D; N = 4 * D; }
    else if ((it -= 4096) < 1024) { W = a.in[23]; WT = (bf16_t*)(ws + WS_WHO); K = D; N = D; }
    else if ((it -= 1024) < 4 * 4096) { const int l = it >> 12; it &= 4095; W = a.in[28] + (size_t)l * D * FF; WT = (bf16_t*)(ws + WS_WF1) + (size_t)l * FF * D; K = D; N = FF; }
    else { it -= 4 * 4096; const int l = it >> 12; it &= 4095; W = a.in[29] + (size_t)l * FF * D; WT = (bf16_t*)(ws + WS_WF2) + (size_t)l * D * FF; K = FF; N = D; }
    const int nb = N / 64, kb = it / nb, n0 = 64 * (it - kb * nb), k0 = 64 * kb;
    const int row0 = mode == 0 ? n0 : 256 * (n0 >> 7) + 128 * (mode - 1) + (n0 & 127);
    ConvItem c; c.src = W + (size_t)k0 * N + n0; c.dst = WT + (size_t)row0 * K + k0; c.N = N; c.K = K; return c;
}
__device__ __forceinline__ void conv_load(const ConvItem& c, f32x4 (&wv)[16], int lane) {
#pragma unroll
    for (int i = 0; i < 16; ++i) wv[i] = __builtin_nontemporal_load((const f32x4*)(c.src + (size_t)(4 * i + (lane >> 4)) * c.N + 4 * (lane & 15)));
}
__device__ __forceinline__ void conv_store(const ConvItem& c, const f32x4 (&wv)[16], LAS float* scr, int lane) {
#pragma unroll
    for (int i = 0; i < 16; ++i) { LAS float* d = scr + (4 * i + (lane >> 4)) * 65 + 4 * (lane & 15); d[0] = wv[i][0]; d[1] = wv[i][1]; d[2] = wv[i][2]; d[3] = wv[i][3]; }
    asm volatile("s_waitcnt lgkmcnt(0)" ::: "memory");
    const int cc = lane & 7;
#pragma unroll
    for (int j = 0; j < 8; ++j) { const int n = (lane >> 3) + 8 * j; const LAS float* sp = scr + (8 * cc) * 65 + n;
        u32x4 o; o.x = pk2(sp[0 * 65], sp[1 * 65]); o.y = pk2(sp[2 * 65], sp[3 * 65]); o.z = pk2(sp[4 * 65], sp[5 * 65]); o.w = pk2(sp[6 * 65], sp[7 * 65]);
        *(u32x4*)(c.dst + (size_t)n * c.K + 8 * cc) = o; }
    asm volatile("s_waitcnt lgkmcnt(0)" ::: "memory");
}
__device__ __forceinline__ void conv_worker(const Args& a, LAS float* scr, int w, int nw, int lane) {
    f32x4 va[16], vb[16];
    int it = w; if (it >= CONV_ITEMS) return;
    ConvItem ca = conv_decode(a, it), cb = ca; conv_load(ca, va, lane);
    for (;;) {
        const bool hb = it + nw < CONV_ITEMS; if (hb) { cb = conv_decode(a, it + nw); conv_load(cb, vb, lane); }
        conv_store(ca, va, scr, lane); if (!hb) break; it += nw;
        const bool ha = it + nw < CONV_ITEMS; if (ha) { ca = conv_decode(a, it + nw); conv_load(ca, va, lane); }
        conv_store(cb, vb, scr, lane); if (!ha) break; it += nw;
    }
}
__device__ __forceinline__ int conv_ticket(LAS unsigned* ctr, int b, int nblk, int lane) {
    unsigned t = 0u; if (lane == 0) t = __hip_atomic_fetch_add(ctr, 1u, __ATOMIC_RELAXED, __HIP_MEMORY_SCOPE_WORKGROUP);
    t = (unsigned)__builtin_amdgcn_readfirstlane((int)t); return 6 * b + (int)(t % 6u) + (int)(t / 6u) * 6 * nblk;
}
__device__ __forceinline__ void conv_to_lds(const f32x4 (&wv)[16], LAS float* scr, int lane) {
#pragma unroll
    for (int i = 0; i < 16; ++i) { LAS float* d = scr + (4 * i + (lane >> 4)) * 65 + 4 * (lane & 15); d[0] = wv[i][0]; d[1] = wv[i][1]; d[2] = wv[i][2]; d[3] = wv[i][3]; }
    asm volatile("s_waitcnt lgkmcnt(0)" ::: "memory");
}
__device__ __forceinline__ void conv_from_lds(const ConvItem& c, LAS float* scr, int lane) {
    const int cc = lane & 7;
#pragma unroll
    for (int j = 0; j < 8; ++j) { const int n = (lane >> 3) + 8 * j; const LAS float* sp = scr + (8 * cc) * 65 + n;
        u32x4 o; o.x = pk2(sp[0 * 65], sp[1 * 65]); o.y = pk2(sp[2 * 65], sp[3 * 65]); o.z = pk2(sp[4 * 65], sp[5 * 65]); o.w = pk2(sp[6 * 65], sp[7 * 65]);
        *(u32x4*)(c.dst + (size_t)n * c.K + 8 * cc) = o; }
    asm volatile("s_waitcnt lgkmcnt(0)" ::: "memory");
}
__device__ __forceinline__ void conv_worker_dyn(const Args& a, LAS float* scr, LAS unsigned* ctr, int b, int nblk, int lane) {
    f32x4 va[16], vb[16];
    int ia = conv_ticket(ctr, b, nblk, lane); if (ia >= CONV_ITEMS) return;
    ConvItem ca = conv_decode(a, ia), cb = ca; conv_load(ca, va, lane);
    int ib = conv_ticket(ctr, b, nblk, lane); bool hb = ib < CONV_ITEMS; if (hb) { cb = conv_decode(a, ib); conv_load(cb, vb, lane); }
    for (;;) {
        conv_to_lds(va, scr, lane);
        const ConvItem c0 = ca; ia = conv_ticket(ctr, b, nblk, lane); const bool ha = ia < CONV_ITEMS; if (ha) { ca = conv_decode(a, ia); conv_load(ca, va, lane); }
        conv_from_lds(c0, scr, lane);
        if (!hb) break;
        conv_to_lds(vb, scr, lane);
        const ConvItem c1 = cb; ib = conv_ticket(ctr, b, nblk, lane); hb = ib < CONV_ITEMS; if (hb) { cb = conv_decode(a, ib); conv_load(cb, vb, lane); }
        conv_from_lds(c1, scr, lane);
        if (!ha) break;
    }
}
__device__ __forceinline__ void params1_item(const Args& a, int idx) {
    unsigned char* par = a.ws + WS_PAR;
    if (idx < 2 * NG * NP) {
        const int j = idx / (NG * NP), g = (idx / NP) % NG;
        const double are = a.in[7][idx], aim = a.in[8][idx], dt = exp((double)a.in[9][j * NG + g]);
        const double e = exp(are * dt), cr = e * cos(aim * dt), ci = e * sin(aim * dt);
        float* ab = (float*)(par + PAR_ABAR) + (size_t)idx * 2; ab[0] = (float)cr; ab[1] = (float)ci;
    }
    if (idx < D) {
        const float* lg = a.in[21]; float v0 = lg[idx], v1 = lg[D + idx], v2 = lg[2 * D + idx], v3 = lg[3 * D + idx];
        const float mx = fmaxf(fmaxf(v0, v1), fmaxf(v2, v3));
        v0 = expf(v0 - mx); v1 = expf(v1 - mx); v2 = expf(v2 - mx); v3 = expf(v3 - mx);
        ((float*)(par + PAR_LB))[idx] = (v1 + v2) / (v0 + v1 + v2 + v3);
    }
}
__device__ __forceinline__ void params2_item(const Args& a, int idx);
__device__ __forceinline__ void ph_params(const Args& a, int nblk, int b) {
    const int tid = tid_fresh(); const int nth = nblk * 512;
    for (int idx = b * 512 + tid; idx < 2 * NG * 8 * 64 + 2 * NG * 4 * 64; idx += nth) params2_item(a, idx);
    for (int idx = b * 512 + tid; idx < 2 * NG * NP; idx += nth) params1_item(a, idx);
}

template <int C> __device__ __forceinline__ float dppf(float v) { return __builtin_bit_cast(float, __builtin_amdgcn_mov_dpp(__builtin_bit_cast(int, v), C, 0xf, 0xf, true)); }
__device__ __forceinline__ float wave_sum_dpp(float v) {
    v += dppf<0x121>(v); v += dppf<0x122>(v); v += dppf<0x124>(v); v += dppf<0x128>(v);
    const int iv = __builtin_bit_cast(int, v);
    return (__builtin_bit_cast(float, __builtin_amdgcn_readlane(iv, 0)) + __builtin_bit_cast(float, __builtin_amdgcn_readlane(iv, 16))) + (__builtin_bit_cast(float, __builtin_amdgcn_readlane(iv, 32)) + __builtin_bit_cast(float, __builtin_amdgcn_readlane(iv, 48)));
}
__device__ __forceinline__ void ph_ln(const Args& a, int L, int which, bool final_, bool split, bool wr_x, bool res_inputs, int nblk, int b) {
    unsigned char* ws = a.ws; const bf16_t* P = (const bf16_t*)(ws + WS_SCR + SCR_PART);
    const bf16_t* Z = (const bf16_t*)(ws + WS_Z); float* Xo = final_ ? a.out : (float*)(ws + WS_X); bf16_t* XB = (bf16_t*)(ws + WS_XB);
    auto lo = [](unsigned w) -> float { return __builtin_bit_cast(float, w << 16); }; auto hi = [](unsigned w) -> float { return __builtin_bit_cast(float, w & 0xffff0000u); };
    const float* gam = a.in[which ? 26 : 24] + (size_t)L * D; const float* bet = a.in[which ? 27 : 25] + (size_t)L * D;
    const int tid = tid_fresh(); const int lane = tid & 63, gw = b * 8 + (tid >> 6), ngw = nblk * 8;
    f32x4 gg[4][2], bb[4][2];
#pragma unroll
    for (int j = 0; j < 4; ++j)
#pragma unroll
        for (int h = 0; h < 2; ++h) { gg[j][h] = *(const f32x4*)(gam + 512 * j + 8 * lane + 4 * h); bb[j][h] = *(const f32x4*)(bet + 512 * j + 8 * lane + 4 * h); }
    u32x4 zc[4], xc[4];
    auto ldrow = [&](int r) { const u32x4* zr = (const u32x4*)(Z + (size_t)r * D) + lane;
#pragma unroll
        for (int j = 0; j < 4; ++j) zc[j] = zr[64 * j];
        if (!res_inputs) { const u32x4* xr = (const u32x4*)(XB + (size_t)r * D) + lane;
#pragma unroll
            for (int j = 0; j < 4; ++j) xc[j] = xr[64 * j]; } };
    if (gw < M) ldrow(gw);
    for (int r = gw; r < M; r += ngw) {
        float v[4][8];
#pragma unroll
        for (int j = 0; j < 4; ++j)
#pragma unroll
            for (int e = 0; e < 4; ++e) { v[j][2 * e] = lo(zc[j][e]); v[j][2 * e + 1] = hi(zc[j][e]); }
        if (!res_inputs) {
#pragma unroll
            for (int j = 0; j < 4; ++j)
#pragma unroll
                for (int e = 0; e < 4; ++e) { v[j][2 * e] += ALPHA * lo(xc[j][e]); v[j][2 * e + 1] += ALPHA * hi(xc[j][e]); } }
        if (r + ngw < M) ldrow(r + ngw);
        if (split && r >= MP) {
#pragma unroll
            for (int p = 0; p < 3; ++p) { const u32x4* pr = (const u32x4*)(P + ((size_t)p * MS + (r - MP)) * D) + lane;
#pragma unroll
                for (int j = 0; j < 4; ++j) { const u32x4 w = pr[64 * j];
#pragma unroll
                    for (int e = 0; e < 4; ++e) { v[j][2 * e] += lo(w[e]); v[j][2 * e + 1] += hi(w[e]); } } } }
        if (res_inputs) { const f32x4* xr = (const f32x4*)(r < MP ? a.in[0] + (size_t)r * D : a.in[1] + (size_t)(r - MP) * D) + 2 * lane;
#pragma unroll
            for (int j = 0; j < 4; ++j)
#pragma unroll
                for (int h = 0; h < 2; ++h) { const f32x4 x = xr[128 * j + h];
#pragma unroll
                    for (int e = 0; e < 4; ++e) v[j][4 * h + e] += ALPHA * x[e]; } }
        float s = 0.f;
#pragma unroll
        for (int j = 0; j < 4; ++j) s += ((v[j][0] + v[j][1]) + (v[j][2] + v[j][3])) + ((v[j][4] + v[j][5]) + (v[j][6] + v[j][7]));
        const float mean = wave_sum_dpp(s) * (1.f / D); float s2 = 0.f;
#pragma unroll
        for (int j = 0; j < 4; ++j)
#pragma unroll
            for (int e = 0; e < 8; ++e) { v[j][e] -= mean; s2 += v[j][e] * v[j][e]; }
        const float rstd = 1.f / sqrtf(wave_sum_dpp(s2) * (1.f / D) + LN_EPS);
        f32x4* xo = (f32x4*)(Xo + (size_t)r * D) + 2 * lane; u32x4* xb = (u32x4*)(XB + (size_t)r * D) + lane;
#pragma unroll
        for (int j = 0; j < 4; ++j) { f32x4 y[2];
#pragma unroll
            for (int h = 0; h < 2; ++h)
#pragma unroll
                for (int e = 0; e < 4; ++e) y[h][e] = v[j][4 * h + e] * rstd * gg[j][h][e] + bb[j][h][e];
            if (final_ || wr_x) { xo[128 * j] = y[0]; xo[128 * j + 1] = y[1]; }
            if (!final_) { u32x4 w; w.x = pk2(y[0][0], y[0][1]); w.y = pk2(y[0][2], y[0][3]); w.z = pk2(y[1][0], y[1][1]); w.w = pk2(y[1][2], y[1][3]); xb[64 * j] = w; } }
    }
}
__device__ __forceinline__ void params2_item(const Args& a, int idx) {
    unsigned char* par = a.ws + WS_PAR;
    if (idx < 2 * NG * 8 * 64) {
        const int lane = idx & 63, n8 = (idx >> 6) & 7, jg = idx >> 9; const int j = jg / NG, g = jg % NG; const int G4 = lane >> 4, c = lane & 15;
        const int pp = 16 * n8 + c, p = pp & 63, im = pp >> 6; const int sidx = (j * NG + g) * NP + p;
        const double are = a.in[7][sidx], aim = a.in[8][sidx], dt = exp((double)a.in[9][j * NG + g]);
        const double e = exp(are * dt), cr = e * cos(aim * dt), ci = e * sin(aim * dt);
        const double xr = cr - 1.0, xi = ci, den = are * are + aim * aim; const double fr = (xr * are + xi * aim) / den, fi = (xi * are - xr * aim) / den;
        unsigned w[4];
#pragma unroll
        for (int e2 = 0; e2 < 4; ++e2) { float v[2];
#pragma unroll
            for (int h = 0; h < 2; ++h) { const int q = (8 * G4 + 2 * e2 + h) & 15; const double br = a.in[10][(size_t)sidx * NQ + q], bi = a.in[11][(size_t)sidx * NQ + q];
                v[h] = (float)(im ? (fr * bi + fi * br) : (fr * br - fi * bi)); }
            w[e2] = pk2(v[0], v[1]); }
        ((u32x4*)(par + PAR_BFRAG))[idx] = (u32x4){w[0], w[1], w[2], w[3]};
    } else if (idx < 2 * NG * 8 * 64 + 2 * NG * 4 * 64) {
        const int id2 = idx - 2 * NG * 8 * 64; const int lane = id2 & 63, kk = (id2 >> 6) & 3, jg = id2 >> 8; const int G4 = lane >> 4, c = lane & 15;
        unsigned w[4];
#pragma unroll
        for (int e2 = 0; e2 < 4; ++e2) { float v[2];
#pragma unroll
            for (int h = 0; h < 2; ++h) { const int pp = 32 * kk + 8 * G4 + 2 * e2 + h; const size_t ci = ((size_t)jg * NQ + c) * NP + (pp & 63);
                v[h] = pp < 64 ? a.in[12][ci] : -a.in[13][ci]; }
            w[e2] = pk2(v[0], v[1]); }
        ((u32x4*)(par + PAR_CFRAG))[id2] = (u32x4){w[0], w[1], w[2], w[3]};
    }
}

__device__ __forceinline__ f32x4 mfma_t(bf16x8 a, bf16x8 b, f32x4 c) {
    asm volatile("s_nop 4" : "+v"(c) : "v"(a), "v"(b));
    f32x4 d = __builtin_amdgcn_mfma_f32_16x16x32_bf16(a, b, c, 0, 0, 0);
    asm volatile("s_nop 7" : "+v"(d) : "v"(a), "v"(b));
    return d;
}
__device__ __forceinline__ f32x4 mfma_u(bf16x8 a, bf16x8 b, f32x4 c) {
    f32x4 d = __builtin_amdgcn_mfma_f32_16x16x32_bf16(a, b, c, 0, 0, 0);
    asm volatile("" : "+v"(d) : "v"(a), "v"(b));
    return d;
}
__device__ __forceinline__ f32x4 mfma_a(bf16x8 a, bf16x8 b, f32x4 c) { f32x4 d = __builtin_amdgcn_mfma_f32_16x16x32_bf16(a, b, c, 0, 0, 0); asm("" : "+v"(d) : "v"(a), "v"(b)); return d; }
#define OPAQUE(x) asm volatile("" : "+v"(x))
#define MFMA_PRE1(x) asm volatile("s_nop 4" : "+v"(x))
#define MFMA_POST4(a, b, c, d) asm volatile("s_nop 7\n\ts_nop 7" : "+v"(a), "+v"(b), "+v"(c), "+v"(d))
#define MFMA_POST8(a, b, c, d, e, f, g, h) asm volatile("s_nop 7\n\ts_nop 7" : "+v"(a), "+v"(b), "+v"(c), "+v"(d), "+v"(e), "+v"(f), "+v"(g), "+v"(h))
#define MFMA_POST1(a) asm volatile("s_nop 7\n\ts_nop 7" : "+v"(a))
constexpr int SSM_BUS = 132;
constexpr int SSM_WLDS = 16 * SSM_BUS * 4 + 64 * 16 * 4;
template <bool FULL>
__device__ __forceinline__ void ssm_core(const Args& a, LAS unsigned char* wl, int j, int L, bool samp, int n, int g, int tb, int te, float& hr, float& hi, int lane) {
    unsigned char* ws = a.ws;
    const size_t rowbase = samp ? (size_t)MP + (size_t)n * DSEQ : (size_t)n * SEQ;
    const float* xbase = (L == 0) ? (samp ? a.in[1] + (size_t)n * DSEQ * D : a.in[0] + rowbase * D) : (const float*)(ws + WS_X) + rowbase * D;
    const int G4 = lane >> 4, c = lane & 15;
    const bf16x8* bfp = (const bf16x8*)(ws + WS_PAR + PAR_BFRAG) + (size_t)(j * NG + g) * 8 * 64 + lane;
    const bf16x8* cfp = (const bf16x8*)(ws + WS_PAR + PAR_CFRAG) + (size_t)(j * NG + g) * 4 * 64 + lane;
    bf16x8 Bf[8], Cf[4];
#pragma unroll
    for (int i = 0; i < 8; ++i) Bf[i] = bfp[i * 64];
    if (FULL) {
#pragma unroll
        for (int i = 0; i < 4; ++i) Cf[i] = cfp[i * 64]; }
    const float* ab = (const float*)(ws + WS_PAR + PAR_ABAR) + ((size_t)(j * NG + g) * NP + lane) * 2; const float ar = ab[0], ai = ab[1];
    const float dsk = a.in[14][(size_t)j * D + g * NQ + c];
    LAS float* BUs = (LAS float*)wl; LAS float* Us = (LAS float*)(wl + 16 * SSM_BUS * 4);
    bf16_t* Y = (bf16_t*)(ws + WS_Y);
    const float* up = xbase + (size_t)c * D + g * NQ + 8 * (G4 & 1);
    auto ldu = [&](int trow, f32x4& lo, f32x4& hi4) { const float* p = up + (size_t)trow * D; lo = *(const f32x4*)p; hi4 = *(const f32x4*)(p + 4); };
    f32x4 ub[4][2];
#pragma unroll
    for (int k = 0; k < 4; ++k) ldu(tb + 16 * k, ub[k][0], ub[k][1]);
    for (int t0 = tb; t0 < te; t0 += 64) {
#pragma unroll
        for (int k = 0; k < 4; ++k) { LAS f32x4* ud = (LAS f32x4*)(Us + (16 * k + c) * 16 + 8 * (G4 & 1)); ud[0] = ub[k][0]; ud[1] = ub[k][1]; }
        if (t0 + 64 < te) {
#pragma unroll
            for (int k = 0; k < 4; ++k) ldu(t0 + 64 + 16 * k, ub[k][0], ub[k][1]); }
        asm volatile("s_waitcnt lgkmcnt(0)" ::: "memory");
#pragma unroll 1
        for (int k = 0; k < 4; ++k) {
            bf16x8 afk;
            { const LAS f32x4* usrc = (const LAS f32x4*)(Us + (16 * k + c) * 16 + 8 * (G4 & 1)); const f32x4 x0 = usrc[0], x1 = usrc[1];
              u32x4 aw;
#pragma unroll
              for (int e2 = 0; e2 < 4; ++e2) { const float u0 = e2 < 2 ? x0[2 * e2] : x1[2 * e2 - 4], u1 = e2 < 2 ? x0[2 * e2 + 1] : x1[2 * e2 - 3];
                  const unsigned hp = pk2(u0, u1); const unsigned lp = pk2(u0 - __builtin_bit_cast(float, hp << 16), u1 - __builtin_bit_cast(float, hp & 0xffff0000u)); aw[e2] = G4 < 2 ? hp : lp; }
              afk = __builtin_bit_cast(bf16x8, aw); }
            f32x4 dd[8];
#pragma unroll
            for (int n8 = 0; n8 < 8; ++n8) dd[n8] = mfma_t(afk, Bf[n8], (f32x4){0.f, 0.f, 0.f, 0.f});
#pragma unroll
            for (int n8 = 0; n8 < 8; ++n8)
#pragma unroll
                for (int i = 0; i < 4; ++i) BUs[(4 * G4 + i) * SSM_BUS + 16 * n8 + c] = dd[n8][i];
            asm volatile("s_waitcnt lgkmcnt(0)" ::: "memory");
#pragma unroll
            for (int t = 0; t < 16; ++t) { const float br = BUs[t * SSM_BUS + lane], bi = BUs[t * SSM_BUS + 64 + lane];
                const float nr = fmaf(ar, hr, fmaf(-ai, hi, br)), ni = fmaf(ar, hi, fmaf(ai, hr, bi)); hr = nr; hi = ni;
                if (FULL) { BUs[t * SSM_BUS + lane] = hr; BUs[t * SSM_BUS + 64 + lane] = hi; } }
            asm volatile("s_waitcnt lgkmcnt(0)" ::: "memory");
            if (FULL) {
                f32x4 y = (f32x4){0.f, 0.f, 0.f, 0.f};
                u32x4 hw[4];
#pragma unroll
                for (int kk = 0; kk < 4; ++kk) { const LAS f32x4* hp = (const LAS f32x4*)(BUs + c * SSM_BUS + 32 * kk + 8 * G4); const f32x4 h0 = hp[0], h1 = hp[1];
                    hw[kk].x = pk2(h0[0], h0[1]); hw[kk].y = pk2(h0[2], h0[3]); hw[kk].z = pk2(h1[0], h1[1]); hw[kk].w = pk2(h1[2], h1[3]); }
#pragma unroll
                for (int kk = 0; kk < 4; ++kk) y = mfma_t(__builtin_bit_cast(bf16x8, hw[kk]), Cf[kk], y);
#pragma unroll
                for (int i = 0; i < 4; ++i) { const float us = Us[(16 * k + 4 * G4 + i) * 16 + c]; Y[(rowbase + t0 + 16 * k + 4 * G4 + i) * D + g * NQ + c] = (bf16_t)f2bf(gelu_tanh(y[i] + dsk * us)); }
                asm volatile("s_waitcnt lgkmcnt(0)" ::: "memory");
            }
        }
    }
}
__device__ __forceinline__ void ssm_item(const Args& a, LAS unsigned char* wl, int j, int L, bool samp, int n, int g, int lane) {
    float hr = 0.f, hi = 0.f;
    if (samp) { hr = a.in[2][((size_t)(j * DB + n) * NG + g) * NP + lane]; hi = a.in[3][((size_t)(j * DB + n) * NG + g) * NP + lane]; }
    ssm_core<true>(a, wl, j, L, samp, n, g, 0, samp ? DSEQ : SEQ, hr, hi, lane);
    const size_t so = ((size_t)(j * (samp ? DB : NB) + n) * NG + g) * NP + lane;
    a.out[(samp ? O_SRS : O_SRP) + so] = hr; a.out[(samp ? O_SIS : O_SIP) + so] = hi;
}
template <bool CONV> __device__ __forceinline__ void ph_ssm(const Args& a, LAS unsigned char* lds, int j, int L, int nblk, int b) {
    const int tid = tid_fresh(); const int wave = __builtin_amdgcn_readfirstlane(tid >> 6), lane = tid & 63;
    LAS unsigned char* wl = CONV ? (wave < 2 ? lds + wave * SSM_WLDS : lds + 2 * SSM_WLDS + (wave - 2) * CONV_LDS) : lds + wave * SSM_WLDS;
    if (wave < 2) { for (int it = b * 2 + wave; it < NB * NG; it += nblk * 2) ssm_item(a, wl, j, L, false, it / NG, it % NG, lane); }
    else { for (int it = b * 6 + (wave - 2); it < DB * NG; it += nblk * 6) ssm_item(a, wl, j, L, true, it / NG, it % NG, lane);
        if (CONV) conv_worker(a, (LAS float*)wl, b * 6 + (wave - 2), nblk * 6, lane); }
}
constexpr int SSM_L0_X = 1472;
__device__ __forceinline__ void ph_ssm_l0(const Args& a, LAS unsigned char* lds, int nblk, int b) {
    const int tid = tid_fresh(); const int wave = __builtin_amdgcn_readfirstlane(tid >> 6), lane = tid & 63;
    LAS unsigned char* wl = lds + wave * CONV_LDS; LAS unsigned* ctr = (LAS unsigned*)(lds + 8 * CONV_LDS);
    __syncthreads();
    if (tid == 0) *ctr = 0u;
    __syncthreads();
    if (wave < 4) {
        __builtin_amdgcn_s_setprio(3);
        const int seq = 2 * b + (wave >> 1), n = seq / NG, g = seq % NG; float hr = 0.f, hi = 0.f;
        if ((wave & 1) == 0) ssm_core<true>(a, wl, 0, 0, false, n, g, 0, SSM_L0_X, hr, hi, lane);
        else { ssm_core<false>(a, wl, 0, 0, false, n, g, 0, SSM_L0_X, hr, hi, lane); ssm_core<true>(a, wl, 0, 0, false, n, g, SSM_L0_X, SEQ, hr, hi, lane);
            const size_t so = ((size_t)n * NG + g) * NP + lane; a.out[O_SRP + so] = hr; a.out[O_SIP + so] = hi; }
        __builtin_amdgcn_s_setprio(0);
    } else { for (int q = 0; q < 4; ++q) { const int it = 16 * b + 4 * (wave - 4) + q; ssm_item(a, wl, 0, 0, true, it / NG, it % NG, lane); } }
    conv_worker_dyn(a, (LAS float*)wl, ctr, b, nblk, lane);
}
constexpr int SSM_EXCH = 8 * SSM_WLDS;
__device__ __forceinline__ void ph_ssm_split(const Args& a, LAS unsigned char* lds, int j, int L, int b) {
    unsigned char* ws = a.ws;
    const int tid = tid_fresh(); const int wave = __builtin_amdgcn_readfirstlane(tid >> 6), lane = tid & 63;
    LAS unsigned char* wl = lds + wave * SSM_WLDS; LAS f32x2* exch = (LAS f32x2*)(lds + SSM_EXCH);
    const int seq = 2 * b + (wave >> 2), seg = wave & 3, n = seq / NG, g = seq % NG;
    if (seg < 3) { float er = 0.f, ei = 0.f; ssm_core<false>(a, wl, j, L, false, n, g, 512 * seg, 512 * seg + 512, er, ei, lane); exch[wave * 64 + lane] = (f32x2){er, ei}; }
    else { for (int q = 0; q < 4; ++q) { const int it = 16 * b + 4 * (wave >> 2) + q; ssm_item(a, wl, j, L, true, it / NG, it % NG, lane); } }
    __syncthreads();
    float hr = 0.f, hi = 0.f;
    if (seg > 0) {
        const float* ab = (const float*)(ws + WS_PAR + PAR_ABAR) + ((size_t)(j * NG + g) * NP + lane) * 2; float pr = ab[0], pi = ab[1];
#pragma unroll
        for (int q = 0; q < 9; ++q) { const float nr = pr * pr - pi * pi, ni = 2.f * pr * pi; pr = nr; pi = ni; }
        for (int s2 = 0; s2 < seg; ++s2) { const f32x2 e = exch[((wave & 4) + s2) * 64 + lane]; const float nr = pr * hr - pi * hi + e[0], ni = pr * hi + pi * hr + e[1]; hr = nr; hi = ni; }
    }
    ssm_core<true>(a, wl, j, L, false, n, g, 512 * seg, 512 * seg + 512, hr, hi, lane);
    if (seg == 3) { const size_t so = ((size_t)(j * NB + n) * NG + g) * NP + lane; a.out[O_SRP + so] = hr; a.out[O_SIP + so] = hi; }
    { const int it = 16 * b + 8 + wave; ssm_item(a, wl, j, L, true, it / NG, it % NG, lane); }
}

typedef short s16x4 __attribute__((ext_vector_type(4)));
constexpr int AT_KS = 136, AT_VS = 144;
constexpr int AT_TILE = 64 * AT_KS * 2, AT_VTILE = 64 * AT_VS * 2;
constexpr int AT_LDS_K = 0, AT_LDS_V = 2 * AT_TILE, AT_LDS_TAB = AT_LDS_V + 2 * AT_VTILE, AT_LDS_BYTES = AT_LDS_TAB + 2 * 260 * 4;
template <bool SAMP>
__device__ __forceinline__ void attn_unit(const Args& a, LAS unsigned char* lds, int n, int cch, int hp) {
    unsigned char* ws = a.ws;
    const bf16_t* Qb = (const bf16_t*)(ws + WS_H); const bf16_t* Kb = Qb + (size_t)M * D; const bf16_t* Vb = Kb + (size_t)M * D; bf16_t* Y = (bf16_t*)(ws + WS_Y);
    const int tid = tid_fresh(), wave = __builtin_amdgcn_readfirstlane(tid >> 6), lane = tid & 63, G4 = lane >> 4, c = lane & 15, hh = wave >> 2, w4 = wave & 3;
    LAS float* tabs = (LAS float*)(lds + AT_LDS_TAB);
    const int srow = tid >> 4, scc = tid & 15;
    const int t0 = (!SAMP && cch < 8) ? 8 - cch : 0;
    const size_t qrow0 = SAMP ? (size_t)MP + (size_t)n * 64 : (size_t)n * SEQ + (size_t)cch * 64;
    const int h = 2 * hp + hh;
    __syncthreads();
    for (int i = tid; i < 2 * 257; i += 512) { const int th = i / 257, ti = i - th * 257; tabs[th * 260 + ti] = a.in[18][(size_t)(2 * hp + th) * 257 + ti]; }
    bf16x8 Qf[4];
    { const bf16_t* qp = Qb + (qrow0 + 16 * w4 + c) * D + h * HD + 8 * G4;
#pragma unroll
      for (int kk = 0; kk < 4; ++kk) Qf[kk] = *(const bf16x8*)(qp + 32 * kk); }
    f32x4 st[8];
    auto load_tile = [&](int tau) {
#pragma unroll
        for (int p = 0; p < 8; ++p) { const int r = srow + 32 * p, kv = r >> 7, th = (r >> 6) & 1, key = r & 63; const int hd = 2 * hp + th;
            const size_t krow = SAMP ? (size_t)MP + (size_t)n * 64 + key : (size_t)n * SEQ + (size_t)(cch - 8 + tau) * 64 + key;
            const bf16_t* src = (kv ? Vb : Kb) + krow * D + hd * HD + 8 * scc; st[p] = __builtin_bit_cast(f32x4, *(const u32x4*)src); }
    };
    auto store_tile = [&]() {
#pragma unroll
        for (int p = 0; p < 8; ++p) { const int r = srow + 32 * p, kv = r >> 7, th = (r >> 6) & 1, key = r & 63;
            *(LAS u32x4*)(lds + (kv ? AT_LDS_V + th * AT_VTILE + (key * AT_VS + 8 * scc) * 2 : AT_LDS_K + th * AT_TILE + (key * AT_KS + 8 * scc) * 2)) = __builtin_bit_cast(u32x4, st[p]); }
    };
    auto stage_f32 = [&](int tau) {
#pragma unroll
        for (int hf = 0; hf < 2; ++hf) {
#pragma unroll
            for (int p4 = 0; p4 < 4; ++p4) { const int p = 4 * hf + p4; const int r = srow + 32 * p, kv = r >> 7, th = (r >> 6) & 1, key = r & 63; const int hd = 2 * hp + th;
                const float* src = a.in[kv ? 5 : 4] + (((size_t)n * 512 + (size_t)tau * 64 + key) * NH + hd) * HD + 8 * scc;
                st[2 * p4] = *(const f32x4*)src; st[2 * p4 + 1] = *(const f32x4*)(src + 4); }
#pragma unroll
            for (int p4 = 0; p4 < 4; ++p4) { const int p = 4 * hf + p4; const int r = srow + 32 * p, kv = r >> 7, th = (r >> 6) & 1, key = r & 63;
                const f32x4 x0 = st[2 * p4], x1 = st[2 * p4 + 1]; u32x4 w; w.x = pk2(x0[0], x0[1]); w.y = pk2(x0[2], x0[3]); w.z = pk2(x1[0], x1[1]); w.w = pk2(x1[2], x1[3]);
                *(LAS u32x4*)(lds + (kv ? AT_LDS_V + th * AT_VTILE + (key * AT_VS + 8 * scc) * 2 : AT_LDS_K + th * AT_TILE + (key * AT_KS + 8 * scc) * 2)) = w; } }
    };
    f32x4 O[8];
#pragma unroll
    for (int i = 0; i < 8; ++i) O[i] = (f32x4){0.f, 0.f, 0.f, 0.f};
    float mrun = -1e30f, lrun = 0.f;
    const int qi = 16 * w4 + c;
    if (SAMP) stage_f32(0); else { load_tile(t0); store_tile(); }
    __syncthreads();
    const float bconst = tabs[hh * 260 + 256];
    const LAS unsigned char* kbase = lds + AT_LDS_K + hh * AT_TILE + (c * AT_KS + 8 * G4) * 2;
    const LAS unsigned char* vbase = lds + AT_LDS_V + hh * AT_VTILE + ((4 * G4 + (c >> 2)) * AT_VS + 4 * (c & 3)) * 2;
    for (int tau = t0; tau <= 8; ++tau) {
        if (SAMP ? tau == 7 : tau < 8) load_tile(tau + 1);
        f32x4 sa[4];
#pragma unroll
        for (int sub = 0; sub < 4; ++sub) { sa[sub] = (f32x4){0.f, 0.f, 0.f, 0.f};
            bf16x8 kf[4];
#pragma unroll
            for (int kk = 0; kk < 4; ++kk) kf[kk] = *(const LAS bf16x8*)(kbase + (16 * sub * AT_KS + 32 * kk) * 2);
#pragma unroll
            for (int kk = 0; kk < 4; ++kk) sa[sub] = mfma_t(kf[kk], Qf[kk], sa[sub]); }
        MFMA_POST4(sa[0], sa[1], sa[2], sa[3]);
        float mloc = -1e30f;
#pragma unroll
        for (int sub = 0; sub < 4; ++sub)
#pragma unroll
            for (int i = 0; i < 4; ++i) { float bias = bconst;
                if (tau >= 6) { int rel = qi - ((tau - 8) * 64 + 16 * sub + 4 * G4 + i); rel = rel > 128 ? 128 : rel; bias = tabs[hh * 260 + rel + 128]; }
                const float sv = sa[sub][i] * 0.08838834764831845f + bias; sa[sub][i] = sv; mloc = fmaxf(mloc, sv); }
        mloc = fmaxf(mloc, __shfl_xor(mloc, 16)); mloc = fmaxf(mloc, __shfl_xor(mloc, 32));
        const float mnew = fmaxf(mrun, mloc), alpha = __expf(mrun - mnew); mrun = mnew;
        float ps = 0.f;
#pragma unroll
        for (int sub = 0; sub < 4; ++sub)
#pragma unroll
            for (int i = 0; i < 4; ++i) { const float p = __expf(sa[sub][i] - mnew); sa[sub][i] = p; ps += p; }
        lrun = lrun * alpha + ps;
        u32x4 pw[2];
#pragma unroll
        for (int s2 = 0; s2 < 2; ++s2) { pw[s2].x = pk2(sa[2 * s2][0], sa[2 * s2][1]); pw[s2].y = pk2(sa[2 * s2][2], sa[2 * s2][3]); pw[s2].z = pk2(sa[2 * s2 + 1][0], sa[2 * s2 + 1][1]); pw[s2].w = pk2(sa[2 * s2 + 1][2], sa[2 * s2 + 1][3]); }
#pragma unroll
        for (int i = 0; i < 8; ++i) O[i] = O[i] * alpha;
        asm volatile("s_nop 4" : "+v"(pw[0]), "+v"(pw[1]), "+v"(O[0]), "+v"(O[1]), "+v"(O[2]), "+v"(O[3]), "+v"(O[4]), "+v"(O[5]), "+v"(O[6]), "+v"(O[7]));
#pragma unroll
        for (int dp = 0; dp < 4; ++dp) {
            bf16x8 vf[2][2];
#pragma unroll
            for (int d2 = 0; d2 < 2; ++d2)
#pragma unroll
                for (int s2 = 0; s2 < 2; ++s2) { const int dt = 2 * dp + d2;
                    const s16x4 va = __builtin_amdgcn_ds_read_tr16_b64_v4i16((LAS s16x4*)(vbase + ((32 * s2) * AT_VS + 16 * dt) * 2));
                    const s16x4 vb = __builtin_amdgcn_ds_read_tr16_b64_v4i16((LAS s16x4*)(vbase + ((32 * s2 + 16) * AT_VS + 16 * dt) * 2));
                    vf[d2][s2] = __builtin_shufflevector(va, vb, 0, 1, 2, 3, 4, 5, 6, 7); }
#pragma unroll
            for (int s2 = 0; s2 < 2; ++s2)
#pragma unroll
                for (int d2 = 0; d2 < 2; ++d2) O[2 * dp + d2] = mfma_t(vf[d2][s2], __builtin_bit_cast(bf16x8, pw[s2]), O[2 * dp + d2]); }
        MFMA_POST8(O[0], O[1], O[2], O[3], O[4], O[5], O[6], O[7]);
        if (tau < 8) { __syncthreads(); if (SAMP && tau < 7) stage_f32(tau + 1); else store_tile(); __syncthreads(); }
    }
    float lt = lrun; lt += __shfl_xor(lt, 16); lt += __shfl_xor(lt, 32);
    const float inv = 1.0f / lt;
    bf16_t* yp = Y + (qrow0 + 16 * w4 + c) * D + h * HD + 4 * G4;
#pragma unroll
    for (int dt = 0; dt < 8; ++dt) { u32x2 w; w.x = pk2(O[dt][0] * inv, O[dt][1] * inv); w.y = pk2(O[dt][2] * inv, O[dt][3] * inv); *(u32x2*)(yp + 16 * dt) = w; }
}
constexpr int AT2_BUF = AT_TILE + AT_VTILE;
constexpr int AT2_TAB = 2 * AT2_BUF, AT2_BYTES = AT2_TAB + 260 * 4;
template <bool SAMP>
__device__ __forceinline__ void attn_unit2(const Args& a, LAS unsigned char* lds, int n, int cch, int h) {
    constexpr int QC = SAMP ? 1 : 2;
    unsigned char* ws = a.ws;
    const bf16_t* Qb = (const bf16_t*)(ws + WS_H); const bf16_t* Kb = Qb + (size_t)M * D; const bf16_t* Vb = Kb + (size_t)M * D; bf16_t* Y = (bf16_t*)(ws + WS_Y);
    const int tid = tid_fresh(), wave = __builtin_amdgcn_readfirstlane(tid >> 6), lane = tid & 63, G4 = lane >> 4, c = lane & 15;
    LAS float* tabs = (LAS float*)(lds + AT2_TAB);
    const int k0 = SAMP ? 0 : (cch < 8 ? 0 : cch - 8), k1 = SAMP ? 8 : cch + 1;
    __syncthreads();
    if (wave >= 4) {
        const int tp = tid - 256, prow = tp >> 4, scc = tp & 15;
        f32x4 R[SAMP ? 16 : 8];
        auto tile_load = [&](int kc) {
            if (SAMP && kc < 8) {
#pragma unroll
                for (int p = 0; p < 8; ++p) { const int r = prow + 16 * p, kv = r >> 6, key = r & 63;
                    const float* src = a.in[kv ? 5 : 4] + (((size_t)n * 512 + (size_t)kc * 64 + key) * NH + h) * HD + 8 * scc; R[2 * p] = *(const f32x4*)src; R[2 * p + 1] = *(const f32x4*)(src + 4); }
            } else {
#pragma unroll
                for (int p = 0; p < 8; ++p) { const int r = prow + 16 * p, kv = r >> 6, key = r & 63;
                    const size_t krow = SAMP ? (size_t)MP + (size_t)n * 64 + key : (size_t)n * SEQ + (size_t)kc * 64 + key;
                    R[p] = __builtin_bit_cast(f32x4, *(const u32x4*)((kv ? Vb : Kb) + krow * D + h * HD + 8 * scc)); } }
        };
        auto tile_store = [&](int kc, int buf) {
            LAS unsigned char* bb = lds + buf * AT2_BUF;
#pragma unroll
            for (int p = 0; p < 8; ++p) { const int r = prow + 16 * p, kv = r >> 6, key = r & 63; u32x4 w;
                if (SAMP && kc < 8) { const f32x4 x0 = R[2 * p], x1 = R[2 * p + 1]; w.x = pk2(x0[0], x0[1]); w.y = pk2(x0[2], x0[3]); w.z = pk2(x1[0], x1[1]); w.w = pk2(x1[2], x1[3]); }
                else w = __builtin_bit_cast(u32x4, R[p]);
                *(LAS u32x4*)(bb + (kv ? AT_TILE + (key * AT_VS + 8 * scc) * 2 : (key * AT_KS + 8 * scc) * 2)) = w; }
        };
        for (int i = tp; i < 257; i += 256) tabs[i] = a.in[18][(size_t)h * 257 + i];
        tile_load(k0); tile_store(k0, 0);
        if (k0 < k1) tile_load(k0 + 1);
        __syncthreads();
        for (int kc = k0; kc <= k1; ++kc) {
            if (kc < k1) { tile_store(kc + 1, (kc - k0 + 1) & 1); if (kc + 1 < k1) tile_load(kc + 2); }
            __syncthreads(); }
        return;
    }
    const int w4 = wave;
    bf16x8 Qf[QC][4]; f32x4 O[QC][8]; float mrun[QC], lrun[QC];
#pragma unroll
    for (int q = 0; q < QC; ++q) { const size_t qrow = SAMP ? (size_t)MP + (size_t)n * 64 : (size_t)n * SEQ + (size_t)(cch + q) * 64;
        const bf16_t* qp = Qb + (qrow + 16 * w4 + c) * D + h * HD + 8 * G4;
#pragma unroll
        for (int kk = 0; kk < 4; ++kk) Qf[q][kk] = *(const bf16x8*)(qp + 32 * kk);
#pragma unroll
        for (int i = 0; i < 8; ++i) { O[q][i] = (f32x4){0.f, 0.f, 0.f, 0.f}; OPAQUE(O[q][i]); }
        mrun[q] = -1e30f; lrun[q] = 0.f; }
    const int qi = 16 * w4 + c;
    __syncthreads();
    const float bconst = tabs[256];
    for (int kc = k0; kc <= k1; ++kc) {
        const LAS unsigned char* bb = lds + ((kc - k0) & 1) * AT2_BUF;
        const LAS unsigned char* kbase = bb + (c * AT_KS + 8 * G4) * 2;
        const LAS unsigned char* vbase = bb + AT_TILE + ((4 * G4 + (c >> 2)) * AT_VS + 4 * (c & 3)) * 2;
#pragma unroll
        for (int q = 0; q < QC; ++q) {
            const int tau = SAMP ? kc : kc - (cch + q) + 8;
            if (tau >= 0 && tau <= 8) {
                f32x4 sa[4];
#pragma unroll
                for (int sub = 0; sub < 4; ++sub) { sa[sub] = (f32x4){0.f, 0.f, 0.f, 0.f}; OPAQUE(sa[sub]); }
#pragma unroll
                for (int sub = 0; sub < 4; ++sub)
#pragma unroll
                    for (int kk = 0; kk < 4; ++kk) { const bf16x8 kf = *(const LAS bf16x8*)(kbase + (16 * sub * AT_KS + 32 * kk) * 2); sa[sub] = mfma_a(kf, Qf[q][kk], sa[sub]); }
                float mloc = -1e30f;
#pragma unroll
                for (int sub = 0; sub < 4; ++sub)
#pragma unroll
                    for (int i = 0; i < 4; ++i) { float bias = bconst;
                        if (tau >= 6) { int rel = qi - ((tau - 8) * 64 + 16 * sub + 4 * G4 + i); rel = rel > 128 ? 128 : rel; bias = tabs[rel + 128]; }
                        const float sv = sa[sub][i] * 0.08838834764831845f + bias; sa[sub][i] = sv; mloc = fmaxf(mloc, sv); }
                mloc = fmaxf(mloc, __shfl_xor(mloc, 16)); mloc = fmaxf(mloc, __shfl_xor(mloc, 32));
                const float mnew = fmaxf(mrun[q], mloc), alpha = __expf(mrun[q] - mnew); mrun[q] = mnew;
                float ps = 0.f;
#pragma unroll
                for (int sub = 0; sub < 4; ++sub)
#pragma unroll
                    for (int i = 0; i < 4; ++i) { const float p = __expf(sa[sub][i] - mnew); sa[sub][i] = p; ps += p; }
                lrun[q] = lrun[q] * alpha + ps;
                u32x4 pw[2];
#pragma unroll
                for (int s2 = 0; s2 < 2; ++s2) { pw[s2].x = pk2(sa[2 * s2][0], sa[2 * s2][1]); pw[s2].y = pk2(sa[2 * s2][2], sa[2 * s2][3]); pw[s2].z = pk2(sa[2 * s2 + 1][0], sa[2 * s2 + 1][1]); pw[s2].w = pk2(sa[2 * s2 + 1][2], sa[2 * s2 + 1][3]); }
#pragma unroll
                for (int i = 0; i < 8; ++i) O[q][i] = O[q][i] * alpha;
#pragma unroll
                for (int dt = 0; dt < 8; ++dt)
#pragma unroll
                    for (int s2 = 0; s2 < 2; ++s2) {
                        const s16x4 va = __builtin_amdgcn_ds_read_tr16_b64_v4i16((LAS s16x4*)(vbase + ((32 * s2) * AT_VS + 16 * dt) * 2));
                        const s16x4 vb = __builtin_amdgcn_ds_read_tr16_b64_v4i16((LAS s16x4*)(vbase + ((32 * s2 + 16) * AT_VS + 16 * dt) * 2));
                        O[q][dt] = mfma_a(__builtin_shufflevector(va, vb, 0, 1, 2, 3, 4, 5, 6, 7), __builtin_bit_cast(bf16x8, pw[s2]), O[q][dt]); }
            }
        }
        __syncthreads();
    }
#pragma unroll
    for (int q = 0; q < QC; ++q) {
        float lt = lrun[q]; lt += __shfl_xor(lt, 16); lt += __shfl_xor(lt, 32);
        const float inv = 1.0f / lt;
        const size_t qrow = SAMP ? (size_t)MP + (size_t)n * 64 : (size_t)n * SEQ + (size_t)(cch + q) * 64;
        bf16_t* yp = Y + (qrow + 16 * w4 + c) * D + h * HD + 4 * G4;
#pragma unroll
        for (int dt = 0; dt < 8; ++dt) { u32x2 w; w.x = pk2(O[q][dt][0] * inv, O[q][dt][1] * inv); w.y = pk2(O[q][dt][2] * inv, O[q][dt][3] * inv); *(u32x2*)(yp + 16 * dt) = w; } }
}
__device__ __forceinline__ void ph_attn(const Args& a, LAS unsigned char* lds, int nblk, int b) {
    const int nper = (1536 + nblk - 1) / nblk;
    for (int i = 0; i < nper; ++i) { const int ii = (b & 1) ? (i + 4) % nper : i; const int u = b + ii * nblk; if (u >= 1536) continue;
        if (u < 1024) attn_unit2<false>(a, lds, u >> 8, 2 * ((u >> 4) & 15), u & 15);
        else { const int u2 = u - 1024; attn_unit2<true>(a, lds, u2 >> 4, 8, u2 & 15); }
    }
}

constexpr int HG_S = 136;
constexpr int HG_T64 = 64 * HG_S * 2;
constexpr int HGZ_QT = 0, HGZ_KT = HG_T64, HGZ_QH = 2 * HG_T64, HGZ_IS = 3 * HG_T64, HGZ_SS = 4 * HG_T64, HGZ_PART = HGZ_SS + 128 * HG_S * 2, HGZ_RED = HGZ_PART + 4096, HGZ_BYTES = HGZ_RED + 512;
constexpr int HGX_KH = 0, HGX_IS = HG_T64, HGX_PART = 2 * HG_T64, HGX_DK = HGX_PART + 4096, HGX_OUT = HGX_DK + 512, HGX_BYTES = HGX_OUT + 8 * 4096;
constexpr size_t SCR_DS = 0;
constexpr size_t SCR_DK = SCR_DS + (size_t)2048 * 16384 * 2;
constexpr size_t SCR_SP = SCR_DK + (size_t)2048 * 128 * 4;
static_assert(SCR_SP + (size_t)2048 * 16384 * 2 <= SCR_PART && SCR_PART + (size_t)3 * MS * D * 4 <= 252 * MiB, "scratch map");
struct HgPrep { float g[8][2]; float p[8][2]; float pref[2]; };
__device__ __forceinline__ void hg_loadf(const unsigned short* Fp, int kp, int tq, unsigned (&fv)[8]) {
#pragma unroll
    for (int j = 0; j < 8; ++j) fv[j] = *(const unsigned*)(Fp + (size_t)(8 * tq + j) * D + 2 * kp);
}
__device__ __forceinline__ void hg_prep(const unsigned (&fv)[8], LAS float* part, int kp, int tq, HgPrep& P) {
    float c0 = 1.f, c1 = 1.f;
#pragma unroll
    for (int j = 0; j < 8; ++j) { const f32x2 g = uph2(fv[j]); P.g[j][0] = g[0]; P.g[j][1] = g[1]; c0 *= 1.0f - g[0]; c1 *= 1.0f - g[1]; P.p[j][0] = c0; P.p[j][1] = c1; }
    *(LAS f32x2*)(part + tq * 128 + 2 * kp) = (f32x2){c0, c1};
    __syncthreads();
    float base0 = 1.f, base1 = 1.f, r0 = 1.f, r1 = 1.f;
#pragma unroll
    for (int q = 0; q < 8; ++q) { const f32x2 pp = *(const LAS f32x2*)(part + q * 128 + 2 * kp); if (q < tq) { base0 *= pp[0]; base1 *= pp[1]; } if (q < 4) { r0 *= pp[0]; r1 *= pp[1]; } }
#pragma unroll
    for (int j = 0; j < 8; ++j) { P.p[j][0] *= base0; P.p[j][1] *= base1; }
    P.pref[0] = r0; P.pref[1] = r1;
}
__device__ __forceinline__ bf16x8 tr2(const LAS unsigned char* p0, const LAS unsigned char* p1) {
    const s16x4 va = __builtin_amdgcn_ds_read_tr16_b64_v4i16((LAS s16x4*)p0), vb = __builtin_amdgcn_ds_read_tr16_b64_v4i16((LAS s16x4*)p1);
    return __builtin_shufflevector(va, vb, 0, 1, 2, 3, 4, 5, 6, 7);
}
__device__ __forceinline__ void hg_decode(int u, bool& samp, int& n, int& h, int& ch, size_t& row0) {
    if (u < 2048) { samp = false; ch = u & 31; h = (u >> 5) & 15; n = u >> 9; row0 = (size_t)n * SEQ + (size_t)ch * 64; }
    else { samp = true; const int u2 = u - 2048; h = u2 & 15; n = u2 >> 4; ch = 0; row0 = (size_t)MP + (size_t)n * 64; }
}
constexpr int HX2_KH = 0, HX2_IS = HG_T64, HX2_DK = 2 * HG_T64, HX2_BUF = HX2_DK + 512, HX2_OUT = 2 * HX2_BUF, HX2_BYTES = HX2_OUT + 4 * 8192;
__device__ __forceinline__ void ph_hgrn_x(const Args& a, LAS unsigned char* lds, int nblk, int b) {
    unsigned char* ws = a.ws; const bf16_t* Ib = (const bf16_t*)(ws + WS_H) + (size_t)M * D; const unsigned short* F = (const unsigned short*)(ws + WS_Z);
    const int tid = tid_fresh(), wave = __builtin_amdgcn_readfirstlane(tid >> 6), lane = tid & 63, G4 = lane >> 4, c = lane & 15;
    const int nun = (2560 - b + nblk - 1) / nblk;
    __syncthreads();
    if (wave >= 4) {
        unsigned fv[64]; u32x4 iv[8];
        auto pload = [&](int u) {
            bool samp; int n, h, ch; size_t row0; hg_decode(u, samp, n, h, ch, row0);
            if (wave == 4) { const unsigned short* Fp = F + row0 * D + h * 128 + 2 * lane;
#pragma unroll
                for (int j = 0; j < 64; ++j) fv[j] = *(const unsigned*)(Fp + (size_t)j * D);
            } else if (wave < 7) { const int t2 = tid - 320, r = t2 >> 1, hf = t2 & 1; const u32x4* src = (const u32x4*)(Ib + (row0 + r) * D + h * 128 + 64 * hf);
#pragma unroll
                for (int i = 0; i < 8; ++i) iv[i] = src[i]; }
        };
        auto pstore = [&](int u, int buf) {
            LAS unsigned char* bb = lds + buf * HX2_BUF;
            if (wave == 4) { float r0 = 1.f, r1 = 1.f;
#pragma unroll
                for (int j = 63; j >= 0; --j) { const f32x2 g = uph2(fv[j]);
                    *(LAS unsigned*)(bb + HX2_KH + (j * HG_S + 2 * lane) * 2) = pk2(g[0] * r0, g[1] * r1); r0 *= 1.0f - g[0]; r1 *= 1.0f - g[1]; }
                *(LAS f32x2*)(bb + HX2_DK + 8 * lane) = (f32x2){r0, r1};
                if (u < 2048) *(f32x2*)((float*)(ws + WS_SCR + SCR_DK) + (size_t)u * 128 + 2 * lane) = (f32x2){r0, r1};
            } else if (wave < 7) { const int t2 = tid - 320, r = t2 >> 1, hf = t2 & 1; LAS u32x4* dst = (LAS u32x4*)(bb + HX2_IS + (r * HG_S + 64 * hf) * 2);
#pragma unroll
                for (int i = 0; i < 8; ++i) dst[i] = iv[i]; }
        };
        pload(b); pstore(b, 0);
        if (nun > 1) pload(b + nblk);
        __syncthreads();
        for (int i = 0; i < nun; ++i) { if (i + 1 < nun) { pstore(b + (i + 1) * nblk, (i + 1) & 1); if (i + 2 < nun) pload(b + (i + 2) * nblk); } __syncthreads(); }
        return;
    }
    __syncthreads();
    for (int i = 0; i < nun; ++i) {
        const int u = b + i * nblk; bool samp; int n, h, ch; size_t row0; hg_decode(u, samp, n, h, ch, row0);
        const LAS unsigned char* bb = lds + (i & 1) * HX2_BUF; const LAS float* dk = (const LAS float*)(bb + HX2_DK);
        LAS unsigned char* ost = lds + HX2_OUT + wave * 8192;
        const LAS unsigned char* ia = bb + HX2_IS + ((8 * G4 + (c >> 2)) * HG_S + 4 * (c & 3)) * 2;
        bf16x8 kfr[2][2], ifr[8][2];
#pragma unroll
        for (int m2 = 0; m2 < 2; ++m2) { const LAS unsigned char* ka = bb + HX2_KH + ((8 * G4 + (c >> 2)) * HG_S + 16 * (2 * wave + m2) + 4 * (c & 3)) * 2;
#pragma unroll
            for (int kt = 0; kt < 2; ++kt) kfr[m2][kt] = tr2(ka + (32 * kt) * HG_S * 2, ka + (32 * kt + 4) * HG_S * 2); }
#pragma unroll
        for (int nv = 0; nv < 8; ++nv)
#pragma unroll
            for (int kt = 0; kt < 2; ++kt) ifr[nv][kt] = tr2(ia + ((32 * kt) * HG_S + 16 * nv) * 2, ia + ((32 * kt + 4) * HG_S + 16 * nv) * 2);
        const float dkc0 = dk[32 * wave + c], dkc1 = dk[32 * wave + 16 + c];
#pragma unroll
        for (int m2 = 0; m2 < 2; ++m2) { const int mk = 2 * wave + m2;
            f32x4 acc[8];
#pragma unroll
            for (int nv = 0; nv < 8; ++nv) { acc[nv] = (f32x4){0.f, 0.f, 0.f, 0.f}; OPAQUE(acc[nv]); }
#pragma unroll
            for (int kt = 0; kt < 2; ++kt)
#pragma unroll
                for (int nv = 0; nv < 8; ++nv) acc[nv] = mfma_a(ifr[nv][kt], kfr[m2][kt], acc[nv]);
            if (!samp) {
#pragma unroll
                for (int nv = 0; nv < 8; ++nv) { u32x2 w; w.x = pk2(acc[nv][0], acc[nv][1]); w.y = pk2(acc[nv][2], acc[nv][3]); *(LAS u32x2*)(ost + m2 * 4096 + (c * 128 + 16 * nv + 4 * G4) * 2) = w; }
            } else { const size_t so = (((size_t)n * NH + h) * 128 + 16 * mk + c) * 128 + 4 * G4; const float dkc = m2 ? dkc1 : dkc0; f32x4 s0[8];
#pragma unroll
                for (int nv = 0; nv < 8; ++nv) s0[nv] = *(const f32x4*)(a.in[6] + so + 16 * nv);
#pragma unroll
                for (int nv = 0; nv < 8; ++nv) *(f32x4*)(a.out + O_HS + so + 16 * nv) = dkc * s0[nv] + acc[nv]; } }
        if (!samp) {
            asm volatile("s_waitcnt lgkmcnt(0)" ::: "memory");
            bf16_t* dsu = (bf16_t*)(ws + WS_SCR + SCR_DS) + (size_t)u * 16384 + (size_t)(32 * wave) * 128;
#pragma unroll
            for (int q = 0; q < 8; ++q) { const int row = 4 * q + (lane >> 4), chq = lane & 15; *(u32x4*)(dsu + row * 128 + 8 * chq) = *(const LAS u32x4*)(ost + (row * 128 + 8 * chq) * 2); }
            asm volatile("s_waitcnt lgkmcnt(0)" ::: "memory");
        }
        __syncthreads();
    }
}
__device__ __forceinline__ void ph_hgrn_y(const Args& a, int nblk, int b) {
    unsigned char* ws = a.ws; const bf16_t* DS = (const bf16_t*)(ws + WS_SCR + SCR_DS); const float* DK = (const float*)(ws + WS_SCR + SCR_DK); bf16_t* SP = (bf16_t*)(ws + WS_SCR + SCR_SP);
    const int nth = nblk * 512;
    const int tid = tid_fresh();
    for (int e4 = b * 512 + tid; e4 < 64 * 4096; e4 += nth) {
        const int pr = e4 >> 12, off = (e4 & 4095) * 4, k = off >> 7;
        f32x4 S = (f32x4){0.f, 0.f, 0.f, 0.f};
#pragma unroll 1
        for (int c8 = 0; c8 < 32; c8 += 8) {
            f32x4 d[8]; float dk[8];
#pragma unroll
            for (int i = 0; i < 8; ++i) { const size_t u = (size_t)pr * 32 + c8 + i; const u32x2 w = *(const u32x2*)(DS + u * 16384 + off);
                d[i] = (f32x4){__builtin_bit_cast(float, w.x << 16), __builtin_bit_cast(float, w.x & 0xffff0000u), __builtin_bit_cast(float, w.y << 16), __builtin_bit_cast(float, w.y & 0xffff0000u)}; dk[i] = DK[u * 128 + k]; }
#pragma unroll
            for (int i = 0; i < 8; ++i) { const size_t u = (size_t)pr * 32 + c8 + i;
                u32x2 w; w.x = pk2(S[0], S[1]); w.y = pk2(S[2], S[3]); *(u32x2*)(SP + u * 16384 + off) = w; S = S * dk[i] + d[i]; } }
        *(f32x4*)(a.out + O_HP + (size_t)pr * 16384 + off) = S;
    }
}
__device__ __forceinline__ void ph_hgrn_z(const Args& a, LAS unsigned char* lds, int nblk, int b) {
    unsigned char* ws = a.ws; const bf16_t* Qb = (const bf16_t*)(ws + WS_H); const bf16_t* Ib = Qb + (size_t)M * D; const bf16_t* Gb = Ib + (size_t)M * D; const unsigned short* F = (const unsigned short*)(ws + WS_Z);
    bf16_t* Y = (bf16_t*)(ws + WS_Y); const bf16_t* SP = (const bf16_t*)(ws + WS_SCR + SCR_SP);
    const int tid = tid_fresh(), wave = __builtin_amdgcn_readfirstlane(tid >> 6), lane = tid & 63, G4 = lane >> 4, c = lane & 15, kp = tid & 63, tq = tid >> 6;
    LAS float* part = (LAS float*)(lds + HGZ_PART); LAS float* red = (LAS float*)(lds + HGZ_RED);
    const int mt = wave;
    unsigned fF[8]; unsigned fQ[8]; u32x4 fI[2]; f32x4 fS[8];
    auto ldunit = [&](int u2) { bool s2; int n2, h2, c2; size_t r2; hg_decode(u2, s2, n2, h2, c2, r2); hg_loadf(F + r2 * D + h2 * 128, kp, tq, fF);
#pragma unroll
        for (int j = 0; j < 8; ++j) fQ[j] = *(const unsigned*)(Qb + (r2 + 8 * tq + j) * D + h2 * 128 + 2 * kp);
        const u32x4* src = (const u32x4*)(Ib + (r2 + (tid >> 3)) * D + h2 * 128 + 16 * (tid & 7)); fI[0] = src[0]; fI[1] = src[1];
        const int r = tid >> 2, cq = tid & 3;
        if (!s2) { const u32x4* sp = (const u32x4*)(SP + (size_t)u2 * 16384 + r * 128 + 32 * cq);
#pragma unroll
            for (int i = 0; i < 4; ++i) fS[i] = __builtin_bit_cast(f32x4, sp[i]); }
        else { const f32x4* sp = (const f32x4*)(a.in[6] + (((size_t)n2 * NH + h2) * 128 + r) * 128 + 32 * cq);
#pragma unroll
            for (int i = 0; i < 8; ++i) fS[i] = sp[i]; } };
    __syncthreads();
    if (tid < 128) red[tid] = a.in[22][tid];
    if (b < 2560) ldunit(b);
    for (int u = b; u < 2560; u += nblk) {
        bool samp; int n, h, ch; size_t row0; hg_decode(u, samp, n, h, ch, row0);
        __syncthreads();
        HgPrep P; hg_prep(fF, part, kp, tq, P);
#pragma unroll
        for (int j = 0; j < 8; ++j) { const int t = 8 * tq + j; const unsigned qw = fQ[j];
            const float q0 = __builtin_bit_cast(float, qw << 16), q1 = __builtin_bit_cast(float, qw & 0xffff0000u);
            const float ir0 = __builtin_amdgcn_rcpf(P.pref[0]), ir1 = __builtin_amdgcn_rcpf(P.pref[1]), ip0 = __builtin_amdgcn_rcpf(P.p[j][0]), ip1 = __builtin_amdgcn_rcpf(P.p[j][1]);
            *(LAS unsigned*)(lds + HGZ_QT + (t * HG_S + 2 * kp) * 2) = pk2(q0 * P.p[j][0] * ir0, q1 * P.p[j][1] * ir1);
            *(LAS unsigned*)(lds + HGZ_KT + (t * HG_S + 2 * kp) * 2) = pk2(P.g[j][0] * P.pref[0] * ip0, P.g[j][1] * P.pref[1] * ip1);
            *(LAS unsigned*)(lds + HGZ_QH + (t * HG_S + 2 * kp) * 2) = pk2(q0 * P.p[j][0], q1 * P.p[j][1]); }
        { const int r = tid >> 3, cq = tid & 7; LAS u32x4* dst = (LAS u32x4*)(lds + HGZ_IS + (r * HG_S + 16 * cq) * 2); dst[0] = fI[0]; dst[1] = fI[1]; }
        { const int r = tid >> 2, cq = tid & 3; LAS u32x4* dst = (LAS u32x4*)(lds + HGZ_SS + (r * HG_S + 32 * cq) * 2);
          if (!samp) {
#pragma unroll
              for (int i = 0; i < 4; ++i) dst[i] = __builtin_bit_cast(u32x4, fS[i]); }
          else {
#pragma unroll
              for (int i = 0; i < 4; ++i) { const f32x4 x0 = fS[2 * i], x1 = fS[2 * i + 1]; u32x4 w; w.x = pk2(x0[0], x0[1]); w.y = pk2(x0[2], x0[3]); w.z = pk2(x1[0], x1[1]); w.w = pk2(x1[2], x1[3]); dst[i] = w; } } }
        if (u + nblk < 2560) ldunit(u + nblk);
        __syncthreads();
        if (wave < 4) {
        const size_t yo = (row0 + 16 * mt + c) * D + h * 128 + 4 * G4;
        bf16x8 Qf[4], kf[4][4], vf0[8];
#pragma unroll
        for (int kk = 0; kk < 4; ++kk) Qf[kk] = *(const LAS bf16x8*)(lds + HGZ_QT + ((16 * mt + c) * HG_S + 32 * kk + 8 * G4) * 2);
#pragma unroll
        for (int ns = 0; ns < 4; ++ns)
#pragma unroll
            for (int kk = 0; kk < 4; ++kk) kf[ns][kk] = *(const LAS bf16x8*)(lds + HGZ_KT + ((16 * ns + c) * HG_S + 32 * kk + 8 * G4) * 2);
        const LAS unsigned char* ia = lds + HGZ_IS + ((4 * G4 + (c >> 2)) * HG_S + 4 * (c & 3)) * 2;
        const LAS unsigned char* sa = lds + HGZ_SS + ((8 * G4 + (c >> 2)) * HG_S + 4 * (c & 3)) * 2;
#pragma unroll
        for (int j = 0; j < 8; ++j) vf0[j] = tr2(ia + (16 * j) * 2, ia + (16 * HG_S + 16 * j) * 2);
        f32x4 At[4];
#pragma unroll
        for (int ns = 0; ns < 4; ++ns) { At[ns] = (f32x4){0.f, 0.f, 0.f, 0.f}; OPAQUE(At[ns]); }
#pragma unroll
        for (int kk = 0; kk < 4; ++kk)
#pragma unroll
            for (int ns = 0; ns < 4; ++ns) At[ns] = mfma_a(kf[ns][kk], Qf[kk], At[ns]);
        u32x2 gwv[8];
#pragma unroll
        for (int j = 0; j < 8; ++j) gwv[j] = *(const u32x2*)(Gb + yo + 16 * j);
        bf16x8 vf1[8], qh[4], sf[2][8];
#pragma unroll
        for (int j = 0; j < 8; ++j) vf1[j] = tr2(ia + ((32) * HG_S + 16 * j) * 2, ia + ((32 + 16) * HG_S + 16 * j) * 2);
#pragma unroll
        for (int kk = 0; kk < 4; ++kk) qh[kk] = *(const LAS bf16x8*)(lds + HGZ_QH + ((16 * mt + c) * HG_S + 32 * kk + 8 * G4) * 2);
#pragma unroll
        for (int ns = 0; ns < 4; ++ns)
#pragma unroll
            for (int i = 0; i < 4; ++i) if (16 * ns + 4 * G4 + i > 16 * mt + c) At[ns][i] = 0.f;
        f32x4 o[8];
#pragma unroll
        for (int j = 0; j < 8; ++j) { o[j] = (f32x4){0.f, 0.f, 0.f, 0.f}; OPAQUE(o[j]); }
        u32x4 pw[2];
#pragma unroll
        for (int ks = 0; ks < 2; ++ks) { pw[ks].x = pk2(At[2 * ks][0], At[2 * ks][1]); pw[ks].y = pk2(At[2 * ks][2], At[2 * ks][3]); pw[ks].z = pk2(At[2 * ks + 1][0], At[2 * ks + 1][1]); pw[ks].w = pk2(At[2 * ks + 1][2], At[2 * ks + 1][3]); }
#pragma unroll
        for (int j = 0; j < 8; ++j) o[j] = mfma_a(vf0[j], __builtin_bit_cast(bf16x8, pw[0]), o[j]);
#pragma unroll
        for (int j = 0; j < 8; ++j) sf[0][j] = tr2(sa + (16 * j) * 2, sa + (4 * HG_S + 16 * j) * 2);
#pragma unroll
        for (int j = 0; j < 8; ++j) o[j] = mfma_a(vf1[j], __builtin_bit_cast(bf16x8, pw[1]), o[j]);
#pragma unroll
        for (int kk = 0; kk < 4; ++kk) {
            if (kk < 3) {
#pragma unroll
                for (int j = 0; j < 8; ++j) sf[(kk + 1) & 1][j] = tr2(sa + ((32 * (kk + 1)) * HG_S + 16 * j) * 2, sa + ((32 * (kk + 1) + 4) * HG_S + 16 * j) * 2); }
#pragma unroll
            for (int j = 0; j < 8; ++j) o[j] = mfma_a(sf[kk & 1][j], qh[kk], o[j]); }
        float ss = 0.f;
#pragma unroll
        for (int j = 0; j < 8; ++j)
#pragma unroll
            for (int i = 0; i < 4; ++i) ss += o[j][i] * o[j][i];
        ss += __shfl_xor(ss, 16); ss += __shfl_xor(ss, 32);
        const float sc = 1.0f / sqrtf(ss * (1.0f / 128.0f) + RMS_EPS);
#pragma unroll
        for (int j = 0; j < 8; ++j) { const u32x2 gw = gwv[j]; const f32x4 ng = *(const LAS f32x4*)(red + 16 * j + 4 * G4);
            const float g0 = __builtin_bit_cast(float, gw.x << 16), g1 = __builtin_bit_cast(float, gw.x & 0xffff0000u), g2 = __builtin_bit_cast(float, gw.y << 16), g3 = __builtin_bit_cast(float, gw.y & 0xffff0000u);
            u32x2 w; w.x = pk2(o[j][0] * sc * ng[0] * g0 * sigmoidf_(g0), o[j][1] * sc * ng[1] * g1 * sigmoidf_(g1)); w.y = pk2(o[j][2] * sc * ng[2] * g2 * sigmoidf_(g2), o[j][3] * sc * ng[3] * g3 * sigmoidf_(g3));
            *(u32x2*)(Y + yo + 16 * j) = w; }
        }
    }
}

template <int L> __device__ __forceinline__ void do_layer(const Args& a, LAS unsigned char* lds, const XcdBarrier& bar, int G, int b) {
    unsigned char* ws = a.ws;
    bf16_t* XB = (bf16_t*)(ws + WS_XB); bf16_t* Z = (bf16_t*)(ws + WS_Z); unsigned short* ZF = (unsigned short*)(ws + WS_Z); bf16_t* H = (bf16_t*)(ws + WS_H); bf16_t* Y = (bf16_t*)(ws + WS_Y);
    constexpr int kind = L % 3, j = L / 3; bf16_t* PS = (bf16_t*)(ws + WS_SCR + SCR_PART);
    if constexpr (kind == 0) {
        if (G != 256) ph_ssm<L == 0>(a, lds, j, L, G, b); else if (L == 0) ph_ssm_l0(a, lds, G, b); else ph_ssm_split(a, lds, j, L, b);
        xcd_barrier(bar);
        pg8::Gemm g{Y, (const bf16_t*)(ws + WS_WSSM) + (size_t)j * 4096 * D, D, D}; pg8::BStatOrder S; S.init(M, 4096, D, b);
        EpiSsmGate E{Z}; pg8::gemm_phase<EpiSsmGate, pg8::BStatOrder>(lds, g, S, E);
    } else if constexpr (kind == 1) {
        { pg8::Gemm g{XB, (const bf16_t*)(ws + WS_WQKV), D, D}; pg8::BStatOrder S; S.init(M, 6144, D, b);
          EpiQkv E{H, a.out}; pg8::gemm_phase<EpiQkv, pg8::BStatOrder>(lds, g, S, E); }
        xcd_barrier(bar);
        ph_attn(a, lds, G, b);
        xcd_barrier(bar);
        { pg8::Gemm g{Y, (const bf16_t*)(ws + WS_WAO), D, D}; pg8::SplitOrder S; S.init(D, b);
          EpiRes E{Z, PS}; pg8::gemm_phase<EpiRes, pg8::SplitOrder>(lds, g, S, E); }
    } else {
        { pg8::Gemm g{XB, (const bf16_t*)(ws + WS_WHIN), D, D}; pg8::BStatOrder S; S.init(M, 8192, D, b);
          EpiHgrnIn E{H, ZF, (const float*)(ws + WS_PAR + PAR_LB)}; pg8::gemm_phase<EpiHgrnIn, pg8::BStatOrder>(lds, g, S, E); }
        xcd_barrier(bar);
        ph_hgrn_x(a, lds, G, b);
        xcd_barrier(bar);
        ph_hgrn_y(a, G, b);
        xcd_barrier(bar);
        ph_hgrn_z(a, lds, G, b);
        xcd_barrier(bar);
        { pg8::Gemm g{Y, (const bf16_t*)(ws + WS_WHO), D, D}; pg8::SplitOrder S; S.init(D, b);
          EpiRes E{Z, PS}; pg8::gemm_phase<EpiRes, pg8::SplitOrder>(lds, g, S, E); }
    }
    xcd_barrier(bar);
    ph_ln(a, L, 0, false, kind != 0, false, L == 0, G, b);
    xcd_barrier(bar);
    { pg8::Gemm g{XB, (const bf16_t*)(ws + WS_WF1) + (size_t)L * FF * D, D, D}; pg8::BStatOrder S; S.init(M, FF, D, b);
      EpiFfn1 E{H}; pg8::gemm_phase<EpiFfn1, pg8::BStatOrder>(lds, g, S, E); }
    xcd_barrier(bar);
    { pg8::Gemm g{H, (const bf16_t*)(ws + WS_WF2) + (size_t)L * FF * D, FF, FF}; pg8::SplitOrder S; S.init(FF, b);
      EpiRes E{Z, PS}; pg8::gemm_phase<EpiRes, pg8::SplitOrder, true>(lds, g, S, E); }
    xcd_barrier(bar);
    ph_ln(a, L, 1, L == 3, true, L == 2, false, G, b);
    if constexpr (L < 3) xcd_barrier(bar);
}
constexpr int LDS_BAR_OFF = 139264;
constexpr int LDS_BYTES = LDS_BAR_OFF + 1024;
static_assert(pg8::STAGE_BYTES <= LDS_BAR_OFF && HGZ_BYTES <= LDS_BAR_OFF && HX2_BYTES <= LDS_BAR_OFF && AT2_BYTES <= LDS_BAR_OFF && SSM_EXCH + 8 * 64 * 8 <= LDS_BAR_OFF && 2 * SSM_WLDS + 6 * CONV_LDS <= LDS_BAR_OFF && CONV_LDS >= SSM_WLDS && 8 * CONV_LDS + 64 <= LDS_BAR_OFF && LDS_BYTES <= 160 * 1024 && SSM_L0_X % 64 == 0, "LDS map");
constexpr int CW_BAR = 4096;
__global__ void __launch_bounds__(512, 2) k_mega(Args a) {
    extern __shared__ __attribute__((aligned(16))) unsigned char lds_raw[];
    LAS unsigned char* lds = (LAS unsigned char*)lds_raw;
    unsigned char* ws = a.ws;
    if (threadIdx.x < 4) ((LAS unsigned*)(lds + LDS_BAR_OFF))[threadIdx.x] = 0u;
    __syncthreads();
    const XcdBarrier bar = xcd_barrier_post((unsigned*)(ws + WS_CTL) + CW_BAR, (volatile LAS unsigned*)(lds + LDS_BAR_OFF));
    const int G = gridDim.x, b = blockIdx.x;
    ph_params(a, G, b);
    xcd_barrier(bar);
    do_layer<0>(a, lds, bar, G, b);
    do_layer<1>(a, lds, bar, G, b);
    do_layer<2>(a, lds, bar, G, b);
    do_layer<3>(a, lds, bar, G, b);
}

extern "C" void kernel_launch(void* const* d_in, const int* in_sizes, int n_in, void* d_out, int out_size, void* d_ws, size_t ws_size, hipStream_t stream) {
    static int grid = 0;
    if (grid == 0) {
        if (n_in != 30 || (size_t)out_size != O_END || ws_size < WS_END) { fprintf(stderr, "kernel_launch: unexpected shapes (n_in %d out %d ws %zu, need %zu)\n", n_in, out_size, ws_size, (size_t)WS_END); grid = -1; return; }
        int dev = 0, cus = 0, per_cu = 0;
        if (hipGetDevice(&dev) != hipSuccess || hipDeviceGetAttribute(&cus, hipDeviceAttributeMultiprocessorCount, dev) != hipSuccess) { grid = -1; return; }
        if (hipFuncSetAttribute((const void*)k_mega, hipFuncAttributeMaxDynamicSharedMemorySize, LDS_BYTES) != hipSuccess) { fprintf(stderr, "kernel_launch: hipFuncSetAttribute failed\n"); grid = -1; return; }
        if (hipOccupancyMaxActiveBlocksPerMultiprocessor(&per_cu, (const void*)k_mega, 512, LDS_BYTES) != hipSuccess || per_cu < 1) fprintf(stderr, "kernel_launch: occupancy query says %d\n", per_cu);
        (void)hipGetLastError();
        grid = cus;
    }
    if (grid < 0) return;
    (void)hipMemsetAsync((char*)d_ws + WS_CTL, 0, 64 * 1024, stream);
    Args a{}; for (int i = 0; i < 30; ++i) a.in[i] = (const float*)d_in[i]; a.out = (float*)d_out; a.ws = (unsigned char*)d_ws;
    hipLaunchKernelGGL(k_mega, dim3(grid), dim3(512), LDS_BYTES, stream, a);
}
```

```cpp
#include <hip/hip_runtime.h>
#include <cstdio>
#include <cstdint>

#define LAS __attribute__((address_space(3)))
typedef unsigned short bf16_t;
typedef short bf16x8 __attribute__((ext_vector_type(8)));
typedef float f32x4 __attribute__((ext_vector_type(4)));
typedef float f32x2 __attribute__((ext_vector_type(2)));
typedef unsigned u32x4 __attribute__((ext_vector_type(4)));
typedef unsigned u32x2 __attribute__((ext_vector_type(2)));

constexpr int D = 2048, SEQ = 2048, NB = 4, DB = 32, DSEQ = 64, FF = 8192;
constexpr int MP = NB * SEQ, MS = DB * DSEQ, M = MP + MS;
constexpr int NG = 128, NP = 64, NQ = 16;
constexpr int NH = 16, HD = 128;
constexpr float ALPHA = 1.6817928305074290f;
constexpr float LN_EPS = 1e-5f, RMS_EPS = 1e-6f;
constexpr size_t O_YP = 0, O_YS = O_YP + (size_t)MP * D, O_SRP = O_YS + (size_t)MS * D, O_SIP = O_SRP + 2 * NB * NG * NP,
                 O_KP = O_SIP + 2 * NB * NG * NP, O_VP = O_KP + (size_t)NB * 512 * D, O_HP = O_VP + (size_t)NB * 512 * D,
                 O_SRS = O_HP + (size_t)NB * NH * 128 * 128, O_SIS = O_SRS + 2 * DB * NG * NP, O_KS = O_SIS + 2 * DB * NG * NP,
                 O_VS = O_KS + (size_t)MS * D, O_HS = O_VS + (size_t)MS * D, O_END = O_HS + (size_t)DB * NH * 128 * 128;

constexpr size_t MiB = 1u << 20;
constexpr size_t WS_CTL = 0;
constexpr size_t WS_WSSM = 1 * MiB;
constexpr size_t WS_WQKV = WS_WSSM + 32 * MiB;
constexpr size_t WS_WAO = WS_WQKV + 24 * MiB;
constexpr size_t WS_WHIN = WS_WAO + 8 * MiB;
constexpr size_t WS_WHO = WS_WHIN + 32 * MiB;
constexpr size_t WS_WF1 = WS_WHO + 8 * MiB;
constexpr size_t WS_WF2 = WS_WF1 + 128 * MiB;
constexpr size_t WS_X = WS_WF2 + 128 * MiB;
constexpr size_t WS_XB = WS_X + 80 * MiB;
constexpr size_t WS_Z = WS_XB + 40 * MiB;
constexpr size_t WS_H = WS_Z + 80 * MiB;
constexpr size_t WS_Y = WS_H + 160 * MiB;
constexpr size_t WS_PAR = WS_Y + 40 * MiB;
constexpr size_t WS_SCR = WS_PAR + 8 * MiB;
constexpr size_t WS_END = WS_SCR + 252 * MiB;
constexpr size_t SCR_PART = 200 * MiB;
constexpr size_t PAR_ABAR = 0;
constexpr size_t PAR_BBAR = PAR_ABAR + 2 * NG * NP * 2 * 4;
constexpr size_t PAR_LB = PAR_BBAR + (size_t)2 * NG * NP * NQ * 2 * 4;
constexpr size_t PAR_BFRAG = PAR_LB + D * 4;
constexpr size_t PAR_CFRAG = PAR_BFRAG + (size_t)2 * NG * 8 * 64 * 16;
constexpr size_t PAR_END = PAR_CFRAG + (size_t)2 * NG * 4 * 64 * 16;
static_assert(PAR_END <= 8 * MiB, "params region");

__device__ __forceinline__ unsigned f2bf(float f) { unsigned u = __builtin_bit_cast(unsigned, f); return (u + 0x7fffu + ((u >> 16) & 1u)) >> 16; }
typedef __bf16 bf16x2_t __attribute__((ext_vector_type(2)));
__device__ __forceinline__ unsigned pk2(float lo, float hi) { const f32x2 v = {lo, hi}; return __builtin_bit_cast(unsigned, __builtin_convertvector(v, bf16x2_t)); }
typedef _Float16 f16x2_t __attribute__((ext_vector_type(2)));
__device__ __forceinline__ unsigned pkh2(float lo, float hi) { const f32x2 v = {lo, hi}; return __builtin_bit_cast(unsigned, __builtin_convertvector(v, f16x2_t)); }
__device__ __forceinline__ f32x2 uph2(unsigned w) { return __builtin_convertvector(__builtin_bit_cast(f16x2_t, w), f32x2); }
__device__ __forceinline__ float bf2f(bf16_t b) { return __builtin_bit_cast(float, (unsigned)b << 16); }
__device__ __forceinline__ float sigmoidf_(float x) { return __builtin_amdgcn_rcpf(1.0f + __expf(-x)); }
__device__ __forceinline__ float gelu_tanh(float x) { const float t = 1.5957691216057308f * (x + 0.044715f * x * x * x); return x * __builtin_amdgcn_rcpf(1.0f + __expf(-t)); }

__device__ __forceinline__ int tid_fresh() { int t = threadIdx.x; asm volatile("" : "+v"(t)); return t; }
namespace pg8 {
constexpr int BM = 256, BK = 64, HALF = 128, HTB = HALF * BK * 2, STAGE_BYTES = 8 * HTB, NXCD = 8, WGM = 8;
__host__ __device__ __forceinline__ int lds_byte(int r, int c) { const int st = (r >> 4) * 2 + (c >> 5), rr = r & 15, cc = c & 31, ob = rr * 64 + cc * 2; return st * 1024 + (ob ^ (((ob >> 9) & 1) << 5)); }
__host__ __device__ __forceinline__ void stage_rc(int b, int& R, int& C) { const int st = b / 1024, sb = b % 1024, swz = sb ^ (((sb >> 9) & 1) << 5); R = (st >> 1) * 16 + swz / 64; C = (st & 1) * 32 + (swz % 64) / 2; }
__host__ __device__ __forceinline__ int perm32(int rho) { const int n = rho >> 4, i = rho & 15; return 8 * (i >> 2) + 4 * n + (i & 3); }

struct Unit { int pm, pn, k0, nt, part; };
struct Gemm { const bf16_t* A; const bf16_t* Bt; int lda, ldb; };

struct StaticOrder {
    int nM, nN, nwg, G, c, nt;
    __host__ __device__ void init(int M_, int N_, int K_, int G_, int c_) { nM = M_ / BM; nN = N_ / BM; nwg = nM * nN; G = G_; c = c_; nt = K_ / BK; }
    __host__ __device__ bool next(int i, Unit& u) const {
        const long L = (long)i * G + c; if (L >= nwg) return false;
        int wgid = (int)L; { const int q = nwg / NXCD, r = nwg % NXCD, xcd = wgid % NXCD, off = wgid / NXCD; wgid = (xcd < r ? xcd * (q + 1) : r * (q + 1) + (xcd - r) * q) + off; }
        const int nig = WGM * nN, gid = wgid / nig, fm = gid * WGM, gsz = (nM - fm) < WGM ? (nM - fm) : WGM;
        u.pm = fm + ((wgid % nig) % gsz); u.pn = (wgid % nig) / gsz; u.k0 = 0; u.nt = nt; u.part = 0; return true;
    }
    __device__ __forceinline__ void a_ready(const Unit&) const {}
    __device__ __forceinline__ void done(const Unit&) const {}
};

struct BStatOrder {
    int x, j, tpx, nM, nt;
    __host__ __device__ void init(int M_, int N_, int K_, int c_) { x = c_ & 7; j = c_ >> 3; tpx = N_ / BM / 8; nM = M_ / BM; nt = K_ / BK; }
    __host__ __device__ bool next(int r, Unit& u) const {
        const int q = r * 32 + j; if (q >= nM * tpx) return false;
        u.pm = q / tpx; u.pn = x * tpx + (q - u.pm * tpx); u.k0 = 0; u.nt = nt; u.part = 0; return true;
    }
    __device__ __forceinline__ void a_ready(const Unit&) const {}
    __device__ __forceinline__ void done(const Unit&) const {}
};
struct SplitOrder {
    int x, i, ntf;
    __host__ __device__ void init(int K_, int c_) { x = c_ & 7; i = c_ >> 3; ntf = K_ / BK; }
    __host__ __device__ bool next(int r, Unit& u) const {
        const int gidx = 4 * x + (i >> 3);
        if (r == 0) { u.pm = gidx; u.pn = i & 7; u.k0 = 0; u.nt = ntf; u.part = 0; return true; }
        if (r == 1) { const int part = gidx & 3; u.pm = 32 + (gidx >> 2); u.pn = i & 7; u.nt = ntf >> 2; u.k0 = part * (ntf >> 2) * BK; u.part = part; return true; }
        return false;
    }
    __device__ __forceinline__ void a_ready(const Unit&) const {}
    __device__ __forceinline__ void done(const Unit&) const {}
};
__device__ __forceinline__ unsigned cvt_pk_bf16(float lo, float hi) { return pk2(lo, hi); }

template <class Epi, class Sched, bool ABLK = false, bool ALIGN_EPI = true, bool SP2 = true>
__device__ __forceinline__ void gemm_phase(LAS unsigned char* lds, const Gemm g, const Sched& S, const Epi& E) {
    const int tid = tid_fresh(), wid = __builtin_amdgcn_readfirstlane(tid >> 6), lane = tid & 63, wr = wid >> 2, wc = wid & 3, fr = lane & 15, fq = lane >> 4;
    unsigned voffA[2], voffB[2];
#pragma unroll
    for (int i = 0; i < 2; ++i) { int R, C; stage_rc(tid * 16 + i * 8192, R, C); const int r32 = Epi::PERM ? perm32(R & 31) : (R & 31);
        const int Rb = Epi::ADJ ? 64 * (R >> 5) + r32 : (R & ~31) + r32;
        voffA[i] = (unsigned)(R * (ABLK ? 64 : g.lda) + C) * 2u; voffB[i] = (unsigned)(Rb * g.ldb + C) * 2u; }
    const size_t kstep = (size_t)(BK * 2);
    const size_t hstepA = (size_t)HALF * (ABLK ? 64 : g.lda) * 2, hstepB = (size_t)(Epi::ADJ ? 32 : HALF) * g.ldb * 2;
    const size_t tstepB = (size_t)BM * g.ldb * 2;
    const unsigned ldsw = (unsigned)wid * 1024u;
    const int aoff = lds_byte(wr * 64 + fr, fq * 8), boff = lds_byte(wc * 32 + fr, fq * 8);
#define PG8_SA(b, h) (((b) * 2 + (h)) * HTB)
#define PG8_SB(b, h) ((4 + (b) * 2 + (h)) * HTB)
#define PG8_STAGE(bufoff, gbase, voff) do { _Pragma("unroll") for (int _i = 0; _i < 2; ++_i) \
        __builtin_amdgcn_global_load_lds((const unsigned*)((const char*)(gbase) + (voff)[_i]), (LAS unsigned*)(lds + (bufoff) + ldsw + _i * 8192), 16, 0, 0); } while (0)
#define PG8_LDA(dst, b, h) do { _Pragma("unroll") for (int m = 0; m < 4; ++m) _Pragma("unroll") for (int k = 0; k < 2; ++k) dst[m][k] = *(const LAS bf16x8*)(lds + PG8_SA(b, h) + aoff + m * 2048 + k * 1024); } while (0)
#define PG8_LDB(dst, b, h) do { _Pragma("unroll") for (int n = 0; n < 2; ++n) _Pragma("unroll") for (int k = 0; k < 2; ++k) dst[n][k] = *(const LAS bf16x8*)(lds + PG8_SB(b, h) + boff + n * 2048 + k * 1024); } while (0)
#define PG8_MMA(ai, bj, At, Bt) do { __builtin_amdgcn_s_setprio(1); _Pragma("unroll") for (int m = 0; m < 4; ++m) _Pragma("unroll") for (int n = 0; n < 2; ++n) _Pragma("unroll") for (int k = 0; k < 2; ++k) \
        acc[ai][bj][m][n] = __builtin_amdgcn_mfma_f32_16x16x32_bf16(Bt[n][k], At[m][k], acc[ai][bj][m][n], 0, 0, 0); __builtin_amdgcn_s_setprio(0); } while (0)
#define PG8_WAIT_V(n) asm volatile("s_waitcnt vmcnt(" #n ")" ::: "memory")
#define PG8_WAIT_L(n) asm volatile("s_waitcnt lgkmcnt(" #n ")" ::: "memory")
#define PG8_BAR __builtin_amdgcn_s_barrier()
#define PG8_SCHED __builtin_amdgcn_sched_barrier(0)
    Unit cur, nxt; int ui = 0;
    if (!S.next(0, cur)) return;
    f32x4 acc[2][2][4][2];
#pragma unroll
    for (int a = 0; a < 2; ++a)
#pragma unroll
        for (int b = 0; b < 2; ++b)
#pragma unroll
            for (int m = 0; m < 4; ++m)
#pragma unroll
                for (int n = 0; n < 2; ++n) acc[a][b][m][n] = (f32x4){0.f, 0.f, 0.f, 0.f};
    bf16x8 At[4][2], B0[2][2], B1[2][2];
    auto a_unit = [&](const Unit& u) -> const char* { return ABLK ? (const char*)g.A + (size_t)u.pm * ((size_t)g.lda / 64) * 32768 : (const char*)g.A + (size_t)u.pm * 2 * hstepA; };
    auto a_tile = [&](const char* ub, int tau) -> const char* { return ub + (size_t)tau * (ABLK ? (size_t)32768 : kstep); };
    const char* uA = a_unit(cur); int tbA = cur.k0 / BK;
    const char* cA = a_tile(uA, tbA); const char* cB = (const char*)g.Bt + (size_t)cur.pn * tstepB + (size_t)cur.k0 * 2;
    S.a_ready(cur);
    if constexpr (SP2) {
        PG8_STAGE(PG8_SB(0, 0), cB, voffB); PG8_STAGE(PG8_SB(0, 1), cB + hstepB, voffB); PG8_STAGE(PG8_SA(0, 0), cA, voffA); PG8_STAGE(PG8_SA(0, 1), cA + hstepA, voffA);
        if (wr == 1) PG8_BAR;
        PG8_WAIT_V(2); PG8_BAR;
        PG8_STAGE(PG8_SB(1, 0), cB + kstep, voffB); PG8_STAGE(PG8_SA(1, 0), a_tile(uA, tbA + 1), voffA); PG8_STAGE(PG8_SB(1, 1), cB + hstepB + kstep, voffB);
        PG8_WAIT_V(6); PG8_BAR;
    } else {
        PG8_STAGE(PG8_SB(0, 0), cB, voffB); PG8_STAGE(PG8_SA(0, 0), cA, voffA); PG8_STAGE(PG8_SB(0, 1), cB + hstepB, voffB); PG8_STAGE(PG8_SA(0, 1), cA + hstepA, voffA);
        if (wr == 1) PG8_BAR;
        PG8_WAIT_V(4); PG8_BAR;
        PG8_STAGE(PG8_SB(1, 0), cB + kstep, voffB); PG8_STAGE(PG8_SA(1, 0), a_tile(uA, tbA + 1), voffA); PG8_STAGE(PG8_SB(1, 1), cB + hstepB + kstep, voffB);
        PG8_WAIT_V(6); PG8_BAR;
    }
    for (;;) {
        const bool has_next = S.next(ui + 1, nxt);
        const int nt = cur.nt;
        const char* nuA = has_next ? a_unit(nxt) : uA; const int ntbA = has_next ? nxt.k0 / BK : tbA; const char* nB = has_next ? (const char*)g.Bt + (size_t)nxt.pn * tstepB + (size_t)nxt.k0 * 2 : cB;
        for (int t = 0; t < nt; t += 2) {
            const bool last = (t == nt - 2);
            const char* a1 = a_tile(uA, tbA + t + 1);
            const char* a2 = last ? a_tile(nuA, ntbA) : a_tile(uA, tbA + t + 2); const char* b2 = last ? nB : cB + (size_t)(t + 2) * kstep;
            const char* a3 = last ? a_tile(nuA, ntbA + 1) : a_tile(uA, tbA + t + 3); const char* b3 = b2 + kstep;
            if (last && has_next) S.a_ready(nxt);
            if constexpr (SP2) {
            PG8_LDB(B0, 0, 0); PG8_LDB(B1, 0, 1); PG8_SCHED; PG8_LDA(At, 0, 0); PG8_STAGE(PG8_SA(1, 1), a1 + hstepA, voffA);
            PG8_WAIT_V(8); PG8_WAIT_L(0); PG8_BAR; PG8_MMA(0, 0, At, B0); PG8_MMA(0, 1, At, B1); PG8_BAR; PG8_SCHED;
            PG8_LDA(At, 0, 1); PG8_STAGE(PG8_SB(0, 0), b2, voffB); PG8_STAGE(PG8_SB(0, 1), b2 + hstepB, voffB); PG8_STAGE(PG8_SA(0, 0), a2, voffA);
            PG8_WAIT_V(8); PG8_WAIT_L(0); PG8_BAR; PG8_MMA(1, 0, At, B0); PG8_MMA(1, 1, At, B1); PG8_BAR; PG8_SCHED;
            PG8_LDB(B0, 1, 0); PG8_LDB(B1, 1, 1); PG8_SCHED; PG8_LDA(At, 1, 0); PG8_STAGE(PG8_SA(0, 1), a2 + hstepA, voffA);
            PG8_WAIT_V(8); PG8_WAIT_L(0); PG8_BAR; PG8_MMA(0, 0, At, B0); PG8_MMA(0, 1, At, B1); PG8_BAR; PG8_SCHED;
            PG8_LDA(At, 1, 1); PG8_STAGE(PG8_SB(1, 0), b3, voffB); PG8_STAGE(PG8_SB(1, 1), b3 + hstepB, voffB); PG8_STAGE(PG8_SA(1, 0), a3, voffA);
            PG8_WAIT_V(8); PG8_WAIT_L(0); PG8_BAR; PG8_MMA(1, 0, At, B0); PG8_MMA(1, 1, At, B1); PG8_BAR; PG8_SCHED;
            } else {
            PG8_LDB(B0, 0, 0); PG8_SCHED; PG8_LDA(At, 0, 0); PG8_STAGE(PG8_SA(1, 1), a1 + hstepA, voffA);
            PG8_WAIT_L(8); PG8_BAR; PG8_WAIT_L(0); PG8_MMA(0, 0, At, B0); PG8_BAR; PG8_SCHED;
            PG8_LDB(B1, 0, 1); PG8_STAGE(PG8_SB(0, 0), b2, voffB);
            PG8_BAR; PG8_WAIT_L(0); PG8_MMA(0, 1, At, B1); PG8_BAR;
            PG8_LDA(At, 0, 1); PG8_STAGE(PG8_SA(0, 0), a2, voffA);
            PG8_BAR; PG8_WAIT_L(0); PG8_MMA(1, 0, At, B0); PG8_BAR; PG8_SCHED;
            PG8_STAGE(PG8_SB(0, 1), b2 + hstepB, voffB);
            PG8_WAIT_V(6); PG8_BAR; PG8_MMA(1, 1, At, B1); PG8_BAR;
            PG8_LDB(B0, 1, 0); PG8_SCHED; PG8_LDA(At, 1, 0); PG8_STAGE(PG8_SA(0, 1), a2 + hstepA, voffA);
            PG8_WAIT_L(8); PG8_BAR; PG8_WAIT_L(0); PG8_MMA(0, 0, At, B0); PG8_BAR; PG8_SCHED;
            PG8_LDB(B1, 1, 1); PG8_STAGE(PG8_SB(1, 0), b3, voffB);
            PG8_BAR; PG8_WAIT_L(0); PG8_MMA(0, 1, At, B1); PG8_BAR;
            PG8_LDA(At, 1, 1); PG8_STAGE(PG8_SA(1, 0), a3, voffA);
            PG8_BAR; PG8_WAIT_L(0); PG8_MMA(1, 0, At, B0); PG8_BAR; PG8_SCHED;
            PG8_STAGE(PG8_SB(1, 1), b3 + hstepB, voffB);
            PG8_WAIT_V(6); PG8_BAR; PG8_MMA(1, 1, At, B1); PG8_BAR;
            }
        }
        if constexpr (ALIGN_EPI) { if (wr == 0) PG8_BAR; }
        E(acc, cur, wr, wc, fr, fq); S.done(cur);
        if (!has_next) break;
#pragma unroll
        for (int a = 0; a < 2; ++a)
#pragma unroll
            for (int b = 0; b < 2; ++b)
#pragma unroll
                for (int m = 0; m < 4; ++m)
#pragma unroll
                    for (int n = 0; n < 2; ++n) acc[a][b][m][n] = (f32x4){0.f, 0.f, 0.f, 0.f};
        cur = nxt; uA = nuA; tbA = ntbA; cB = nB; ++ui;
        if constexpr (ALIGN_EPI) { if (wr == 1) PG8_BAR; }
    }
    PG8_WAIT_V(0);
    if constexpr (!ALIGN_EPI) { if (wr == 0) PG8_BAR; }
    PG8_BAR;
#undef PG8_SA
#undef PG8_SB
#undef PG8_STAGE
#undef PG8_LDA
#undef PG8_LDB
#undef PG8_MMA
#undef PG8_WAIT_V
#undef PG8_WAIT_L
#undef PG8_BAR
#undef PG8_SCHED
}
}

using pg8::Unit;
struct ResSrc { const float* xp; const float* xs; const bf16_t* xb;
    __device__ __forceinline__ f32x4 ld4(int r, int col) const {
        if (xb) { const u32x2 w = *(const u32x2*)(xb + (size_t)r * D + col);
            return (f32x4){__builtin_bit_cast(float, w.x << 16), __builtin_bit_cast(float, w.x & 0xffff0000u), __builtin_bit_cast(float, w.y << 16), __builtin_bit_cast(float, w.y & 0xffff0000u)}; }
        return *(const f32x4*)((r < MP ? xp + (size_t)r * D : xs + (size_t)(r - MP) * D) + col); } };

__device__ __forceinline__ u32x4 ror8(u32x4 v) { u32x4 r;
#pragma unroll
    for (int i = 0; i < 4; ++i) r[i] = (unsigned)__builtin_amdgcn_mov_dpp((int)v[i], 0x128, 0xf, 0xf, true);
    return r; }
__device__ __forceinline__ void store_pair(unsigned char* own, size_t stride8, int hi_off, u32x4 lo, u32x4 hi, bool upper) {
    const u32x4 tlo = ror8(lo), thi = ror8(hi);
    const u32x4 A = upper ? thi : lo, B = upper ? hi : tlo;
    unsigned char* pa = upper ? own - stride8 + hi_off : own;
    unsigned char* pb = upper ? own + hi_off : own + stride8;
    *(u32x4*)pa = A; *(u32x4*)pb = B;
}
__device__ __forceinline__ void store_pair_f(float* own, size_t stride8_elems, f32x4 lo, f32x4 hi, bool upper) {
    store_pair((unsigned char*)own, stride8_elems * 4, 64, __builtin_bit_cast(u32x4, lo), __builtin_bit_cast(u32x4, hi), upper);
}
struct EpiSsmGate {
    static constexpr bool PERM = true, ADJ = false;
    bf16_t* Z;
    __device__ __forceinline__ void operator()(const f32x4 (&acc)[2][2][4][2], const Unit& u, int wr, int wc, int fr, int fq) const {
        const int row0 = u.pm * 256 + wr * 64 + fr, ch0 = u.pn * 128 + wc * 32 + 8 * fq;
#pragma unroll
        for (int ai = 0; ai < 2; ++ai)
#pragma unroll
            for (int m = 0; m < 4; ++m) { f32x4 z[2];
#pragma unroll
                for (int n = 0; n < 2; ++n) { const f32x4 o = acc[ai][0][m][n], gt = acc[ai][1][m][n];
#pragma unroll
                    for (int j = 0; j < 4; ++j) z[n][j] = o[j] * sigmoidf_(gt[j]); }
                u32x4 w; w.x = pk2(z[0][0], z[0][1]); w.y = pk2(z[0][2], z[0][3]); w.z = pk2(z[1][0], z[1][1]); w.w = pk2(z[1][2], z[1][3]);
                *(u32x4*)(Z + (size_t)(row0 + ai * 128 + m * 16) * D + ch0) = w; }
    }
};
struct EpiRes {
    static constexpr bool PERM = true, ADJ = true;
    bf16_t* Z; bf16_t* P;
    __device__ __forceinline__ void operator()(const f32x4 (&acc)[2][2][4][2], const Unit& u, int wr, int wc, int fr, int fq) const {
        const int row0 = u.pm * 256 + wr * 64 + fr, col0 = u.pn * 256 + wc * 64 + 8 * fq;
        bf16_t* base = u.part == 0 ? Z + (size_t)row0 * D + col0 : P + ((size_t)(u.part - 1) * MS + (row0 - MP)) * D + col0;
#pragma unroll
        for (int ai = 0; ai < 2; ++ai)
#pragma unroll
            for (int m = 0; m < 4; ++m) { u32x4 w[2];
#pragma unroll
                for (int bj = 0; bj < 2; ++bj) { const f32x4 v0 = acc[ai][bj][m][0], v1 = acc[ai][bj][m][1]; w[bj].x = pk2(v0[0], v0[1]); w[bj].y = pk2(v0[2], v0[3]); w[bj].z = pk2(v1[0], v1[1]); w[bj].w = pk2(v1[2], v1[3]); }
                store_pair((unsigned char*)(base + (size_t)(ai * 128 + m * 16) * D), (size_t)8 * D * 2, 64, w[0], w[1], fr >= 8); }
    }
};
struct EpiFfn1 {
    static constexpr bool PERM = true, ADJ = true;
    bf16_t* H;
    __device__ __forceinline__ void operator()(const f32x4 (&acc)[2][2][4][2], const Unit& u, int wr, int wc, int fr, int fq) const {
#pragma unroll
        for (int ai = 0; ai < 2; ++ai)
#pragma unroll
            for (int m = 0; m < 4; ++m) { unsigned char* rowp = (unsigned char*)(H + ((size_t)(u.pm * (FF / 64) + u.pn * 4 + wc) * 256 + (wr * 64 + fr + ai * 128 + m * 16)) * 64 + 8 * fq); u32x4 w[2];
#pragma unroll
                for (int bj = 0; bj < 2; ++bj) { f32x4 v0 = acc[ai][bj][m][0], v1 = acc[ai][bj][m][1];
#pragma unroll
                    for (int j = 0; j < 4; ++j) { const float a = fmaxf(v0[j], 0.f), b = fmaxf(v1[j], 0.f); v0[j] = a * a; v1[j] = b * b; }
                    w[bj].x = pk2(v0[0], v0[1]); w[bj].y = pk2(v0[2], v0[3]); w[bj].z = pk2(v1[0], v1[1]); w[bj].w = pk2(v1[2], v1[3]); }
                store_pair(rowp, (size_t)8 * 64 * 2, 64, w[0], w[1], fr >= 8); }
    }
};
struct EpiQkv {
    static constexpr bool PERM = true, ADJ = true;
    bf16_t* QKV; float* out;
    __device__ __forceinline__ void operator()(const f32x4 (&acc)[2][2][4][2], const Unit& u, int wr, int wc, int fr, int fq) const {
        const int t = u.pn >> 3; const int colt = (u.pn & 7) * 256;
        const int col0 = colt + wc * 64 + 8 * fq;
        bf16_t* base = QKV + (size_t)t * M * D;
        float* fdst = nullptr;
        if (t >= 1) {
            if (u.pm < 32) { if ((u.pm & 7) >= 6) { const int n = u.pm >> 3; fdst = out + (t == 1 ? O_KP : O_VP) + ((size_t)n * 512 + (size_t)((u.pm & 7) - 6) * 256) * D; } }
            else fdst = out + (t == 1 ? O_KS : O_VS) + (size_t)(u.pm - 32) * 256 * D;
        }
#pragma unroll
        for (int ai = 0; ai < 2; ++ai)
#pragma unroll
            for (int m = 0; m < 4; ++m) { const int rl = wr * 64 + fr + ai * 128 + m * 16; u32x4 w[2];
#pragma unroll
                for (int bj = 0; bj < 2; ++bj) { const f32x4 v0 = acc[ai][bj][m][0], v1 = acc[ai][bj][m][1];
                    w[bj].x = pk2(v0[0], v0[1]); w[bj].y = pk2(v0[2], v0[3]); w[bj].z = pk2(v1[0], v1[1]); w[bj].w = pk2(v1[2], v1[3]);
                    if (fdst) { float* fp = fdst + (size_t)rl * D + col0 + bj * 32; *(f32x4*)fp = v0; *(f32x4*)(fp + 4) = v1; } }
                store_pair((unsigned char*)(base + (size_t)(u.pm * 256 + rl) * D + col0), (size_t)8 * D * 2, 64, w[0], w[1], fr >= 8); }
    }
};
struct EpiHgrnIn {
    static constexpr bool PERM = true, ADJ = true;
    bf16_t* QIG; unsigned short* F; const float* lb;
    __device__ __forceinline__ void operator()(const f32x4 (&acc)[2][2][4][2], const Unit& u, int wr, int wc, int fr, int fq) const {
        const int t = u.pn >> 3; const int colt = (u.pn & 7) * 256;
        const int row0 = u.pm * 256 + wr * 64 + fr, col0 = colt + wc * 64 + 8 * fq;
        if (t == 1) {
            f32x4 l[2][2];
#pragma unroll
            for (int bj = 0; bj < 2; ++bj) { l[bj][0] = 1.0f - *(const f32x4*)(lb + col0 + bj * 32); l[bj][1] = 1.0f - *(const f32x4*)(lb + col0 + bj * 32 + 4); }
#pragma unroll
            for (int ai = 0; ai < 2; ++ai)
#pragma unroll
                for (int m = 0; m < 4; ++m) { u32x4 w[2];
#pragma unroll
                    for (int bj = 0; bj < 2; ++bj) { f32x4 v0 = acc[ai][bj][m][0], v1 = acc[ai][bj][m][1];
#pragma unroll
                        for (int j = 0; j < 4; ++j) { v0[j] = l[bj][0][j] * sigmoidf_(-v0[j]); v1[j] = l[bj][1][j] * sigmoidf_(-v1[j]); }
                        w[bj].x = pkh2(v0[0], v0[1]); w[bj].y = pkh2(v0[2], v0[3]); w[bj].z = pkh2(v1[0], v1[1]); w[bj].w = pkh2(v1[2], v1[3]); }
                    store_pair((unsigned char*)(F + (size_t)(row0 + ai * 128 + m * 16) * D + col0), (size_t)8 * D * 2, 64, w[0], w[1], fr >= 8); }
        } else {
            bf16_t* base = QIG + (size_t)(t == 0 ? 0 : t - 1) * M * D;
#pragma unroll
            for (int ai = 0; ai < 2; ++ai)
#pragma unroll
                for (int m = 0; m < 4; ++m) { u32x4 w[2];
#pragma unroll
                    for (int bj = 0; bj < 2; ++bj) { const f32x4 v0 = acc[ai][bj][m][0], v1 = acc[ai][bj][m][1]; w[bj].x = pk2(v0[0], v0[1]); w[bj].y = pk2(v0[2], v0[3]); w[bj].z = pk2(v1[0], v1[1]); w[bj].w = pk2(v1[2], v1[3]); }
                    store_pair((unsigned char*)(base + (size_t)(row0 + ai * 128 + m * 16) * D + col0), (size_t)8 * D * 2, 64, w[0], w[1], fr >= 8); }
        }
    }
};

struct Args { const float* in[30]; float* out; unsigned char* ws; };


__device__ __forceinline__ float wave_sum(float v) {
#pragma unroll
    for (int o = 1; o < 64; o <<= 1) v += __shfl_xor(v, o);
    return v;
}

#define XB_TMO      128
#define XB_XCNT(j)  (256  + 64 * (j))
#define XB_XSUB(j)  (1280 + 64 * (j))
#define XB_XGEN(j)  (2304 + 64 * (j))
#define XB_TOP      3328
#define XB_TOPGEN   3392
#define XCD_BAR_WORDS 3456
#define XB_SPIN_CAP (1u << 18)
__device__ __forceinline__ unsigned xb_ld(unsigned* p)              { return __hip_atomic_load(p, __ATOMIC_RELAXED, __HIP_MEMORY_SCOPE_AGENT); }
__device__ __forceinline__ unsigned xb_add(unsigned* p, unsigned v) { return __hip_atomic_fetch_add(p, v, __ATOMIC_RELAXED, __HIP_MEMORY_SCOPE_AGENT); }
__device__ __forceinline__ unsigned xb_xcc_id() { return (unsigned)__builtin_amdgcn_s_getreg((3 << 11) | 20) & 0xFu; }
#define XB_SPIN(cond, bar) do { unsigned _sp = 0; while (cond) { __builtin_amdgcn_s_sleep(1); \
    if ((++_sp & 255u) == 0u) { if (xb_ld(&(bar)[XB_TMO])) break; if (_sp > XB_SPIN_CAP) { atomicAdd(&(bar)[XB_TMO], 1u); break; } } } } while (0)
struct XcdBarrier { unsigned* bar; unsigned x; volatile LAS unsigned* st; };
__device__ __forceinline__ XcdBarrier xcd_barrier_post(unsigned* bar, volatile LAS unsigned* st) {
    XcdBarrier b; b.bar = bar; b.x = xb_xcc_id(); b.st = st;
    if (threadIdx.x == 0) (void)xb_add(&bar[XB_XCNT(b.x)], 1u);
    return b;
}
__device__ __forceinline__ void xcd_barrier_complete(unsigned* bar, unsigned x, unsigned& nloc, unsigned& nx) {
    const unsigned G = gridDim.x * gridDim.y * gridDim.z;
    unsigned sum, cnt, mine, sp = 0u;
    for (;;) {
        sum = 0u; cnt = 0u; mine = 0u;
#pragma unroll
        for (unsigned j = 0; j < 16; ++j) { const unsigned c = xb_ld(&bar[XB_XCNT(j)]); sum += c; cnt += (c > 0u) ? 1u : 0u; mine = (j == x) ? c : mine; }
        if (sum == G) break;
        __builtin_amdgcn_s_sleep(1);
        if ((++sp & 255u) == 0u) { if (xb_ld(&bar[XB_TMO])) break; if (sp > XB_SPIN_CAP) { atomicAdd(&bar[XB_TMO], 1u); break; } }
    }
    nloc = mine > 0u ? mine : 1u; nx = cnt > 0u ? cnt : 1u;
}
__device__ __forceinline__ void xcd_barrier(const XcdBarrier& b) {
    asm volatile("s_waitcnt vmcnt(0)" ::: "memory");
    __syncthreads();
    if (threadIdx.x == 0) {
        unsigned* bar = b.bar;
        __builtin_amdgcn_s_waitcnt(0);
        unsigned nloc = b.st[0], nx = b.st[1];
        if (nloc == 0u) { xcd_barrier_complete(bar, b.x, nloc, nx); b.st[0] = nloc; b.st[1] = nx; }
        const unsigned old = xb_add(&bar[XB_XSUB(b.x)], 1u);
        const unsigned gen = old / nloc;
        if (old + 1u == (gen + 1u) * nloc) {
            __builtin_amdgcn_fence(__ATOMIC_RELEASE, "agent");
            asm volatile("s_waitcnt vmcnt(0)" ::: "memory");
            const unsigned og = xb_add(&bar[XB_TOP], 1u);
            const unsigned tg = og / nx;
            if (og + 1u == (tg + 1u) * nx) xb_add(&bar[XB_TOPGEN], 1u);
            else XB_SPIN(xb_ld(&bar[XB_TOPGEN]) == tg, bar);
            __builtin_amdgcn_fence(__ATOMIC_ACQUIRE, "agent");
            xb_add(&bar[XB_XGEN(b.x)], 1u);
            asm volatile("s_waitcnt vmcnt(0)" ::: "memory");
        } else {
            XB_SPIN(xb_ld(&bar[XB_XGEN(b.x)]) == gen, bar);
            __builtin_amdgcn_fence(__ATOMIC_ACQUIRE, "agent");
            asm volatile("s_waitcnt vmcnt(0)" ::: "memory");
        }
    }
    __syncthreads();
}

struct ConvItem { const float* src; bf16_t* dst; int N, K; };
constexpr int CONV_ITEMS = (4 * 2048 + 6144 + 2048 + 8192 + 2048 + 8 * 8192) / 2;
constexpr int CONV_LDS = 64 * 65 * 4;
__device__ __forceinline__ ConvItem conv_decode(const Args& a, int it) {
    unsigned char* ws = a.ws; const float* W; bf16_t* WT; int K, N, mode = 0;
    if (it < 4 * 1024) { const int m = it >> 10; it &= 1023; const int jj = m >> 1; mode = 1 + (m & 1); W = a.in[15 + (m & 1)] + (size_t)jj * D * D; WT = (bf16_t*)(ws + WS_WSSM) + (size_t)jj * 4096 * D; K = D; N = D; }
    else if ((it -= 4 * 1024) < 3072) { W = a.in[17]; WT = (bf16_t*)(ws + WS_WQKV); K = D; N = 3 * D; }
    else if ((it -= 3072) < 1024) { W = a.in[19]; WT = (bf16_t*)(ws + WS_WAO); K = D; N = D; }
    else if ((it -= 1024) < 4096) { W = a.in[20]; WT = (bf16_t*)(ws + WS_WHIN); K = D; N = 4 * D; }
    else if ((it -= 4096) < 1024) { W = a.in[23]; WT = (bf16_t*)(ws + WS_WHO); K = D; N = D; }
    else if ((it -= 1024) < 4 * 4096) { const int l = it >> 12; it &= 4095; W = a.in[28] + (size_t)l * D * FF; WT = (bf16_t*)(ws + WS_WF1) + (size_t)l * FF * D; K = D; N = FF; }
    else { it -= 4 * 4096; const int l = it >> 12; it &= 4095; W = a.in[29] + (size_t)l * FF * D; WT = (bf16_t*)(ws + WS_WF2) + (size_t)l * D * FF; K = FF; N = D; }
    const int nb = N / 64, kb = it / nb, n0 = 64 * (it - kb * nb), k0 = 64 * kb;
    const int row0 = mode == 0 ? n0 : 256 * (n0 >> 7) + 128 * (mode - 1) + (n0 & 127);
    ConvItem c; c.src = W + (size_t)k0 * N + n0; c.dst = WT + (size_t)row0 * K + k0; c.N = N; c.K = K; return c;
}
__device__ __forceinline__ void conv_load(const ConvItem& c, f32x4 (&wv)[16], int lane) {
#pragma unroll
    for (int i = 0; i < 16; ++i) wv[i] = __builtin_nontemporal_load((const f32x4*)(c.src + (size_t)(4 * i + (lane >> 4)) * c.N + 4 * (lane & 15)));
}
__device__ __forceinline__ void conv_store(const ConvItem& c, const f32x4 (&wv)[16], LAS float* scr, int lane) {
#pragma unroll
    for (int i = 0; i < 16; ++i) { LAS float* d = scr + (4 * i + (lane >> 4)) * 65 + 4 * (lane & 15); d[0] = wv[i][0]; d[1] = wv[i][1]; d[2] = wv[i][2]; d[3] = wv[i][3]; }
    asm volatile("s_waitcnt lgkmcnt(0)" ::: "memory");
    const int cc = lane & 7;
#pragma unroll
    for (int j = 0; j < 8; ++j) { const int n = (lane >> 3) + 8 * j; const LAS float* sp = scr + (8 * cc) * 65 + n;
        u32x4 o; o.x = pk2(sp[0 * 65], sp[1 * 65]); o.y = pk2(sp[2 * 65], sp[3 * 65]); o.z = pk2(sp[4 * 65], sp[5 * 65]); o.w = pk2(sp[6 * 65], sp[7 * 65]);
        *(u32x4*)(c.dst + (size_t)n * c.K + 8 * cc) = o; }
    asm volatile("s_waitcnt lgkmcnt(0)" ::: "memory");
}
__device__ __forceinline__ void conv_worker(const Args& a, LAS float* scr, int w, int nw, int lane) {
    f32x4 va[16], vb[16];
    int it = w; if (it >= CONV_ITEMS) return;
    ConvItem ca = conv_decode(a, it), cb = ca; conv_load(ca, va, lane);
    for (;;) {
        const bool hb = it + nw < CONV_ITEMS; if (hb) { cb = conv_decode(a, it + nw); conv_load(cb, vb, lane); }
        conv_store(ca, va, scr, lane); if (!hb) break; it += nw;
        const bool ha = it + nw < CONV_ITEMS; if (ha) { ca = conv_decode(a, it + nw); conv_load(ca, va, lane); }
        conv_store(cb, vb, scr, lane); if (!ha) break; it += nw;
    }
}
__device__ __forceinline__ void params1_item(const Args& a, int idx) {
    unsigned char* par = a.ws + WS_PAR;
    if (idx < 2 * NG * NP) {
        const int j = idx / (NG * NP), g = (idx / NP) % NG;
        const double are = a.in[7][idx], aim = a.in[8][idx], dt = exp((double)a.in[9][j * NG + g]);
        const double e = exp(are * dt), cr = e * cos(aim * dt), ci = e * sin(aim * dt);
        float* ab = (float*)(par + PAR_ABAR) + (size_t)idx * 2; ab[0] = (float)cr; ab[1] = (float)ci;
    }
    if (idx < D) {
        const float* lg = a.in[21]; float v0 = lg[idx], v1 = lg[D + idx], v2 = lg[2 * D + idx], v3 = lg[3 * D + idx];
        const float mx = fmaxf(fmaxf(v0, v1), fmaxf(v2, v3));
        v0 = expf(v0 - mx); v1 = expf(v1 - mx); v2 = expf(v2 - mx); v3 = expf(v3 - mx);
        ((float*)(par + PAR_LB))[idx] = (v1 + v2) / (v0 + v1 + v2 + v3);
    }
}
__device__ __forceinline__ void params2_item(const Args& a, int idx);
__device__ __forceinline__ void ph_params(const Args& a, int nblk, int b) {
    const int tid = tid_fresh(); const int nth = nblk * 512;
    for (int idx = b * 512 + tid; idx < 2 * NG * 8 * 64 + 2 * NG * 4 * 64; idx += nth) params2_item(a, idx);
    for (int idx = b * 512 + tid; idx < 2 * NG * NP; idx += nth) params1_item(a, idx);
}

template <int C> __device__ __forceinline__ float dppf(float v) { return __builtin_bit_cast(float, __builtin_amdgcn_mov_dpp(__builtin_bit_cast(int, v), C, 0xf, 0xf, true)); }
__device__ __forceinline__ float wave_sum_dpp(float v) {
    v += dppf<0x121>(v); v += dppf<0x122>(v); v += dppf<0x124>(v); v += dppf<0x128>(v);
    const int iv = __builtin_bit_cast(int, v);
    return (__builtin_bit_cast(float, __builtin_amdgcn_readlane(iv, 0)) + __builtin_bit_cast(float, __builtin_amdgcn_readlane(iv, 16))) + (__builtin_bit_cast(float, __builtin_amdgcn_readlane(iv, 32)) + __builtin_bit_cast(float, __builtin_amdgcn_readlane(iv, 48)));
}
__device__ __forceinline__ void ph_ln(const Args& a, int L, int which, bool final_, bool split, bool wr_x, bool res_inputs, int nblk, int b) {
    unsigned char* ws = a.ws; const bf16_t* P = (const bf16_t*)(ws + WS_SCR + SCR_PART);
    const bf16_t* Z = (const bf16_t*)(ws + WS_Z); float* Xo = final_ ? a.out : (float*)(ws + WS_X); bf16_t* XB = (bf16_t*)(ws + WS_XB);
    auto lo = [](unsigned w) -> float { return __builtin_bit_cast(float, w << 16); }; auto hi = [](unsigned w) -> float { return __builtin_bit_cast(float, w & 0xffff0000u); };
    const float* gam = a.in[which ? 26 : 24] + (size_t)L * D; const float* bet = a.in[which ? 27 : 25] + (size_t)L * D;
    const int tid = tid_fresh(); const int lane = tid & 63, gw = b * 8 + (tid >> 6), ngw = nblk * 8;
    f32x4 gg[4][2], bb[4][2];
#pragma unroll
    for (int j = 0; j < 4; ++j)
#pragma unroll
        for (int h = 0; h < 2; ++h) { gg[j][h] = *(const f32x4*)(gam + 512 * j + 8 * lane + 4 * h); bb[j][h] = *(const f32x4*)(bet + 512 * j + 8 * lane + 4 * h); }
    u32x4 zc[4], xc[4];
    auto ldrow = [&](int r) { const u32x4* zr = (const u32x4*)(Z + (size_t)r * D) + lane;
#pragma unroll
        for (int j = 0; j < 4; ++j) zc[j] = zr[64 * j];
        if (!res_inputs) { const u32x4* xr = (const u32x4*)(XB + (size_t)r * D) + lane;
#pragma unroll
            for (int j = 0; j < 4; ++j) xc[j] = xr[64 * j]; } };
    if (gw < M) ldrow(gw);
    for (int r = gw; r < M; r += ngw) {
        float v[4][8];
#pragma unroll
        for (int j = 0; j < 4; ++j)
#pragma unroll
            for (int e = 0; e < 4; ++e) { v[j][2 * e] = lo(zc[j][e]); v[j][2 * e + 1] = hi(zc[j][e]); }
        if (!res_inputs) {
#pragma unroll
            for (int j = 0; j < 4; ++j)
#pragma unroll
                for (int e = 0; e < 4; ++e) { v[j][2 * e] += ALPHA * lo(xc[j][e]); v[j][2 * e + 1] += ALPHA * hi(xc[j][e]); } }
        if (r + ngw < M) ldrow(r + ngw);
        if (split && r >= MP) {
#pragma unroll
            for (int p = 0; p < 3; ++p) { const u32x4* pr = (const u32x4*)(P + ((size_t)p * MS + (r - MP)) * D) + lane;
#pragma unroll
                for (int j = 0; j < 4; ++j) { const u32x4 w = pr[64 * j];
#pragma unroll
                    for (int e = 0; e < 4; ++e) { v[j][2 * e] += lo(w[e]); v[j][2 * e + 1] += hi(w[e]); } } } }
        if (res_inputs) { const f32x4* xr = (const f32x4*)(r < MP ? a.in[0] + (size_t)r * D : a.in[1] + (size_t)(r - MP) * D) + 2 * lane;
#pragma unroll
            for (int j = 0; j < 4; ++j)
#pragma unroll
                for (int h = 0; h < 2; ++h) { const f32x4 x = xr[128 * j + h];
#pragma unroll
                    for (int e = 0; e < 4; ++e) v[j][4 * h + e] += ALPHA * x[e]; } }
        float s = 0.f;
#pragma unroll
        for (int j = 0; j < 4; ++j) s += ((v[j][0] + v[j][1]) + (v[j][2] + v[j][3])) + ((v[j][4] + v[j][5]) + (v[j][6] + v[j][7]));
        const float mean = wave_sum_dpp(s) * (1.f / D); float s2 = 0.f;
#pragma unroll
        for (int j = 0; j < 4; ++j)
#pragma unroll
            for (int e = 0; e < 8; ++e) { v[j][e] -= mean; s2 += v[j][e] * v[j][e]; }
        const float rstd = 1.f / sqrtf(wave_sum_dpp(s2) * (1.f / D) + LN_EPS);
        f32x4* xo = (f32x4*)(Xo + (size_t)r * D) + 2 * lane; u32x4* xb = (u32x4*)(XB + (size_t)r * D) + lane;
#pragma unroll
        for (int j = 0; j < 4; ++j) { f32x4 y[2];
#pragma unroll
            for (int h = 0; h < 2; ++h)
#pragma unroll
                for (int e = 0; e < 4; ++e) y[h][e] = v[j][4 * h + e] * rstd * gg[j][h][e] + bb[j][h][e];
            if (final_ || wr_x) { xo[128 * j] = y[0]; xo[128 * j + 1] = y[1]; }
            if (!final_) { u32x4 w; w.x = pk2(y[0][0], y[0][1]); w.y = pk2(y[0][2], y[0][3]); w.z = pk2(y[1][0], y[1][1]); w.w = pk2(y[1][2], y[1][3]); xb[64 * j] = w; } }
    }
}
__device__ __forceinline__ void params2_item(const Args& a, int idx) {
    unsigned char* par = a.ws + WS_PAR;
    if (idx < 2 * NG * 8 * 64) {
        const int lane = idx & 63, n8 = (idx >> 6) & 7, jg = idx >> 9; const int j = jg / NG, g = jg % NG; const int G4 = lane >> 4, c = lane & 15;
        const int pp = 16 * n8 + c, p = pp & 63, im = pp >> 6; const int sidx = (j * NG + g) * NP + p;
        const double are = a.in[7][sidx], aim = a.in[8][sidx], dt = exp((double)a.in[9][j * NG + g]);
        const double e = exp(are * dt), cr = e * cos(aim * dt), ci = e * sin(aim * dt);
        const double xr = cr - 1.0, xi = ci, den = are * are + aim * aim; const double fr = (xr * are + xi * aim) / den, fi = (xi * are - xr * aim) / den;
        unsigned w[4];
#pragma unroll
        for (int e2 = 0; e2 < 4; ++e2) { float v[2];
#pragma unroll
            for (int h = 0; h < 2; ++h) { const int q = (8 * G4 + 2 * e2 + h) & 15; const double br = a.in[10][(size_t)sidx * NQ + q], bi = a.in[11][(size_t)sidx * NQ + q];
                v[h] = (float)(im ? (fr * bi + fi * br) : (fr * br - fi * bi)); }
            w[e2] = pk2(v[0], v[1]); }
        ((u32x4*)(par + PAR_BFRAG))[idx] = (u32x4){w[0], w[1], w[2], w[3]};
    } else if (idx < 2 * NG * 8 * 64 + 2 * NG * 4 * 64) {
        const int id2 = idx - 2 * NG * 8 * 64; const int lane = id2 & 63, kk = (id2 >> 6) & 3, jg = id2 >> 8; const int G4 = lane >> 4, c = lane & 15;
        unsigned w[4];
#pragma unroll
        for (int e2 = 0; e2 < 4; ++e2) { float v[2];
#pragma unroll
            for (int h = 0; h < 2; ++h) { const int pp = 32 * kk + 8 * G4 + 2 * e2 + h; const size_t ci = ((size_t)jg * NQ + c) * NP + (pp & 63);
                v[h] = pp < 64 ? a.in[12][ci] : -a.in[13][ci]; }
            w[e2] = pk2(v[0], v[1]); }
        ((u32x4*)(par + PAR_CFRAG))[id2] = (u32x4){w[0], w[1], w[2], w[3]};
    }
}

__device__ __forceinline__ f32x4 mfma_t(bf16x8 a, bf16x8 b, f32x4 c) {
    asm volatile("s_nop 4" : "+v"(c) : "v"(a), "v"(b));
    f32x4 d = __builtin_amdgcn_mfma_f32_16x16x32_bf16(a, b, c, 0, 0, 0);
    asm volatile("s_nop 7" : "+v"(d) : "v"(a), "v"(b));
    return d;
}
__device__ __forceinline__ f32x4 mfma_u(bf16x8 a, bf16x8 b, f32x4 c) {
    f32x4 d = __builtin_amdgcn_mfma_f32_16x16x32_bf16(a, b, c, 0, 0, 0);
    asm volatile("" : "+v"(d) : "v"(a), "v"(b));
    return d;
}
__device__ __forceinline__ f32x4 mfma_a(bf16x8 a, bf16x8 b, f32x4 c) { f32x4 d = __builtin_amdgcn_mfma_f32_16x16x32_bf16(a, b, c, 0, 0, 0); asm("" : "+v"(d) : "v"(a), "v"(b)); return d; }
#define OPAQUE(x) asm volatile("" : "+v"(x))
#define MFMA_PRE1(x) asm volatile("s_nop 4" : "+v"(x))
#define MFMA_POST4(a, b, c, d) asm volatile("s_nop 7\n\ts_nop 7" : "+v"(a), "+v"(b), "+v"(c), "+v"(d))
#define MFMA_POST8(a, b, c, d, e, f, g, h) asm volatile("s_nop 7\n\ts_nop 7" : "+v"(a), "+v"(b), "+v"(c), "+v"(d), "+v"(e), "+v"(f), "+v"(g), "+v"(h))
#define MFMA_POST1(a) asm volatile("s_nop 7\n\ts_nop 7" : "+v"(a))
constexpr int SSM_BUS = 132;
constexpr int SSM_WLDS = 16 * SSM_BUS * 4 + 64 * 16 * 4;
template <bool FULL>
__device__ __forceinline__ void ssm_core(const Args& a, LAS unsigned char* wl, int j, int L, bool samp, int n, int g, int tb, int te, float& hr, float& hi, int lane) {
    unsigned char* ws = a.ws;
    const size_t rowbase = samp ? (size_t)MP + (size_t)n * DSEQ : (size_t)n * SEQ;
    const float* xbase = (L == 0) ? (samp ? a.in[1] + (size_t)n * DSEQ * D : a.in[0] + rowbase * D) : (const float*)(ws + WS_X) + rowbase * D;
    const int G4 = lane >> 4, c = lane & 15;
    const bf16x8* bfp = (const bf16x8*)(ws + WS_PAR + PAR_BFRAG) + (size_t)(j * NG + g) * 8 * 64 + lane;
    const bf16x8* cfp = (const bf16x8*)(ws + WS_PAR + PAR_CFRAG) + (size_t)(j * NG + g) * 4 * 64 + lane;
    bf16x8 Bf[8], Cf[4];
#pragma unroll
    for (int i = 0; i < 8; ++i) Bf[i] = bfp[i * 64];
    if (FULL) {
#pragma unroll
        for (int i = 0; i < 4; ++i) Cf[i] = cfp[i * 64]; }
    const float* ab = (const float*)(ws + WS_PAR + PAR_ABAR) + ((size_t)(j * NG + g) * NP + lane) * 2; const float ar = ab[0], ai = ab[1];
    const float dsk = a.in[14][(size_t)j * D + g * NQ + c];
    LAS float* BUs = (LAS float*)wl; LAS float* Us = (LAS float*)(wl + 16 * SSM_BUS * 4);
    bf16_t* Y = (bf16_t*)(ws + WS_Y);
    const float* up = xbase + (size_t)c * D + g * NQ + 8 * (G4 & 1);
    auto ldu = [&](int trow, f32x4& lo, f32x4& hi4) { const float* p = up + (size_t)trow * D; lo = *(const f32x4*)p; hi4 = *(const f32x4*)(p + 4); };
    f32x4 ub[4][2];
#pragma unroll
    for (int k = 0; k < 4; ++k) ldu(tb + 16 * k, ub[k][0], ub[k][1]);
    for (int t0 = tb; t0 < te; t0 += 64) {
#pragma unroll
        for (int k = 0; k < 4; ++k) { LAS f32x4* ud = (LAS f32x4*)(Us + (16 * k + c) * 16 + 8 * (G4 & 1)); ud[0] = ub[k][0]; ud[1] = ub[k][1]; }
        if (t0 + 64 < te) {
#pragma unroll
            for (int k = 0; k < 4; ++k) ldu(t0 + 64 + 16 * k, ub[k][0], ub[k][1]); }
        asm volatile("s_waitcnt lgkmcnt(0)" ::: "memory");
#pragma unroll 1
        for (int k = 0; k < 4; ++k) {
            bf16x8 afk;
            { const LAS f32x4* usrc = (const LAS f32x4*)(Us + (16 * k + c) * 16 + 8 * (G4 & 1)); const f32x4 x0 = usrc[0], x1 = usrc[1];
              u32x4 aw;
#pragma unroll
              for (int e2 = 0; e2 < 4; ++e2) { const float u0 = e2 < 2 ? x0[2 * e2] : x1[2 * e2 - 4], u1 = e2 < 2 ? x0[2 * e2 + 1] : x1[2 * e2 - 3];
                  const unsigned hp = pk2(u0, u1); const unsigned lp = pk2(u0 - __builtin_bit_cast(float, hp << 16), u1 - __builtin_bit_cast(float, hp & 0xffff0000u)); aw[e2] = G4 < 2 ? hp : lp; }
              afk = __builtin_bit_cast(bf16x8, aw); }
            f32x4 dd[8];
#pragma unroll
            for (int n8 = 0; n8 < 8; ++n8) dd[n8] = mfma_t(afk, Bf[n8], (f32x4){0.f, 0.f, 0.f, 0.f});
#pragma unroll
            for (int n8 = 0; n8 < 8; ++n8)
#pragma unroll
                for (int i = 0; i < 4; ++i) BUs[(4 * G4 + i) * SSM_BUS + 16 * n8 + c] = dd[n8][i];
            asm volatile("s_waitcnt lgkmcnt(0)" ::: "memory");
#pragma unroll
            for (int t = 0; t < 16; ++t) { const float br = BUs[t * SSM_BUS + lane], bi = BUs[t * SSM_BUS + 64 + lane];
                const float nr = fmaf(ar, hr, fmaf(-ai, hi, br)), ni = fmaf(ar, hi, fmaf(ai, hr, bi)); hr = nr; hi = ni;
                if (FULL) { BUs[t * SSM_BUS + lane] = hr; BUs[t * SSM_BUS + 64 + lane] = hi; } }
            asm volatile("s_waitcnt lgkmcnt(0)" ::: "memory");
            if (FULL) {
                f32x4 y = (f32x4){0.f, 0.f, 0.f, 0.f};
                u32x4 hw[4];
#pragma unroll
                for (int kk = 0; kk < 4; ++kk) { const LAS f32x4* hp = (const LAS f32x4*)(BUs + c * SSM_BUS + 32 * kk + 8 * G4); const f32x4 h0 = hp[0], h1 = hp[1];
                    hw[kk].x = pk2(h0[0], h0[1]); hw[kk].y = pk2(h0[2], h0[3]); hw[kk].z = pk2(h1[0], h1[1]); hw[kk].w = pk2(h1[2], h1[3]); }
#pragma unroll
                for (int kk = 0; kk < 4; ++kk) y = mfma_t(__builtin_bit_cast(bf16x8, hw[kk]), Cf[kk], y);
#pragma unroll
                for (int i = 0; i < 4; ++i) { const float us = Us[(16 * k + 4 * G4 + i) * 16 + c]; Y[(rowbase + t0 + 16 * k + 4 * G4 + i) * D + g * NQ + c] = (bf16_t)f2bf(gelu_tanh(y[i] + dsk * us)); }
                asm volatile("s_waitcnt lgkmcnt(0)" ::: "memory");
            }
        }
    }
}
__device__ __forceinline__ void ssm_item(const Args& a, LAS unsigned char* wl, int j, int L, bool samp, int n, int g, int lane) {
    float hr = 0.f, hi = 0.f;
    if (samp) { hr = a.in[2][((size_t)(j * DB + n) * NG + g) * NP + lane]; hi = a.in[3][((size_t)(j * DB + n) * NG + g) * NP + lane]; }
    ssm_core<true>(a, wl, j, L, samp, n, g, 0, samp ? DSEQ : SEQ, hr, hi, lane);
    const size_t so = ((size_t)(j * (samp ? DB : NB) + n) * NG + g) * NP + lane;
    a.out[(samp ? O_SRS : O_SRP) + so] = hr; a.out[(samp ? O_SIS : O_SIP) + so] = hi;
}
template <bool CONV> __device__ __forceinline__ void ph_ssm(const Args& a, LAS unsigned char* lds, int j, int L, int nblk, int b) {
    const int tid = tid_fresh(); const int wave = __builtin_amdgcn_readfirstlane(tid >> 6), lane = tid & 63;
    LAS unsigned char* wl = CONV ? (wave < 2 ? lds + wave * SSM_WLDS : lds + 2 * SSM_WLDS + (wave - 2) * CONV_LDS) : lds + wave * SSM_WLDS;
    if (wave < 2) { for (int it = b * 2 + wave; it < NB * NG; it += nblk * 2) ssm_item(a, wl, j, L, false, it / NG, it % NG, lane); }
    else { for (int it = b * 6 + (wave - 2); it < DB * NG; it += nblk * 6) ssm_item(a, wl, j, L, true, it / NG, it % NG, lane);
        if (CONV) conv_worker(a, (LAS float*)wl, b * 6 + (wave - 2), nblk * 6, lane); }
}
constexpr int SSM_EXCH = 8 * SSM_WLDS;
__device__ __forceinline__ void ph_ssm_split(const Args& a, LAS unsigned char* lds, int j, int L, int b) {
    unsigned char* ws = a.ws;
    const int tid = tid_fresh(); const int wave = __builtin_amdgcn_readfirstlane(tid >> 6), lane = tid & 63;
    LAS unsigned char* wl = lds + wave * SSM_WLDS; LAS f32x2* exch = (LAS f32x2*)(lds + SSM_EXCH);
    const int seq = 2 * b + (wave >> 2), seg = wave & 3, n = seq / NG, g = seq % NG;
    if (seg < 3) { float er = 0.f, ei = 0.f; ssm_core<false>(a, wl, j, L, false, n, g, 512 * seg, 512 * seg + 512, er, ei, lane); exch[wave * 64 + lane] = (f32x2){er, ei}; }
    else { for (int q = 0; q < 4; ++q) { const int it = 16 * b + 4 * (wave >> 2) + q; ssm_item(a, wl, j, L, true, it / NG, it % NG, lane); } }
    __syncthreads();
    float hr = 0.f, hi = 0.f;
    if (seg > 0) {
        const float* ab = (const float*)(ws + WS_PAR + PAR_ABAR) + ((size_t)(j * NG + g) * NP + lane) * 2; float pr = ab[0], pi = ab[1];
#pragma unroll
        for (int q = 0; q < 9; ++q) { const float nr = pr * pr - pi * pi, ni = 2.f * pr * pi; pr = nr; pi = ni; }
        for (int s2 = 0; s2 < seg; ++s2) { const f32x2 e = exch[((wave & 4) + s2) * 64 + lane]; const float nr = pr * hr - pi * hi + e[0], ni = pr * hi + pi * hr + e[1]; hr = nr; hi = ni; }
    }
    ssm_core<true>(a, wl, j, L, false, n, g, 512 * seg, 512 * seg + 512, hr, hi, lane);
    if (seg == 3) { const size_t so = ((size_t)(j * NB + n) * NG + g) * NP + lane; a.out[O_SRP + so] = hr; a.out[O_SIP + so] = hi; }
    { const int it = 16 * b + 8 + wave; ssm_item(a, wl, j, L, true, it / NG, it % NG, lane); }
}

typedef short s16x4 __attribute__((ext_vector_type(4)));
constexpr int AT_KS = 136, AT_VS = 144;
constexpr int AT_TILE = 64 * AT_KS * 2, AT_VTILE = 64 * AT_VS * 2;
constexpr int AT_LDS_K = 0, AT_LDS_V = 2 * AT_TILE, AT_LDS_TAB = AT_LDS_V + 2 * AT_VTILE, AT_LDS_BYTES = AT_LDS_TAB + 2 * 260 * 4;
template <bool SAMP>
__device__ __forceinline__ void attn_unit(const Args& a, LAS unsigned char* lds, int n, int cch, int hp) {
    unsigned char* ws = a.ws;
    const bf16_t* Qb = (const bf16_t*)(ws + WS_H); const bf16_t* Kb = Qb + (size_t)M * D; const bf16_t* Vb = Kb + (size_t)M * D; bf16_t* Y = (bf16_t*)(ws + WS_Y);
    const int tid = tid_fresh(), wave = __builtin_amdgcn_readfirstlane(tid >> 6), lane = tid & 63, G4 = lane >> 4, c = lane & 15, hh = wave >> 2, w4 = wave & 3;
    LAS float* tabs = (LAS float*)(lds + AT_LDS_TAB);
    const int srow = tid >> 4, scc = tid & 15;
    const int t0 = (!SAMP && cch < 8) ? 8 - cch : 0;
    const size_t qrow0 = SAMP ? (size_t)MP + (size_t)n * 64 : (size_t)n * SEQ + (size_t)cch * 64;
    const int h = 2 * hp + hh;
    __syncthreads();
    for (int i = tid; i < 2 * 257; i += 512) { const int th = i / 257, ti = i - th * 257; tabs[th * 260 + ti] = a.in[18][(size_t)(2 * hp + th) * 257 + ti]; }
    bf16x8 Qf[4];
    { const bf16_t* qp = Qb + (qrow0 + 16 * w4 + c) * D + h * HD + 8 * G4;
#pragma unroll
      for (int kk = 0; kk < 4; ++kk) Qf[kk] = *(const bf16x8*)(qp + 32 * kk); }
    f32x4 st[8];
    auto load_tile = [&](int tau) {
#pragma unroll
        for (int p = 0; p < 8; ++p) { const int r = srow + 32 * p, kv = r >> 7, th = (r >> 6) & 1, key = r & 63; const int hd = 2 * hp + th;
            const size_t krow = SAMP ? (size_t)MP + (size_t)n * 64 + key : (size_t)n * SEQ + (size_t)(cch - 8 + tau) * 64 + key;
            const bf16_t* src = (kv ? Vb : Kb) + krow * D + hd * HD + 8 * scc; st[p] = __builtin_bit_cast(f32x4, *(const u32x4*)src); }
    };
    auto store_tile = [&]() {
#pragma unroll
        for (int p = 0; p < 8; ++p) { const int r = srow + 32 * p, kv = r >> 7, th = (r >> 6) & 1, key = r & 63;
            *(LAS u32x4*)(lds + (kv ? AT_LDS_V + th * AT_VTILE + (key * AT_VS + 8 * scc) * 2 : AT_LDS_K + th * AT_TILE + (key * AT_KS + 8 * scc) * 2)) = __builtin_bit_cast(u32x4, st[p]); }
    };
    auto stage_f32 = [&](int tau) {
#pragma unroll
        for (int hf = 0; hf < 2; ++hf) {
#pragma unroll
            for (int p4 = 0; p4 < 4; ++p4) { const int p = 4 * hf + p4; const int r = srow + 32 * p, kv = r >> 7, th = (r >> 6) & 1, key = r & 63; const int hd = 2 * hp + th;
                const float* src = a.in[kv ? 5 : 4] + (((size_t)n * 512 + (size_t)tau * 64 + key) * NH + hd) * HD + 8 * scc;
                st[2 * p4] = *(const f32x4*)src; st[2 * p4 + 1] = *(const f32x4*)(src + 4); }
#pragma unroll
            for (int p4 = 0; p4 < 4; ++p4) { const int p = 4 * hf + p4; const int r = srow + 32 * p, kv = r >> 7, th = (r >> 6) & 1, key = r & 63;
                const f32x4 x0 = st[2 * p4], x1 = st[2 * p4 + 1]; u32x4 w; w.x = pk2(x0[0], x0[1]); w.y = pk2(x0[2], x0[3]); w.z = pk2(x1[0], x1[1]); w.w = pk2(x1[2], x1[3]);
                *(LAS u32x4*)(lds + (kv ? AT_LDS_V + th * AT_VTILE + (key * AT_VS + 8 * scc) * 2 : AT_LDS_K + th * AT_TILE + (key * AT_KS + 8 * scc) * 2)) = w; } }
    };
    f32x4 O[8];
#pragma unroll
    for (int i = 0; i < 8; ++i) O[i] = (f32x4){0.f, 0.f, 0.f, 0.f};
    float mrun = -1e30f, lrun = 0.f;
    const int qi = 16 * w4 + c;
    if (SAMP) stage_f32(0); else { load_tile(t0); store_tile(); }
    __syncthreads();
    const float bconst = tabs[hh * 260 + 256];
    const LAS unsigned char* kbase = lds + AT_LDS_K + hh * AT_TILE + (c * AT_KS + 8 * G4) * 2;
    const LAS unsigned char* vbase = lds + AT_LDS_V + hh * AT_VTILE + ((4 * G4 + (c >> 2)) * AT_VS + 4 * (c & 3)) * 2;
    for (int tau = t0; tau <= 8; ++tau) {
        if (SAMP ? tau == 7 : tau < 8) load_tile(tau + 1);
        f32x4 sa[4];
#pragma unroll
        for (int sub = 0; sub < 4; ++sub) { sa[sub] = (f32x4){0.f, 0.f, 0.f, 0.f};
            bf16x8 kf[4];
#pragma unroll
            for (int kk = 0; kk < 4; ++kk) kf[kk] = *(const LAS bf16x8*)(kbase + (16 * sub * AT_KS + 32 * kk) * 2);
#pragma unroll
            for (int kk = 0; kk < 4; ++kk) sa[sub] = mfma_t(kf[kk], Qf[kk], sa[sub]); }
        MFMA_POST4(sa[0], sa[1], sa[2], sa[3]);
        float mloc = -1e30f;
#pragma unroll
        for (int sub = 0; sub < 4; ++sub)
#pragma unroll
            for (int i = 0; i < 4; ++i) { float bias = bconst;
                if (tau >= 6) { int rel = qi - ((tau - 8) * 64 + 16 * sub + 4 * G4 + i); rel = rel > 128 ? 128 : rel; bias = tabs[hh * 260 + rel + 128]; }
                const float sv = sa[sub][i] * 0.08838834764831845f + bias; sa[sub][i] = sv; mloc = fmaxf(mloc, sv); }
        mloc = fmaxf(mloc, __shfl_xor(mloc, 16)); mloc = fmaxf(mloc, __shfl_xor(mloc, 32));
        const float mnew = fmaxf(mrun, mloc), alpha = __expf(mrun - mnew); mrun = mnew;
        float ps = 0.f;
#pragma unroll
        for (int sub = 0; sub < 4; ++sub)
#pragma unroll
            for (int i = 0; i < 4; ++i) { const float p = __expf(sa[sub][i] - mnew); sa[sub][i] = p; ps += p; }
        lrun = lrun * alpha + ps;
        u32x4 pw[2];
#pragma unroll
        for (int s2 = 0; s2 < 2; ++s2) { pw[s2].x = pk2(sa[2 * s2][0], sa[2 * s2][1]); pw[s2].y = pk2(sa[2 * s2][2], sa[2 * s2][3]); pw[s2].z = pk2(sa[2 * s2 + 1][0], sa[2 * s2 + 1][1]); pw[s2].w = pk2(sa[2 * s2 + 1][2], sa[2 * s2 + 1][3]); }
#pragma unroll
        for (int i = 0; i < 8; ++i) O[i] = O[i] * alpha;
        asm volatile("s_nop 4" : "+v"(pw[0]), "+v"(pw[1]), "+v"(O[0]), "+v"(O[1]), "+v"(O[2]), "+v"(O[3]), "+v"(O[4]), "+v"(O[5]), "+v"(O[6]), "+v"(O[7]));
#pragma unroll
        for (int dp = 0; dp < 4; ++dp) {
            bf16x8 vf[2][2];
#pragma unroll
            for (int d2 = 0; d2 < 2; ++d2)
#pragma unroll
                for (int s2 = 0; s2 < 2; ++s2) { const int dt = 2 * dp + d2;
                    const s16x4 va = __builtin_amdgcn_ds_read_tr16_b64_v4i16((LAS s16x4*)(vbase + ((32 * s2) * AT_VS + 16 * dt) * 2));
                    const s16x4 vb = __builtin_amdgcn_ds_read_tr16_b64_v4i16((LAS s16x4*)(vbase + ((32 * s2 + 16) * AT_VS + 16 * dt) * 2));
                    vf[d2][s2] = __builtin_shufflevector(va, vb, 0, 1, 2, 3, 4, 5, 6, 7); }
#pragma unroll
            for (int s2 = 0; s2 < 2; ++s2)
#pragma unroll
                for (int d2 = 0; d2 < 2; ++d2) O[2 * dp + d2] = mfma_t(vf[d2][s2], __builtin_bit_cast(bf16x8, pw[s2]), O[2 * dp + d2]); }
        MFMA_POST8(O[0], O[1], O[2], O[3], O[4], O[5], O[6], O[7]);
        if (tau < 8) { __syncthreads(); if (SAMP && tau < 7) stage_f32(tau + 1); else store_tile(); __syncthreads(); }
    }
    float lt = lrun; lt += __shfl_xor(lt, 16); lt += __shfl_xor(lt, 32);
    const float inv = 1.0f / lt;
    bf16_t* yp = Y + (qrow0 + 16 * w4 + c) * D + h * HD + 4 * G4;
#pragma unroll
    for (int dt = 0; dt < 8; ++dt) { u32x2 w; w.x = pk2(O[dt][0] * inv, O[dt][1] * inv); w.y = pk2(O[dt][2] * inv, O[dt][3] * inv); *(u32x2*)(yp + 16 * dt) = w; }
}
constexpr int AT2_BUF = AT_TILE + AT_VTILE;
constexpr int AT2_TAB = 2 * AT2_BUF, AT2_BYTES = AT2_TAB + 260 * 4;
template <bool SAMP>
__device__ __forceinline__ void attn_unit2(const Args& a, LAS unsigned char* lds, int n, int cch, int h) {
    constexpr int QC = SAMP ? 1 : 2;
    unsigned char* ws = a.ws;
    const bf16_t* Qb = (const bf16_t*)(ws + WS_H); const bf16_t* Kb = Qb + (size_t)M * D; const bf16_t* Vb = Kb + (size_t)M * D; bf16_t* Y = (bf16_t*)(ws + WS_Y);
    const int tid = tid_fresh(), wave = __builtin_amdgcn_readfirstlane(tid >> 6), lane = tid & 63, G4 = lane >> 4, c = lane & 15;
    LAS float* tabs = (LAS float*)(lds + AT2_TAB);
    const int k0 = SAMP ? 0 : (cch < 8 ? 0 : cch - 8), k1 = SAMP ? 8 : cch + 1;
    __syncthreads();
    if (wave >= 4) {
        const int tp = tid - 256, prow = tp >> 4, scc = tp & 15;
        f32x4 R[SAMP ? 16 : 8];
        auto tile_load = [&](int kc) {
            if (SAMP && kc < 8) {
#pragma unroll
                for (int p = 0; p < 8; ++p) { const int r = prow + 16 * p, kv = r >> 6, key = r & 63;
                    const float* src = a.in[kv ? 5 : 4] + (((size_t)n * 512 + (size_t)kc * 64 + key) * NH + h) * HD + 8 * scc; R[2 * p] = *(const f32x4*)src; R[2 * p + 1] = *(const f32x4*)(src + 4); }
            } else {
#pragma unroll
                for (int p = 0; p < 8; ++p) { const int r = prow + 16 * p, kv = r >> 6, key = r & 63;
                    const size_t krow = SAMP ? (size_t)MP + (size_t)n * 64 + key : (size_t)n * SEQ + (size_t)kc * 64 + key;
                    R[p] = __builtin_bit_cast(f32x4, *(const u32x4*)((kv ? Vb : Kb) + krow * D + h * HD + 8 * scc)); } }
        };
        auto tile_store = [&](int kc, int buf) {
            LAS unsigned char* bb = lds + buf * AT2_BUF;
#pragma unroll
            for (int p = 0; p < 8; ++p) { const int r = prow + 16 * p, kv = r >> 6, key = r & 63; u32x4 w;
                if (SAMP && kc < 8) { const f32x4 x0 = R[2 * p], x1 = R[2 * p + 1]; w.x = pk2(x0[0], x0[1]); w.y = pk2(x0[2], x0[3]); w.z = pk2(x1[0], x1[1]); w.w = pk2(x1[2], x1[3]); }
                else w = __builtin_bit_cast(u32x4, R[p]);
                *(LAS u32x4*)(bb + (kv ? AT_TILE + (key * AT_VS + 8 * scc) * 2 : (key * AT_KS + 8 * scc) * 2)) = w; }
        };
        for (int i = tp; i < 257; i += 256) tabs[i] = a.in[18][(size_t)h * 257 + i] * 1.4426950408889634f;
        tile_load(k0); tile_store(k0, 0);
        if (k0 < k1) tile_load(k0 + 1);
        __syncthreads();
        for (int kc = k0; kc <= k1; ++kc) {
            if (kc < k1) { tile_store(kc + 1, (kc - k0 + 1) & 1); if (kc + 1 < k1) tile_load(kc + 2); }
            __syncthreads(); }
        return;
    }
    const int w4 = wave;
    bf16x8 Qf[QC][4]; f32x4 O[QC][8]; float mrun[QC], lrun[QC];
#pragma unroll
    for (int q = 0; q < QC; ++q) { const size_t qrow = SAMP ? (size_t)MP + (size_t)n * 64 : (size_t)n * SEQ + (size_t)(cch + q) * 64;
        const bf16_t* qp = Qb + (qrow + 16 * w4 + c) * D + h * HD + 8 * G4;
#pragma unroll
        for (int kk = 0; kk < 4; ++kk) Qf[q][kk] = *(const bf16x8*)(qp + 32 * kk);
#pragma unroll
        for (int i = 0; i < 8; ++i) { O[q][i] = (f32x4){0.f, 0.f, 0.f, 0.f}; OPAQUE(O[q][i]); }
        mrun[q] = -1e30f; lrun[q] = 0.f; }
    const int qi = 16 * w4 + c;
    __syncthreads();
    const float bconst = tabs[256];
    for (int kc = k0; kc <= k1; ++kc) {
        const LAS unsigned char* bb = lds + ((kc - k0) & 1) * AT2_BUF;
        const LAS unsigned char* kbase = bb + (c * AT_KS + 8 * G4) * 2;
        const LAS unsigned char* vbase = bb + AT_TILE + ((4 * G4 + (c >> 2)) * AT_VS + 4 * (c & 3)) * 2;
#pragma unroll
        for (int q = 0; q < QC; ++q) {
            const int tau = SAMP ? kc : kc - (cch + q) + 8;
            if (tau >= 0 && tau <= 8) {
                f32x4 sa[4];
#pragma unroll
                for (int sub = 0; sub < 4; ++sub) { sa[sub] = (f32x4){0.f, 0.f, 0.f, 0.f}; OPAQUE(sa[sub]); }
#pragma unroll
                for (int sub = 0; sub < 4; ++sub)
#pragma unroll
                    for (int kk = 0; kk < 4; ++kk) { const bf16x8 kf = *(const LAS bf16x8*)(kbase + (16 * sub * AT_KS + 32 * kk) * 2); sa[sub] = mfma_a(kf, Qf[q][kk], sa[sub]); }
                float mloc = -1e30f;
#pragma unroll
                for (int sub = 0; sub < 4; ++sub)
#pragma unroll
                    for (int i = 0; i < 4; ++i) { float bias = bconst;
                        if (tau >= 6) { int rel = qi - ((tau - 8) * 64 + 16 * sub + 4 * G4 + i); rel = rel > 128 ? 128 : rel; bias = tabs[rel + 128]; }
                        const float sv = sa[sub][i] * (0.08838834764831845f * 1.4426950408889634f) + bias; sa[sub][i] = sv; mloc = fmaxf(mloc, sv); }
                mloc = fmaxf(mloc, __shfl_xor(mloc, 16)); mloc = fmaxf(mloc, __shfl_xor(mloc, 32));
                const float mnew = fmaxf(mrun[q], mloc), alpha = __builtin_amdgcn_exp2f(mrun[q] - mnew); mrun[q] = mnew;
                float ps = 0.f;
#pragma unroll
                for (int sub = 0; sub < 4; ++sub)
#pragma unroll
                    for (int i = 0; i < 4; ++i) { const float p = __builtin_amdgcn_exp2f(sa[sub][i] - mnew); sa[sub][i] = p; ps += p; }
                lrun[q] = lrun[q] * alpha + ps;
                u32x4 pw[2];
#pragma unroll
                for (int s2 = 0; s2 < 2; ++s2) { pw[s2].x = pk2(sa[2 * s2][0], sa[2 * s2][1]); pw[s2].y = pk2(sa[2 * s2][2], sa[2 * s2][3]); pw[s2].z = pk2(sa[2 * s2 + 1][0], sa[2 * s2 + 1][1]); pw[s2].w = pk2(sa[2 * s2 + 1][2], sa[2 * s2 + 1][3]); }
#pragma unroll
                for (int i = 0; i < 8; ++i) O[q][i] = O[q][i] * alpha;
#pragma unroll
                for (int dt = 0; dt < 8; ++dt)
#pragma unroll
                    for (int s2 = 0; s2 < 2; ++s2) {
                        const s16x4 va = __builtin_amdgcn_ds_read_tr16_b64_v4i16((LAS s16x4*)(vbase + ((32 * s2) * AT_VS + 16 * dt) * 2));
                        const s16x4 vb = __builtin_amdgcn_ds_read_tr16_b64_v4i16((LAS s16x4*)(vbase + ((32 * s2 + 16) * AT_VS + 16 * dt) * 2));
                        O[q][dt] = mfma_a(__builtin_shufflevector(va, vb, 0, 1, 2, 3, 4, 5, 6, 7), __builtin_bit_cast(bf16x8, pw[s2]), O[q][dt]); }
            }
        }
        __syncthreads();
    }
#pragma unroll
    for (int q = 0; q < QC; ++q) {
        float lt = lrun[q]; lt += __shfl_xor(lt, 16); lt += __shfl_xor(lt, 32);
        const float inv = 1.0f / lt;
        const size_t qrow = SAMP ? (size_t)MP + (size_t)n * 64 : (size_t)n * SEQ + (size_t)(cch + q) * 64;
        bf16_t* yp = Y + (qrow + 16 * w4 + c) * D + h * HD + 4 * G4;
#pragma unroll
        for (int dt = 0; dt < 8; ++dt) { u32x2 w; w.x = pk2(O[q][dt][0] * inv, O[q][dt][1] * inv); w.y = pk2(O[q][dt][2] * inv, O[q][dt][3] * inv); *(u32x2*)(yp + 16 * dt) = w; } }
}
__device__ __forceinline__ void ph_attn(const Args& a, LAS unsigned char* lds, int nblk, int b) {
    const int nper = (1536 + nblk - 1) / nblk;
    for (int i = 0; i < nper; ++i) { const int ii = (b & 1) ? (i + 4) % nper : i; const int u = b + ii * nblk; if (u >= 1536) continue;
        if (u < 1024) attn_unit2<false>(a, lds, u >> 8, 2 * ((u >> 4) & 15), u & 15);
        else { const int u2 = u - 1024; attn_unit2<true>(a, lds, u2 >> 4, 8, u2 & 15); }
    }
}

constexpr int HG_S = 136;
constexpr int HG_T64 = 64 * HG_S * 2;
constexpr int HGZ_QT = 0, HGZ_KT = HG_T64, HGZ_QH = 2 * HG_T64, HGZ_IS = 3 * HG_T64, HGZ_SS = 4 * HG_T64, HGZ_PART = HGZ_SS + 128 * HG_S * 2, HGZ_RED = HGZ_PART + 4096, HGZ_BYTES = HGZ_RED + 512;
constexpr int HGX_KH = 0, HGX_IS = HG_T64, HGX_PART = 2 * HG_T64, HGX_DK = HGX_PART + 4096, HGX_OUT = HGX_DK + 512, HGX_BYTES = HGX_OUT + 8 * 4096;
constexpr size_t SCR_DS = 0;
constexpr size_t SCR_DK = SCR_DS + (size_t)2048 * 16384 * 2;
constexpr size_t SCR_SP = SCR_DK + (size_t)2048 * 128 * 4;
static_assert(SCR_SP + (size_t)2048 * 16384 * 2 <= SCR_PART && SCR_PART + (size_t)3 * MS * D * 4 <= 252 * MiB, "scratch map");
struct HgPrep { float g[8][2]; float p[8][2]; float pref[2]; };
__device__ __forceinline__ void hg_loadf(const unsigned short* Fp, int kp, int tq, unsigned (&fv)[8]) {
#pragma unroll
    for (int j = 0; j < 8; ++j) fv[j] = *(const unsigned*)(Fp + (size_t)(8 * tq + j) * D + 2 * kp);
}
__device__ __forceinline__ void hg_prep(const unsigned (&fv)[8], LAS float* part, int kp, int tq, HgPrep& P) {
    float c0 = 1.f, c1 = 1.f;
#pragma unroll
    for (int j = 0; j < 8; ++j) { const f32x2 g = uph2(fv[j]); P.g[j][0] = g[0]; P.g[j][1] = g[1]; c0 *= 1.0f - g[0]; c1 *= 1.0f - g[1]; P.p[j][0] = c0; P.p[j][1] = c1; }
    *(LAS f32x2*)(part + tq * 128 + 2 * kp) = (f32x2){c0, c1};
    __syncthreads();
    float base0 = 1.f, base1 = 1.f, r0 = 1.f, r1 = 1.f;
#pragma unroll
    for (int q = 0; q < 8; ++q) { const f32x2 pp = *(const LAS f32x2*)(part + q * 128 + 2 * kp); if (q < tq) { base0 *= pp[0]; base1 *= pp[1]; } if (q < 4) { r0 *= pp[0]; r1 *= pp[1]; } }
#pragma unroll
    for (int j = 0; j < 8; ++j) { P.p[j][0] *= base0; P.p[j][1] *= base1; }
    P.pref[0] = r0; P.pref[1] = r1;
}
__device__ __forceinline__ bf16x8 tr2(const LAS unsigned char* p0, const LAS unsigned char* p1) {
    const s16x4 va = __builtin_amdgcn_ds_read_tr16_b64_v4i16((LAS s16x4*)p0), vb = __builtin_amdgcn_ds_read_tr16_b64_v4i16((LAS s16x4*)p1);
    return __builtin_shufflevector(va, vb, 0, 1, 2, 3, 4, 5, 6, 7);
}
__device__ __forceinline__ void hg_decode(int u, bool& samp, int& n, int& h, int& ch, size_t& row0) {
    if (u < 2048) { samp = false; ch = u & 31; h = (u >> 5) & 15; n = u >> 9; row0 = (size_t)n * SEQ + (size_t)ch * 64; }
    else { samp = true; const int u2 = u - 2048; h = u2 & 15; n = u2 >> 4; ch = 0; row0 = (size_t)MP + (size_t)n * 64; }
}
constexpr int HX2_KH = 0, HX2_IS = HG_T64, HX2_DK = 2 * HG_T64, HX2_BUF = HX2_DK + 512, HX2_OUT = 2 * HX2_BUF, HX2_BYTES = HX2_OUT + 4 * 8192;
__device__ __forceinline__ void ph_hgrn_x(const Args& a, LAS unsigned char* lds, int nblk, int b) {
    unsigned char* ws = a.ws; const bf16_t* Ib = (const bf16_t*)(ws + WS_H) + (size_t)M * D; const unsigned short* F = (const unsigned short*)(ws + WS_Z);
    const int tid = tid_fresh(), wave = __builtin_amdgcn_readfirstlane(tid >> 6), lane = tid & 63, G4 = lane >> 4, c = lane & 15;
    const int nun = (2560 - b + nblk - 1) / nblk;
    __syncthreads();
    if (wave >= 4) {
        auto prepare = [&](int u, int buf) {
            bool samp; int n, h, ch; size_t row0; hg_decode(u, samp, n, h, ch, row0);
            LAS unsigned char* bb = lds + buf * HX2_BUF;
            if (wave == 4) {
                const unsigned short* Fp = F + row0 * D + h * 128 + 2 * lane; float r0 = 1.f, r1 = 1.f;
                unsigned fv[64];
#pragma unroll
                for (int j = 0; j < 64; ++j) fv[j] = *(const unsigned*)(Fp + (size_t)j * D);
#pragma unroll
                for (int j = 63; j >= 0; --j) { const f32x2 g = uph2(fv[j]);
                    *(LAS unsigned*)(bb + HX2_KH + (j * HG_S + 2 * lane) * 2) = pk2(g[0] * r0, g[1] * r1); r0 *= 1.0f - g[0]; r1 *= 1.0f - g[1]; }
                *(LAS f32x2*)(bb + HX2_DK + 8 * lane) = (f32x2){r0, r1};
                if (!samp) *(f32x2*)((float*)(ws + WS_SCR + SCR_DK) + (size_t)u * 128 + 2 * lane) = (f32x2){r0, r1};
            } else if (wave < 7) {
                const int t2 = tid - 320, r = t2 >> 1, hf = t2 & 1; const u32x4* src = (const u32x4*)(Ib + (row0 + r) * D + h * 128 + 64 * hf);
                LAS u32x4* dst = (LAS u32x4*)(bb + HX2_IS + (r * HG_S + 64 * hf) * 2); u32x4 v[8];
#pragma unroll
                for (int i = 0; i < 8; ++i) v[i] = src[i];
#pragma unroll
                for (int i = 0; i < 8; ++i) dst[i] = v[i];
            }
        };
        prepare(b, 0);
        __syncthreads();
        for (int i = 0; i < nun; ++i) { if (i + 1 < nun) prepare(b + (i + 1) * nblk, (i + 1) & 1); __syncthreads(); }
        return;
    }
    __syncthreads();
    for (int i = 0; i < nun; ++i) {
        const int u = b + i * nblk; bool samp; int n, h, ch; size_t row0; hg_decode(u, samp, n, h, ch, row0);
        const LAS unsigned char* bb = lds + (i & 1) * HX2_BUF; const LAS float* dk = (const LAS float*)(bb + HX2_DK);
        LAS unsigned char* ost = lds + HX2_OUT + wave * 8192;
#pragma unroll
        for (int m2 = 0; m2 < 2; ++m2) { const int mk = 2 * wave + m2;
            const LAS unsigned char* ka = bb + HX2_KH + ((8 * G4 + (c >> 2)) * HG_S + 16 * mk + 4 * (c & 3)) * 2;
            const LAS unsigned char* ia = bb + HX2_IS + ((8 * G4 + (c >> 2)) * HG_S + 4 * (c & 3)) * 2;
            bf16x8 kfr[2];
#pragma unroll
            for (int kt = 0; kt < 2; ++kt) kfr[kt] = tr2(ka + (32 * kt) * HG_S * 2, ka + (32 * kt + 4) * HG_S * 2);
            const float dkc = dk[16 * mk + c];
#pragma unroll
            for (int nv = 0; nv < 8; ++nv) { f32x4 acc = (f32x4){0.f, 0.f, 0.f, 0.f}; OPAQUE(acc);
#pragma unroll
                for (int kt = 0; kt < 2; ++kt) { const bf16x8 ifr = tr2(ia + ((32 * kt) * HG_S + 16 * nv) * 2, ia + ((32 * kt + 4) * HG_S + 16 * nv) * 2); acc = mfma_a(ifr, kfr[kt], acc); }
                if (!samp) { u32x2 w; w.x = pk2(acc[0], acc[1]); w.y = pk2(acc[2], acc[3]); *(LAS u32x2*)(ost + m2 * 4096 + (c * 128 + 16 * nv + 4 * G4) * 2) = w; }
                else { const size_t so = (((size_t)n * NH + h) * 128 + 16 * mk + c) * 128 + 16 * nv + 4 * G4;
                    const f32x4 s0 = *(const f32x4*)(a.in[6] + so); *(f32x4*)(a.out + O_HS + so) = dkc * s0 + acc; } } }
        if (!samp) {
            asm volatile("s_waitcnt lgkmcnt(0)" ::: "memory");
            bf16_t* dsu = (bf16_t*)(ws + WS_SCR + SCR_DS) + (size_t)u * 16384 + (size_t)(32 * wave) * 128;
#pragma unroll
            for (int q = 0; q < 8; ++q) { const int row = 4 * q + (lane >> 4), chq = lane & 15; *(u32x4*)(dsu + row * 128 + 8 * chq) = *(const LAS u32x4*)(ost + (row * 128 + 8 * chq) * 2); }
            asm volatile("s_waitcnt lgkmcnt(0)" ::: "memory");
        }
        __syncthreads();
    }
}
__device__ __forceinline__ void ph_hgrn_y(const Args& a, int nblk, int b) {
    unsigned char* ws = a.ws; const bf16_t* DS = (const bf16_t*)(ws + WS_SCR + SCR_DS); const float* DK = (const float*)(ws + WS_SCR + SCR_DK); bf16_t* SP = (bf16_t*)(ws + WS_SCR + SCR_SP);
    const int nth = nblk * 512;
    const int tid = tid_fresh();
    for (int e4 = b * 512 + tid; e4 < 64 * 4096; e4 += nth) {
        const int pr = e4 >> 12, off = (e4 & 4095) * 4, k = off >> 7;
        f32x4 S = (f32x4){0.f, 0.f, 0.f, 0.f};
#pragma unroll 1
        for (int c8 = 0; c8 < 32; c8 += 8) {
            f32x4 d[8]; float dk[8];
#pragma unroll
            for (int i = 0; i < 8; ++i) { const size_t u = (size_t)pr * 32 + c8 + i; const u32x2 w = *(const u32x2*)(DS + u * 16384 + off);
                d[i] = (f32x4){__builtin_bit_cast(float, w.x << 16), __builtin_bit_cast(float, w.x & 0xffff0000u), __builtin_bit_cast(float, w.y << 16), __builtin_bit_cast(float, w.y & 0xffff0000u)}; dk[i] = DK[u * 128 + k]; }
#pragma unroll
            for (int i = 0; i < 8; ++i) { const size_t u = (size_t)pr * 32 + c8 + i;
                u32x2 w; w.x = pk2(S[0], S[1]); w.y = pk2(S[2], S[3]); *(u32x2*)(SP + u * 16384 + off) = w; S = S * dk[i] + d[i]; } }
        *(f32x4*)(a.out + O_HP + (size_t)pr * 16384 + off) = S;
    }
}
__device__ __forceinline__ void ph_hgrn_z(const Args& a, LAS unsigned char* lds, int nblk, int b) {
    unsigned char* ws = a.ws; const bf16_t* Qb = (const bf16_t*)(ws + WS_H); const bf16_t* Ib = Qb + (size_t)M * D; const bf16_t* Gb = Ib + (size_t)M * D; const unsigned short* F = (const unsigned short*)(ws + WS_Z);
    bf16_t* Y = (bf16_t*)(ws + WS_Y); const bf16_t* SP = (const bf16_t*)(ws + WS_SCR + SCR_SP);
    const int tid = tid_fresh(), wave = __builtin_amdgcn_readfirstlane(tid >> 6), lane = tid & 63, G4 = lane >> 4, c = lane & 15, kp = tid & 63, tq = tid >> 6;
    LAS float* part = (LAS float*)(lds + HGZ_PART); LAS float* red = (LAS float*)(lds + HGZ_RED);
    const int mt = wave;
    unsigned fF[8]; unsigned fQ[8]; u32x4 fI[2]; f32x4 fS[8];
    auto ldunit = [&](int u2) { bool s2; int n2, h2, c2; size_t r2; hg_decode(u2, s2, n2, h2, c2, r2); hg_loadf(F + r2 * D + h2 * 128, kp, tq, fF);
#pragma unroll
        for (int j = 0; j < 8; ++j) fQ[j] = *(const unsigned*)(Qb + (r2 + 8 * tq + j) * D + h2 * 128 + 2 * kp);
        const u32x4* src = (const u32x4*)(Ib + (r2 + (tid >> 3)) * D + h2 * 128 + 16 * (tid & 7)); fI[0] = src[0]; fI[1] = src[1];
        const int r = tid >> 2, cq = tid & 3;
        if (!s2) { const u32x4* sp = (const u32x4*)(SP + (size_t)u2 * 16384 + r * 128 + 32 * cq);
#pragma unroll
            for (int i = 0; i < 4; ++i) fS[i] = __builtin_bit_cast(f32x4, sp[i]); }
        else { const f32x4* sp = (const f32x4*)(a.in[6] + (((size_t)n2 * NH + h2) * 128 + r) * 128 + 32 * cq);
#pragma unroll
            for (int i = 0; i < 8; ++i) fS[i] = sp[i]; } };
    __syncthreads();
    if (tid < 128) red[tid] = a.in[22][tid];
    if (b < 2560) ldunit(b);
    for (int u = b; u < 2560; u += nblk) {
        bool samp; int n, h, ch; size_t row0; hg_decode(u, samp, n, h, ch, row0);
        __syncthreads();
        HgPrep P; hg_prep(fF, part, kp, tq, P);
#pragma unroll
        for (int j = 0; j < 8; ++j) { const int t = 8 * tq + j; const unsigned qw = fQ[j];
            const float q0 = __builtin_bit_cast(float, qw << 16), q1 = __builtin_bit_cast(float, qw & 0xffff0000u);
            const float ir0 = __builtin_amdgcn_rcpf(P.pref[0]), ir1 = __builtin_amdgcn_rcpf(P.pref[1]), ip0 = __builtin_amdgcn_rcpf(P.p[j][0]), ip1 = __builtin_amdgcn_rcpf(P.p[j][1]);
            *(LAS unsigned*)(lds + HGZ_QT + (t * HG_S + 2 * kp) * 2) = pk2(q0 * P.p[j][0] * ir0, q1 * P.p[j][1] * ir1);
            *(LAS unsigned*)(lds + HGZ_KT + (t * HG_S + 2 * kp) * 2) = pk2(P.g[j][0] * P.pref[0] * ip0, P.g[j][1] * P.pref[1] * ip1);
            *(LAS unsigned*)(lds + HGZ_QH + (t * HG_S + 2 * kp) * 2) = pk2(q0 * P.p[j][0], q1 * P.p[j][1]); }
        { const int r = tid >> 3, cq = tid & 7; LAS u32x4* dst = (LAS u32x4*)(lds + HGZ_IS + (r * HG_S + 16 * cq) * 2); dst[0] = fI[0]; dst[1] = fI[1]; }
        { const int r = tid >> 2, cq = tid & 3; LAS u32x4* dst = (LAS u32x4*)(lds + HGZ_SS + (r * HG_S + 32 * cq) * 2);
          if (!samp) {
#pragma unroll
              for (int i = 0; i < 4; ++i) dst[i] = __builtin_bit_cast(u32x4, fS[i]); }
          else {
#pragma unroll
              for (int i = 0; i < 4; ++i) { const f32x4 x0 = fS[2 * i], x1 = fS[2 * i + 1]; u32x4 w; w.x = pk2(x0[0], x0[1]); w.y = pk2(x0[2], x0[3]); w.z = pk2(x1[0], x1[1]); w.w = pk2(x1[2], x1[3]); dst[i] = w; } } }
        if (u + nblk < 2560) ldunit(u + nblk);
        __syncthreads();
        if (wave < 4) {
        const size_t yo = (row0 + 16 * mt + c) * D + h * 128 + 4 * G4;
        bf16x8 Qf[4], kf[4][4], vf0[8];
#pragma unroll
        for (int kk = 0; kk < 4; ++kk) Qf[kk] = *(const LAS bf16x8*)(lds + HGZ_QT + ((16 * mt + c) * HG_S + 32 * kk + 8 * G4) * 2);
#pragma unroll
        for (int ns = 0; ns < 4; ++ns)
#pragma unroll
            for (int kk = 0; kk < 4; ++kk) kf[ns][kk] = *(const LAS bf16x8*)(lds + HGZ_KT + ((16 * ns + c) * HG_S + 32 * kk + 8 * G4) * 2);
        const LAS unsigned char* ia = lds + HGZ_IS + ((4 * G4 + (c >> 2)) * HG_S + 4 * (c & 3)) * 2;
        const LAS unsigned char* sa = lds + HGZ_SS + ((8 * G4 + (c >> 2)) * HG_S + 4 * (c & 3)) * 2;
#pragma unroll
        for (int j = 0; j < 8; ++j) vf0[j] = tr2(ia + (16 * j) * 2, ia + (16 * HG_S + 16 * j) * 2);
        f32x4 At[4];
#pragma unroll
        for (int ns = 0; ns < 4; ++ns) { At[ns] = (f32x4){0.f, 0.f, 0.f, 0.f}; OPAQUE(At[ns]); }
#pragma unroll
        for (int kk = 0; kk < 4; ++kk)
#pragma unroll
            for (int ns = 0; ns < 4; ++ns) At[ns] = mfma_a(kf[ns][kk], Qf[kk], At[ns]);
        u32x2 gwv[8];
#pragma unroll
        for (int j = 0; j < 8; ++j) gwv[j] = *(const u32x2*)(Gb + yo + 16 * j);
        bf16x8 vf1[8], qh[4], sf[2][8];
#pragma unroll
        for (int j = 0; j < 8; ++j) vf1[j] = tr2(ia + ((32) * HG_S + 16 * j) * 2, ia + ((32 + 16) * HG_S + 16 * j) * 2);
#pragma unroll
        for (int kk = 0; kk < 4; ++kk) qh[kk] = *(const LAS bf16x8*)(lds + HGZ_QH + ((16 * mt + c) * HG_S + 32 * kk + 8 * G4) * 2);
#pragma unroll
        for (int ns = 0; ns < 4; ++ns)
#pragma unroll
            for (int i = 0; i < 4; ++i) if (16 * ns + 4 * G4 + i > 16 * mt + c) At[ns][i] = 0.f;
        f32x4 o[8];
#pragma unroll
        for (int j = 0; j < 8; ++j) { o[j] = (f32x4){0.f, 0.f, 0.f, 0.f}; OPAQUE(o[j]); }
        u32x4 pw[2];
#pragma unroll
        for (int ks = 0; ks < 2; ++ks) { pw[ks].x = pk2(At[2 * ks][0], At[2 * ks][1]); pw[ks].y = pk2(At[2 * ks][2], At[2 * ks][3]); pw[ks].z = pk2(At[2 * ks + 1][0], At[2 * ks + 1][1]); pw[ks].w = pk2(At[2 * ks + 1][2], At[2 * ks + 1][3]); }
#pragma unroll
        for (int j = 0; j < 8; ++j) o[j] = mfma_a(vf0[j], __builtin_bit_cast(bf16x8, pw[0]), o[j]);
#pragma unroll
        for (int j = 0; j < 8; ++j) sf[0][j] = tr2(sa + (16 * j) * 2, sa + (4 * HG_S + 16 * j) * 2);
#pragma unroll
        for (int j = 0; j < 8; ++j) o[j] = mfma_a(vf1[j], __builtin_bit_cast(bf16x8, pw[1]), o[j]);
#pragma unroll
        for (int kk = 0; kk < 4; ++kk) {
            if (kk < 3) {
#pragma unroll
                for (int j = 0; j < 8; ++j) sf[(kk + 1) & 1][j] = tr2(sa + ((32 * (kk + 1)) * HG_S + 16 * j) * 2, sa + ((32 * (kk + 1) + 4) * HG_S + 16 * j) * 2); }
#pragma unroll
            for (int j = 0; j < 8; ++j) o[j] = mfma_a(sf[kk & 1][j], qh[kk], o[j]); }
        float ss = 0.f;
#pragma unroll
        for (int j = 0; j < 8; ++j)
#pragma unroll
            for (int i = 0; i < 4; ++i) ss += o[j][i] * o[j][i];
        ss += __shfl_xor(ss, 16); ss += __shfl_xor(ss, 32);
        const float sc = 1.0f / sqrtf(ss * (1.0f / 128.0f) + RMS_EPS);
#pragma unroll
        for (int j = 0; j < 8; ++j) { const u32x2 gw = gwv[j]; const f32x4 ng = *(const LAS f32x4*)(red + 16 * j + 4 * G4);
            const float g0 = __builtin_bit_cast(float, gw.x << 16), g1 = __builtin_bit_cast(float, gw.x & 0xffff0000u), g2 = __builtin_bit_cast(float, gw.y << 16), g3 = __builtin_bit_cast(float, gw.y & 0xffff0000u);
            u32x2 w; w.x = pk2(o[j][0] * sc * ng[0] * g0 * sigmoidf_(g0), o[j][1] * sc * ng[1] * g1 * sigmoidf_(g1)); w.y = pk2(o[j][2] * sc * ng[2] * g2 * sigmoidf_(g2), o[j][3] * sc * ng[3] * g3 * sigmoidf_(g3));
            *(u32x2*)(Y + yo + 16 * j) = w; }
        }
    }
}

template <int L> __device__ __forceinline__ void do_layer(const Args& a, LAS unsigned char* lds, const XcdBarrier& bar, int G, int b) {
    unsigned char* ws = a.ws;
    bf16_t* XB = (bf16_t*)(ws + WS_XB); bf16_t* Z = (bf16_t*)(ws + WS_Z); unsigned short* ZF = (unsigned short*)(ws + WS_Z); bf16_t* H = (bf16_t*)(ws + WS_H); bf16_t* Y = (bf16_t*)(ws + WS_Y);
    constexpr int kind = L % 3, j = L / 3; bf16_t* PS = (bf16_t*)(ws + WS_SCR + SCR_PART);
    if constexpr (kind == 0) {
        if (L == 0 || G != 256) ph_ssm<L == 0>(a, lds, j, L, G, b); else ph_ssm_split(a, lds, j, L, b);
        xcd_barrier(bar);
        pg8::Gemm g{Y, (const bf16_t*)(ws + WS_WSSM) + (size_t)j * 4096 * D, D, D}; pg8::BStatOrder S; S.init(M, 4096, D, b);
        EpiSsmGate E{Z}; pg8::gemm_phase<EpiSsmGate, pg8::BStatOrder>(lds, g, S, E);
    } else if constexpr (kind == 1) {
        { pg8::Gemm g{XB, (const bf16_t*)(ws + WS_WQKV), D, D}; pg8::BStatOrder S; S.init(M, 6144, D, b);
          EpiQkv E{H, a.out}; pg8::gemm_phase<EpiQkv, pg8::BStatOrder>(lds, g, S, E); }
        xcd_barrier(bar);
        ph_attn(a, lds, G, b);
        xcd_barrier(bar);
        { pg8::Gemm g{Y, (const bf16_t*)(ws + WS_WAO), D, D}; pg8::SplitOrder S; S.init(D, b);
          EpiRes E{Z, PS}; pg8::gemm_phase<EpiRes, pg8::SplitOrder>(lds, g, S, E); }
    } else {
        { pg8::Gemm g{XB, (const bf16_t*)(ws + WS_WHIN), D, D}; pg8::BStatOrder S; S.init(M, 8192, D, b);
          EpiHgrnIn E{H, ZF, (const float*)(ws + WS_PAR + PAR_LB)}; pg8::gemm_phase<EpiHgrnIn, pg8::BStatOrder>(lds, g, S, E); }
        xcd_barrier(bar);
        ph_hgrn_x(a, lds, G, b);
        xcd_barrier(bar);
        ph_hgrn_y(a, G, b);
        xcd_barrier(bar);
        ph_hgrn_z(a, lds, G, b);
        xcd_barrier(bar);
        { pg8::Gemm g{Y, (const bf16_t*)(ws + WS_WHO), D, D}; pg8::SplitOrder S; S.init(D, b);
          EpiRes E{Z, PS}; pg8::gemm_phase<EpiRes, pg8::SplitOrder>(lds, g, S, E); }
    }
    xcd_barrier(bar);
    ph_ln(a, L, 0, false, kind != 0, false, L == 0, G, b);
    xcd_barrier(bar);
    { pg8::Gemm g{XB, (const bf16_t*)(ws + WS_WF1) + (size_t)L * FF * D, D, D}; pg8::BStatOrder S; S.init(M, FF, D, b);
      EpiFfn1 E{H}; pg8::gemm_phase<EpiFfn1, pg8::BStatOrder>(lds, g, S, E); }
    xcd_barrier(bar);
    { pg8::Gemm g{H, (const bf16_t*)(ws + WS_WF2) + (size_t)L * FF * D, FF, FF}; pg8::SplitOrder S; S.init(FF, b);
      EpiRes E{Z, PS}; pg8::gemm_phase<EpiRes, pg8::SplitOrder, true>(lds, g, S, E); }
    xcd_barrier(bar);
    ph_ln(a, L, 1, L == 3, true, L == 2, false, G, b);
    if constexpr (L < 3) xcd_barrier(bar);
}
constexpr int LDS_BAR_OFF = 131072;
constexpr int LDS_BYTES = LDS_BAR_OFF + 1024;
static_assert(pg8::STAGE_BYTES <= LDS_BAR_OFF && HGZ_BYTES <= LDS_BAR_OFF && HX2_BYTES <= LDS_BAR_OFF && AT2_BYTES <= LDS_BAR_OFF && SSM_EXCH + 8 * 64 * 8 <= LDS_BAR_OFF && 2 * SSM_WLDS + 6 * CONV_LDS <= LDS_BAR_OFF && CONV_LDS >= SSM_WLDS, "LDS map");
constexpr int CW_BAR = 4096;
__global__ void __launch_bounds__(512, 2) k_mega(Args a) {
    extern __shared__ __attribute__((aligned(16))) unsigned char lds_raw[];
    LAS unsigned char* lds = (LAS unsigned char*)lds_raw;
    unsigned char* ws = a.ws;
    if (threadIdx.x < 4) ((LAS unsigned*)(lds + LDS_BAR_OFF))[threadIdx.x] = 0u;
    __syncthreads();
    const XcdBarrier bar = xcd_barrier_post((unsigned*)(ws + WS_CTL) + CW_BAR, (volatile LAS unsigned*)(lds + LDS_BAR_OFF));
    const int G = gridDim.x, b = blockIdx.x;
    ph_params(a, G, b);
    xcd_barrier(bar);
    do_layer<0>(a, lds, bar, G, b);
    do_layer<1>(a, lds, bar, G, b);
    do_layer<2>(a, lds, bar, G, b);
    do_layer<3>(a, lds, bar, G, b);
}

extern "C" void kernel_launch(void* const* d_in, const int* in_sizes, int n_in, void* d_out, int out_size, void* d_ws, size_t ws_size, hipStream_t stream) {
    static int grid = 0;
    if (grid == 0) {
        if (n_in != 30 || (size_t)out_size != O_END || ws_size < WS_END) { fprintf(stderr, "kernel_launch: unexpected shapes (n_in %d out %d ws %zu, need %zu)\n", n_in, out_size, ws_size, (size_t)WS_END); grid = -1; return; }
        int dev = 0, cus = 0, per_cu = 0;
        if (hipGetDevice(&dev) != hipSuccess || hipDeviceGetAttribute(&cus, hipDeviceAttributeMultiprocessorCount, dev) != hipSuccess) { grid = -1; return; }
        if (hipFuncSetAttribute((const void*)k_mega, hipFuncAttributeMaxDynamicSharedMemorySize, LDS_BYTES) != hipSuccess) { fprintf(stderr, "kernel_launch: hipFuncSetAttribute failed\n"); grid = -1; return; }
        if (hipOccupancyMaxActiveBlocksPerMultiprocessor(&per_cu, (const void*)k_mega, 512, LDS_BYTES) != hipSuccess || per_cu < 1) fprintf(stderr, "kernel_launch: occupancy query says %d\n", per_cu);
        (void)hipGetLastError();
        grid = cus;
    }
    if (grid < 0) return;
    (void)hipMemsetAsync((char*)d_ws + WS_CTL, 0, 64 * 1024, stream);
    Args a{}; for (int i = 0; i < 30; ++i) a.in[i] = (const float*)d_in[i]; a.out = (float*)d_out; a.ws = (unsigned char*)d_ws;
    hipLaunchKernelGGL(k_mega, dim3(grid), dim3(512), LDS_BYTES, stream, a);
}
```

```cpp
#include <hip/hip_runtime.h>
#include <cstdio>
#include <cstdint>

#define LAS __attribute__((address_space(3)))
typedef unsigned short bf16_t;
typedef short bf16x8 __attribute__((ext_vector_type(8)));
typedef float f32x4 __attribute__((ext_vector_type(4)));
typedef float f32x2 __attribute__((ext_vector_type(2)));
typedef unsigned u32x4 __attribute__((ext_vector_type(4)));
typedef unsigned u32x2 __attribute__((ext_vector_type(2)));

constexpr int D = 2048, SEQ = 2048, NB = 4, DB = 32, DSEQ = 64, FF = 8192;
constexpr int MP = NB * SEQ, MS = DB * DSEQ, M = MP + MS;
constexpr int NG = 128, NP = 64, NQ = 16;
constexpr int NH = 16, HD = 128;
constexpr float ALPHA = 1.6817928305074290f;
constexpr float LN_EPS = 1e-5f, RMS_EPS = 1e-6f;
constexpr size_t O_YP = 0, O_YS = O_YP + (size_t)MP * D, O_SRP = O_YS + (size_t)MS * D, O_SIP = O_SRP + 2 * NB * NG * NP,
                 O_KP = O_SIP + 2 * NB * NG * NP, O_VP = O_KP + (size_t)NB * 512 * D, O_HP = O_VP + (size_t)NB * 512 * D,
                 O_SRS = O_HP + (size_t)NB * NH * 128 * 128, O_SIS = O_SRS + 2 * DB * NG * NP, O_KS = O_SIS + 2 * DB * NG * NP,
                 O_VS = O_KS + (size_t)MS * D, O_HS = O_VS + (size_t)MS * D, O_END = O_HS + (size_t)DB * NH * 128 * 128;

constexpr size_t MiB = 1u << 20;
constexpr size_t WS_CTL = 0;
constexpr size_t WS_WSSM = 1 * MiB;
constexpr size_t WS_WQKV = WS_WSSM + 32 * MiB;
constexpr size_t WS_WAO = WS_WQKV + 24 * MiB;
constexpr size_t WS_WHIN = WS_WAO + 8 * MiB;
constexpr size_t WS_WHO = WS_WHIN + 32 * MiB;
constexpr size_t WS_WF1 = WS_WHO + 8 * MiB;
constexpr size_t WS_WF2 = WS_WF1 + 128 * MiB;
constexpr size_t WS_X = WS_WF2 + 128 * MiB;
constexpr size_t WS_XB = WS_X + 80 * MiB;
constexpr size_t WS_Z = WS_XB + 40 * MiB;
constexpr size_t WS_H = WS_Z + 80 * MiB;
constexpr size_t WS_Y = WS_H + 160 * MiB;
constexpr size_t WS_PAR = WS_Y + 40 * MiB;
constexpr size_t WS_SCR = WS_PAR + 8 * MiB;
constexpr size_t WS_END = WS_SCR + 252 * MiB;
constexpr size_t SCR_PART = 200 * MiB;
constexpr size_t PAR_ABAR = 0;
constexpr size_t PAR_BBAR = PAR_ABAR + 2 * NG * NP * 2 * 4;
constexpr size_t PAR_LB = PAR_BBAR + (size_t)2 * NG * NP * NQ * 2 * 4;
constexpr size_t PAR_BFRAG = PAR_LB + D * 4;
constexpr size_t PAR_CFRAG = PAR_BFRAG + (size_t)2 * NG * 8 * 64 * 16;
constexpr size_t PAR_END = PAR_CFRAG + (size_t)2 * NG * 4 * 64 * 16;
static_assert(PAR_END <= 8 * MiB, "params region");

__device__ __forceinline__ unsigned f2bf(float f) { unsigned u = __builtin_bit_cast(unsigned, f); return (u + 0x7fffu + ((u >> 16) & 1u)) >> 16; }
typedef __bf16 bf16x2_t __attribute__((ext_vector_type(2)));
__device__ __forceinline__ unsigned pk2(float lo, float hi) { const f32x2 v = {lo, hi}; return __builtin_bit_cast(unsigned, __builtin_convertvector(v, bf16x2_t)); }
typedef _Float16 f16x2_t __attribute__((ext_vector_type(2)));
__device__ __forceinline__ unsigned pkh2(float lo, float hi) { const f32x2 v = {lo, hi}; return __builtin_bit_cast(unsigned, __builtin_convertvector(v, f16x2_t)); }
__device__ __forceinline__ f32x2 uph2(unsigned w) { return __builtin_convertvector(__builtin_bit_cast(f16x2_t, w), f32x2); }
__device__ __forceinline__ float bf2f(bf16_t b) { return __builtin_bit_cast(float, (unsigned)b << 16); }
__device__ __forceinline__ float sigmoidf_(float x) { return __builtin_amdgcn_rcpf(1.0f + __expf(-x)); }
__device__ __forceinline__ float gelu_tanh(float x) { const float t = 1.5957691216057308f * (x + 0.044715f * x * x * x); return x * __builtin_amdgcn_rcpf(1.0f + __expf(-t)); }

__device__ __forceinline__ int tid_fresh() { int t = threadIdx.x; asm volatile("" : "+v"(t)); return t; }
namespace pg8 {
constexpr int BM = 256, BK = 64, HALF = 128, HTB = HALF * BK * 2, STAGE_BYTES = 8 * HTB, NXCD = 8, WGM = 8;
__host__ __device__ __forceinline__ int lds_byte(int r, int c) { const int st = (r >> 4) * 2 + (c >> 5), rr = r & 15, cc = c & 31, ob = rr * 64 + cc * 2; return st * 1024 + (ob ^ (((ob >> 9) & 1) << 5)); }
__host__ __device__ __forceinline__ void stage_rc(int b, int& R, int& C) { const int st = b / 1024, sb = b % 1024, swz = sb ^ (((sb >> 9) & 1) << 5); R = (st >> 1) * 16 + swz / 64; C = (st & 1) * 32 + (swz % 64) / 2; }
__host__ __device__ __forceinline__ int perm32(int rho) { const int n = rho >> 4, i = rho & 15; return 8 * (i >> 2) + 4 * n + (i & 3); }

struct Unit { int pm, pn, k0, nt, part; };
struct Gemm { const bf16_t* A; const bf16_t* Bt; int lda, ldb; };

struct StaticOrder {
    int nM, nN, nwg, G, c, nt;
    __host__ __device__ void init(int M_, int N_, int K_, int G_, int c_) { nM = M_ / BM; nN = N_ / BM; nwg = nM * nN; G = G_; c = c_; nt = K_ / BK; }
    __host__ __device__ bool next(int i, Unit& u) const {
        const long L = (long)i * G + c; if (L >= nwg) return false;
        int wgid = (int)L; { const int q = nwg / NXCD, r = nwg % NXCD, xcd = wgid % NXCD, off = wgid / NXCD; wgid = (xcd < r ? xcd * (q + 1) : r * (q + 1) + (xcd - r) * q) + off; }
        const int nig = WGM * nN, gid = wgid / nig, fm = gid * WGM, gsz = (nM - fm) < WGM ? (nM - fm) : WGM;
        u.pm = fm + ((wgid % nig) % gsz); u.pn = (wgid % nig) / gsz; u.k0 = 0; u.nt = nt; u.part = 0; return true;
    }
    __device__ __forceinline__ void a_ready(const Unit&) const {}
    __device__ __forceinline__ void done(const Unit&) const {}
};

struct BStatOrder {
    int x, j, tpx, nM, nt;
    __host__ __device__ void init(int M_, int N_, int K_, int c_) { x = c_ & 7; j = c_ >> 3; tpx = N_ / BM / 8; nM = M_ / BM; nt = K_ / BK; }
    __host__ __device__ bool next(int r, Unit& u) const {
        const int q = r * 32 + j; if (q >= nM * tpx) return false;
        u.pm = q / tpx; u.pn = x * tpx + (q - u.pm * tpx); u.k0 = 0; u.nt = nt; u.part = 0; return true;
    }
    __device__ __forceinline__ void a_ready(const Unit&) const {}
    __device__ __forceinline__ void done(const Unit&) const {}
};
struct SplitOrder {
    int x, i, ntf;
    __host__ __device__ void init(int K_, int c_) { x = c_ & 7; i = c_ >> 3; ntf = K_ / BK; }
    __host__ __device__ bool next(int r, Unit& u) const {
        const int gidx = 4 * x + (i >> 3);
        if (r == 0) { u.pm = gidx; u.pn = i & 7; u.k0 = 0; u.nt = ntf; u.part = 0; return true; }
        if (r == 1) { const int part = gidx & 3; u.pm = 32 + (gidx >> 2); u.pn = i & 7; u.nt = ntf >> 2; u.k0 = part * (ntf >> 2) * BK; u.part = part; return true; }
        return false;
    }
    __device__ __forceinline__ void a_ready(const Unit&) const {}
    __device__ __forceinline__ void done(const Unit&) const {}
};
__device__ __forceinline__ unsigned cvt_pk_bf16(float lo, float hi) { return pk2(lo, hi); }

template <class Epi, class Sched, bool ABLK = false, bool ALIGN_EPI = true, bool SP2 = true, bool BBLK = true>
__device__ __forceinline__ void gemm_phase(LAS unsigned char* lds, const Gemm g, const Sched& S, const Epi& E) {
    const int tid = tid_fresh(), wid = __builtin_amdgcn_readfirstlane(tid >> 6), lane = tid & 63, wr = wid >> 2, wc = wid & 3, fr = lane & 15, fq = lane >> 4;
    unsigned voffA[2], voffB[2];
#pragma unroll
    for (int i = 0; i < 2; ++i) { int R, C; stage_rc(tid * 16 + i * 8192, R, C); const int r32 = Epi::PERM ? perm32(R & 31) : (R & 31);
        const int Rb = Epi::ADJ ? 64 * (R >> 5) + r32 : (R & ~31) + r32;
        voffA[i] = (unsigned)(R * (ABLK ? 64 : g.lda) + C) * 2u; voffB[i] = BBLK ? (unsigned)(R * 64 + C) * 2u : (unsigned)(Rb * g.ldb + C) * 2u; }
    const size_t kstep = (size_t)(BK * 2);
    const size_t hstepA = (size_t)HALF * (ABLK ? 64 : g.lda) * 2, hstepB = BBLK ? (size_t)16384 : (size_t)(Epi::ADJ ? 32 : HALF) * g.ldb * 2;
    const size_t tstepB = BBLK ? ((size_t)g.ldb / 64) * 32768 : (size_t)BM * g.ldb * 2;
    const size_t kstepB = BBLK ? (size_t)32768 : kstep;
    auto b_k0 = [&](int k0) -> size_t { return BBLK ? (size_t)(k0 / BK) * 32768 : (size_t)k0 * 2; };
    const unsigned ldsw = (unsigned)wid * 1024u;
    const int aoff = lds_byte(wr * 64 + fr, fq * 8), boff = lds_byte(wc * 32 + fr, fq * 8);
#define PG8_SA(b, h) (((b) * 2 + (h)) * HTB)
#define PG8_SB(b, h) ((4 + (b) * 2 + (h)) * HTB)
#define PG8_STAGE(bufoff, gbase, voff) do { _Pragma("unroll") for (int _i = 0; _i < 2; ++_i) \
        __builtin_amdgcn_global_load_lds((const unsigned*)((const char*)(gbase) + (voff)[_i]), (LAS unsigned*)(lds + (bufoff) + ldsw + _i * 8192), 16, 0, 0); } while (0)
#define PG8_LDA(dst, b, h) do { _Pragma("unroll") for (int m = 0; m < 4; ++m) _Pragma("unroll") for (int k = 0; k < 2; ++k) dst[m][k] = *(const LAS bf16x8*)(lds + PG8_SA(b, h) + aoff + m * 2048 + k * 1024); } while (0)
#define PG8_LDB(dst, b, h) do { _Pragma("unroll") for (int n = 0; n < 2; ++n) _Pragma("unroll") for (int k = 0; k < 2; ++k) dst[n][k] = *(const LAS bf16x8*)(lds + PG8_SB(b, h) + boff + n * 2048 + k * 1024); } while (0)
#define PG8_MMA(ai, bj, At, Bt) do { __builtin_amdgcn_s_setprio(1); _Pragma("unroll") for (int m = 0; m < 4; ++m) _Pragma("unroll") for (int n = 0; n < 2; ++n) _Pragma("unroll") for (int k = 0; k < 2; ++k) \
        acc[ai][bj][m][n] = __builtin_amdgcn_mfma_f32_16x16x32_bf16(Bt[n][k], At[m][k], acc[ai][bj][m][n], 0, 0, 0); __builtin_amdgcn_s_setprio(0); } while (0)
#define PG8_WAIT_V(n) asm volatile("s_waitcnt vmcnt(" #n ")" ::: "memory")
#define PG8_WAIT_L(n) asm volatile("s_waitcnt lgkmcnt(" #n ")" ::: "memory")
#define PG8_BAR __builtin_amdgcn_s_barrier()
#define PG8_SCHED __builtin_amdgcn_sched_barrier(0)
    Unit cur, nxt; int ui = 0;
    if (!S.next(0, cur)) return;
    f32x4 acc[2][2][4][2];
#pragma unroll
    for (int a = 0; a < 2; ++a)
#pragma unroll
        for (int b = 0; b < 2; ++b)
#pragma unroll
            for (int m = 0; m < 4; ++m)
#pragma unroll
                for (int n = 0; n < 2; ++n) acc[a][b][m][n] = (f32x4){0.f, 0.f, 0.f, 0.f};
    bf16x8 At[4][2], B0[2][2], B1[2][2];
    auto a_unit = [&](const Unit& u) -> const char* { return ABLK ? (const char*)g.A + (size_t)u.pm * ((size_t)g.lda / 64) * 32768 : (const char*)g.A + (size_t)u.pm * 2 * hstepA; };
    auto a_tile = [&](const char* ub, int tau) -> const char* { return ub + (size_t)tau * (ABLK ? (size_t)32768 : kstep); };
    const char* uA = a_unit(cur); int tbA = cur.k0 / BK;
    const char* cA = a_tile(uA, tbA); const char* cB = (const char*)g.Bt + (size_t)cur.pn * tstepB + b_k0(cur.k0);
    S.a_ready(cur);
    if constexpr (SP2) {
        PG8_STAGE(PG8_SB(0, 0), cB, voffB); PG8_STAGE(PG8_SB(0, 1), cB + hstepB, voffB); PG8_STAGE(PG8_SA(0, 0), cA, voffA); PG8_STAGE(PG8_SA(0, 1), cA + hstepA, voffA);
        if (wr == 1) PG8_BAR;
        PG8_WAIT_V(2); PG8_BAR;
        PG8_STAGE(PG8_SB(1, 0), cB + kstepB, voffB); PG8_STAGE(PG8_SA(1, 0), a_tile(uA, tbA + 1), voffA); PG8_STAGE(PG8_SB(1, 1), cB + hstepB + kstepB, voffB);
        PG8_WAIT_V(6); PG8_BAR;
    } else {
        PG8_STAGE(PG8_SB(0, 0), cB, voffB); PG8_STAGE(PG8_SA(0, 0), cA, voffA); PG8_STAGE(PG8_SB(0, 1), cB + hstepB, voffB); PG8_STAGE(PG8_SA(0, 1), cA + hstepA, voffA);
        if (wr == 1) PG8_BAR;
        PG8_WAIT_V(4); PG8_BAR;
        PG8_STAGE(PG8_SB(1, 0), cB + kstepB, voffB); PG8_STAGE(PG8_SA(1, 0), a_tile(uA, tbA + 1), voffA); PG8_STAGE(PG8_SB(1, 1), cB + hstepB + kstepB, voffB);
        PG8_WAIT_V(6); PG8_BAR;
    }
    for (;;) {
        const bool has_next = S.next(ui + 1, nxt);
        const int nt = cur.nt;
        const char* nuA = has_next ? a_unit(nxt) : uA; const int ntbA = has_next ? nxt.k0 / BK : tbA; const char* nB = has_next ? (const char*)g.Bt + (size_t)nxt.pn * tstepB + b_k0(nxt.k0) : cB;
        for (int t = 0; t < nt; t += 2) {
            const bool last = (t == nt - 2);
            const char* a1 = a_tile(uA, tbA + t + 1);
            const char* a2 = last ? a_tile(nuA, ntbA) : a_tile(uA, tbA + t + 2); const char* b2 = last ? nB : cB + (size_t)(t + 2) * kstepB;
            const char* a3 = last ? a_tile(nuA, ntbA + 1) : a_tile(uA, tbA + t + 3); const char* b3 = b2 + kstepB;
            if (last && has_next) S.a_ready(nxt);
            if constexpr (SP2) {
            PG8_LDB(B0, 0, 0); PG8_LDB(B1, 0, 1); PG8_SCHED; PG8_LDA(At, 0, 0); PG8_STAGE(PG8_SA(1, 1), a1 + hstepA, voffA);
            PG8_WAIT_V(8); PG8_WAIT_L(0); PG8_BAR; PG8_MMA(0, 0, At, B0); PG8_MMA(0, 1, At, B1); PG8_BAR; PG8_SCHED;
            PG8_LDA(At, 0, 1); PG8_STAGE(PG8_SB(0, 0), b2, voffB); PG8_STAGE(PG8_SB(0, 1), b2 + hstepB, voffB); PG8_STAGE(PG8_SA(0, 0), a2, voffA);
            PG8_WAIT_V(8); PG8_WAIT_L(0); PG8_BAR; PG8_MMA(1, 0, At, B0); PG8_MMA(1, 1, At, B1); PG8_BAR; PG8_SCHED;
            PG8_LDB(B0, 1, 0); PG8_LDB(B1, 1, 1); PG8_SCHED; PG8_LDA(At, 1, 0); PG8_STAGE(PG8_SA(0, 1), a2 + hstepA, voffA);
            PG8_WAIT_V(8); PG8_WAIT_L(0); PG8_BAR; PG8_MMA(0, 0, At, B0); PG8_MMA(0, 1, At, B1); PG8_BAR; PG8_SCHED;
            PG8_LDA(At, 1, 1); PG8_STAGE(PG8_SB(1, 0), b3, voffB); PG8_STAGE(PG8_SB(1, 1), b3 + hstepB, voffB); PG8_STAGE(PG8_SA(1, 0), a3, voffA);
            PG8_WAIT_V(8); PG8_WAIT_L(0); PG8_BAR; PG8_MMA(1, 0, At, B0); PG8_MMA(1, 1, At, B1); PG8_BAR; PG8_SCHED;
            } else {
            PG8_LDB(B0, 0, 0); PG8_SCHED; PG8_LDA(At, 0, 0); PG8_STAGE(PG8_SA(1, 1), a1 + hstepA, voffA);
            PG8_WAIT_L(8); PG8_BAR; PG8_WAIT_L(0); PG8_MMA(0, 0, At, B0); PG8_BAR; PG8_SCHED;
            PG8_LDB(B1, 0, 1); PG8_STAGE(PG8_SB(0, 0), b2, voffB);
            PG8_BAR; PG8_WAIT_L(0); PG8_MMA(0, 1, At, B1); PG8_BAR;
            PG8_LDA(At, 0, 1); PG8_STAGE(PG8_SA(0, 0), a2, voffA);
            PG8_BAR; PG8_WAIT_L(0); PG8_MMA(1, 0, At, B0); PG8_BAR; PG8_SCHED;
            PG8_STAGE(PG8_SB(0, 1), b2 + hstepB, voffB);
            PG8_WAIT_V(6); PG8_BAR; PG8_MMA(1, 1, At, B1); PG8_BAR;
            PG8_LDB(B0, 1, 0); PG8_SCHED; PG8_LDA(At, 1, 0); PG8_STAGE(PG8_SA(0, 1), a2 + hstepA, voffA);
            PG8_WAIT_L(8); PG8_BAR; PG8_WAIT_L(0); PG8_MMA(0, 0, At, B0); PG8_BAR; PG8_SCHED;
            PG8_LDB(B1, 1, 1); PG8_STAGE(PG8_SB(1, 0), b3, voffB);
            PG8_BAR; PG8_WAIT_L(0); PG8_MMA(0, 1, At, B1); PG8_BAR;
            PG8_LDA(At, 1, 1); PG8_STAGE(PG8_SA(1, 0), a3, voffA);
            PG8_BAR; PG8_WAIT_L(0); PG8_MMA(1, 0, At, B0); PG8_BAR; PG8_SCHED;
            PG8_STAGE(PG8_SB(1, 1), b3 + hstepB, voffB);
            PG8_WAIT_V(6); PG8_BAR; PG8_MMA(1, 1, At, B1); PG8_BAR;
            }
        }
        if constexpr (ALIGN_EPI) { if (wr == 0) PG8_BAR; }
        E(acc, cur, wr, wc, fr, fq); S.done(cur);
        if (!has_next) break;
#pragma unroll
        for (int a = 0; a < 2; ++a)
#pragma unroll
            for (int b = 0; b < 2; ++b)
#pragma unroll
                for (int m = 0; m < 4; ++m)
#pragma unroll
                    for (int n = 0; n < 2; ++n) acc[a][b][m][n] = (f32x4){0.f, 0.f, 0.f, 0.f};
        cur = nxt; uA = nuA; tbA = ntbA; cB = nB; ++ui;
        if constexpr (ALIGN_EPI) { if (wr == 1) PG8_BAR; }
    }
    PG8_WAIT_V(0);
    if constexpr (!ALIGN_EPI) { if (wr == 0) PG8_BAR; }
    PG8_BAR;
#undef PG8_SA
#undef PG8_SB
#undef PG8_STAGE
#undef PG8_LDA
#undef PG8_LDB
#undef PG8_MMA
#undef PG8_WAIT_V
#undef PG8_WAIT_L
#undef PG8_BAR
#undef PG8_SCHED
}
}

using pg8::Unit;
struct ResSrc { const float* xp; const float* xs; const bf16_t* xb;
    __device__ __forceinline__ f32x4 ld4(int r, int col) const {
        if (xb) { const u32x2 w = *(const u32x2*)(xb + (size_t)r * D + col);
            return (f32x4){__builtin_bit_cast(float, w.x << 16), __builtin_bit_cast(float, w.x & 0xffff0000u), __builtin_bit_cast(float, w.y << 16), __builtin_bit_cast(float, w.y & 0xffff0000u)}; }
        return *(const f32x4*)((r < MP ? xp + (size_t)r * D : xs + (size_t)(r - MP) * D) + col); } };

__device__ __forceinline__ u32x4 ror8(u32x4 v) { u32x4 r;
#pragma unroll
    for (int i = 0; i < 4; ++i) r[i] = (unsigned)__builtin_amdgcn_mov_dpp((int)v[i], 0x128, 0xf, 0xf, true);
    return r; }
__device__ __forceinline__ void store_pair(unsigned char* own, size_t stride8, int hi_off, u32x4 lo, u32x4 hi, bool upper) {
    const u32x4 tlo = ror8(lo), thi = ror8(hi);
    const u32x4 A = upper ? thi : lo, B = upper ? hi : tlo;
    unsigned char* pa = upper ? own - stride8 + hi_off : own;
    unsigned char* pb = upper ? own + hi_off : own + stride8;
    *(u32x4*)pa = A; *(u32x4*)pb = B;
}
__device__ __forceinline__ void store_pair_f(float* own, size_t stride8_elems, f32x4 lo, f32x4 hi, bool upper) {
    store_pair((unsigned char*)own, stride8_elems * 4, 64, __builtin_bit_cast(u32x4, lo), __builtin_bit_cast(u32x4, hi), upper);
}
struct EpiSsmGate {
    static constexpr bool PERM = true, ADJ = false;
    bf16_t* Z;
    __device__ __forceinline__ void operator()(const f32x4 (&acc)[2][2][4][2], const Unit& u, int wr, int wc, int fr, int fq) const {
        const int row0 = u.pm * 256 + wr * 64 + fr, ch0 = u.pn * 128 + wc * 32 + 8 * fq;
#pragma unroll
        for (int ai = 0; ai < 2; ++ai)
#pragma unroll
            for (int m = 0; m < 4; ++m) { f32x4 z[2];
#pragma unroll
                for (int n = 0; n < 2; ++n) { const f32x4 o = acc[ai][0][m][n], gt = acc[ai][1][m][n];
#pragma unroll
                    for (int j = 0; j < 4; ++j) z[n][j] = o[j] * sigmoidf_(gt[j]); }
                u32x4 w; w.x = pk2(z[0][0], z[0][1]); w.y = pk2(z[0][2], z[0][3]); w.z = pk2(z[1][0], z[1][1]); w.w = pk2(z[1][2], z[1][3]);
                *(u32x4*)(Z + (size_t)(row0 + ai * 128 + m * 16) * D + ch0) = w; }
    }
};
struct EpiRes {
    static constexpr bool PERM = true, ADJ = true;
    bf16_t* Z; bf16_t* P;
    __device__ __forceinline__ void operator()(const f32x4 (&acc)[2][2][4][2], const Unit& u, int wr, int wc, int fr, int fq) const {
        const int row0 = u.pm * 256 + wr * 64 + fr, col0 = u.pn * 256 + wc * 64 + 8 * fq;
        bf16_t* base = u.part == 0 ? Z + (size_t)row0 * D + col0 : P + ((size_t)(u.part - 1) * MS + (row0 - MP)) * D + col0;
#pragma unroll
        for (int ai = 0; ai < 2; ++ai)
#pragma unroll
            for (int m = 0; m < 4; ++m) { u32x4 w[2];
#pragma unroll
                for (int bj = 0; bj < 2; ++bj) { const f32x4 v0 = acc[ai][bj][m][0], v1 = acc[ai][bj][m][1]; w[bj].x = pk2(v0[0], v0[1]); w[bj].y = pk2(v0[2], v0[3]); w[bj].z = pk2(v1[0], v1[1]); w[bj].w = pk2(v1[2], v1[3]); }
                store_pair((unsigned char*)(base + (size_t)(ai * 128 + m * 16) * D), (size_t)8 * D * 2, 64, w[0], w[1], fr >= 8); }
    }
};
struct EpiFfn1 {
    static constexpr bool PERM = true, ADJ = true;
    bf16_t* H;
    __device__ __forceinline__ void operator()(const f32x4 (&acc)[2][2][4][2], const Unit& u, int wr, int wc, int fr, int fq) const {
#pragma unroll
        for (int ai = 0; ai < 2; ++ai)
#pragma unroll
            for (int m = 0; m < 4; ++m) { unsigned char* rowp = (unsigned char*)(H + ((size_t)(u.pm * (FF / 64) + u.pn * 4 + wc) * 256 + (wr * 64 + fr + ai * 128 + m * 16)) * 64 + 8 * fq); u32x4 w[2];
#pragma unroll
                for (int bj = 0; bj < 2; ++bj) { f32x4 v0 = acc[ai][bj][m][0], v1 = acc[ai][bj][m][1];
#pragma unroll
                    for (int j = 0; j < 4; ++j) { const float a = fmaxf(v0[j], 0.f), b = fmaxf(v1[j], 0.f); v0[j] = a * a; v1[j] = b * b; }
                    w[bj].x = pk2(v0[0], v0[1]); w[bj].y = pk2(v0[2], v0[3]); w[bj].z = pk2(v1[0], v1[1]); w[bj].w = pk2(v1[2], v1[3]); }
                store_pair(rowp, (size_t)8 * 64 * 2, 64, w[0], w[1], fr >= 8); }
    }
};
struct EpiQkv {
    static constexpr bool PERM = true, ADJ = true;
    bf16_t* QKV; float* out;
    __device__ __forceinline__ void operator()(const f32x4 (&acc)[2][2][4][2], const Unit& u, int wr, int wc, int fr, int fq) const {
        const int t = u.pn >> 3; const int colt = (u.pn & 7) * 256;
        const int col0 = colt + wc * 64 + 8 * fq;
        bf16_t* base = QKV + (size_t)t * M * D;
        float* fdst = nullptr;
        if (t >= 1) {
            if (u.pm < 32) { if ((u.pm & 7) >= 6) { const int n = u.pm >> 3; fdst = out + (t == 1 ? O_KP : O_VP) + ((size_t)n * 512 + (size_t)((u.pm & 7) - 6) * 256) * D; } }
            else fdst = out + (t == 1 ? O_KS : O_VS) + (size_t)(u.pm - 32) * 256 * D;
        }
#pragma unroll
        for (int ai = 0; ai < 2; ++ai)
#pragma unroll
            for (int m = 0; m < 4; ++m) { const int rl = wr * 64 + fr + ai * 128 + m * 16; u32x4 w[2];
#pragma unroll
                for (int bj = 0; bj < 2; ++bj) { const f32x4 v0 = acc[ai][bj][m][0], v1 = acc[ai][bj][m][1];
                    w[bj].x = pk2(v0[0], v0[1]); w[bj].y = pk2(v0[2], v0[3]); w[bj].z = pk2(v1[0], v1[1]); w[bj].w = pk2(v1[2], v1[3]);
                    if (fdst) { float* fp = fdst + (size_t)rl * D + col0 + bj * 32; *(f32x4*)fp = v0; *(f32x4*)(fp + 4) = v1; } }
                store_pair((unsigned char*)(base + (size_t)(u.pm * 256 + rl) * D + col0), (size_t)8 * D * 2, 64, w[0], w[1], fr >= 8); }
    }
};
struct EpiHgrnIn {
    static constexpr bool PERM = true, ADJ = true;
    bf16_t* QIG; unsigned short* F; const float* lb;
    __device__ __forceinline__ void operator()(const f32x4 (&acc)[2][2][4][2], const Unit& u, int wr, int wc, int fr, int fq) const {
        const int t = u.pn >> 3; const int colt = (u.pn & 7) * 256;
        const int row0 = u.pm * 256 + wr * 64 + fr, col0 = colt + wc * 64 + 8 * fq;
        if (t == 1) {
            f32x4 l[2][2];
#pragma unroll
            for (int bj = 0; bj < 2; ++bj) { l[bj][0] = 1.0f - *(const f32x4*)(lb + col0 + bj * 32); l[bj][1] = 1.0f - *(const f32x4*)(lb + col0 + bj * 32 + 4); }
#pragma unroll
            for (int ai = 0; ai < 2; ++ai)
#pragma unroll
                for (int m = 0; m < 4; ++m) { u32x4 w[2];
#pragma unroll
                    for (int bj = 0; bj < 2; ++bj) { f32x4 v0 = acc[ai][bj][m][0], v1 = acc[ai][bj][m][1];
#pragma unroll
                        for (int j = 0; j < 4; ++j) { v0[j] = l[bj][0][j] * sigmoidf_(-v0[j]); v1[j] = l[bj][1][j] * sigmoidf_(-v1[j]); }
                        w[bj].x = pkh2(v0[0], v0[1]); w[bj].y = pkh2(v0[2], v0[3]); w[bj].z = pkh2(v1[0], v1[1]); w[bj].w = pkh2(v1[2], v1[3]); }
                    store_pair((unsigned char*)(F + (size_t)(row0 + ai * 128 + m * 16) * D + col0), (size_t)8 * D * 2, 64, w[0], w[1], fr >= 8); }
        } else {
            bf16_t* base = QIG + (size_t)(t == 0 ? 0 : t - 1) * M * D;
#pragma unroll
            for (int ai = 0; ai < 2; ++ai)
#pragma unroll
                for (int m = 0; m < 4; ++m) { u32x4 w[2];
#pragma unroll
                    for (int bj = 0; bj < 2; ++bj) { const f32x4 v0 = acc[ai][bj][m][0], v1 = acc[ai][bj][m][1]; w[bj].x = pk2(v0[0], v0[1]); w[bj].y = pk2(v0[2], v0[3]); w[bj].z = pk2(v1[0], v1[1]); w[bj].w = pk2(v1[2], v1[3]); }
                    store_pair((unsigned char*)(base + (size_t)(row0 + ai * 128 + m * 16) * D + col0), (size_t)8 * D * 2, 64, w[0], w[1], fr >= 8); }
        }
    }
};

struct Args { const float* in[30]; float* out; unsigned char* ws; };


__device__ __forceinline__ float wave_sum(float v) {
#pragma unroll
    for (int o = 1; o < 64; o <<= 1) v += __shfl_xor(v, o);
    return v;
}

#define XB_TMO      128
#define XB_XCNT(j)  (256  + 64 * (j))
#define XB_XSUB(j)  (1280 + 64 * (j))
#define XB_XGEN(j)  (2304 + 64 * (j))
#define XB_TOP      3328
#define XB_TOPGEN   3392
#define XCD_BAR_WORDS 3456
#define XB_SPIN_CAP (1u << 18)
__device__ __forceinline__ unsigned xb_ld(unsigned* p)              { return __hip_atomic_load(p, __ATOMIC_RELAXED, __HIP_MEMORY_SCOPE_AGENT); }
__device__ __forceinline__ unsigned xb_add(unsigned* p, unsigned v) { return __hip_atomic_fetch_add(p, v, __ATOMIC_RELAXED, __HIP_MEMORY_SCOPE_AGENT); }
__device__ __forceinline__ unsigned xb_xcc_id() { return (unsigned)__builtin_amdgcn_s_getreg((3 << 11) | 20) & 0xFu; }
#define XB_SPIN(cond, bar) do { unsigned _sp = 0; while (cond) { __builtin_amdgcn_s_sleep(1); \
    if ((++_sp & 255u) == 0u) { if (xb_ld(&(bar)[XB_TMO])) break; if (_sp > XB_SPIN_CAP) { atomicAdd(&(bar)[XB_TMO], 1u); break; } } } } while (0)
struct XcdBarrier { unsigned* bar; unsigned x; volatile LAS unsigned* st; };
__device__ __forceinline__ XcdBarrier xcd_barrier_post(unsigned* bar, volatile LAS unsigned* st) {
    XcdBarrier b; b.bar = bar; b.x = xb_xcc_id(); b.st = st;
    if (threadIdx.x == 0) (void)xb_add(&bar[XB_XCNT(b.x)], 1u);
    return b;
}
__device__ __forceinline__ void xcd_barrier_complete(unsigned* bar, unsigned x, unsigned& nloc, unsigned& nx) {
    const unsigned G = gridDim.x * gridDim.y * gridDim.z;
    unsigned sum, cnt, mine, sp = 0u;
    for (;;) {
        sum = 0u; cnt = 0u; mine = 0u;
#pragma unroll
        for (unsigned j = 0; j < 16; ++j) { const unsigned c = xb_ld(&bar[XB_XCNT(j)]); sum += c; cnt += (c > 0u) ? 1u : 0u; mine = (j == x) ? c : mine; }
        if (sum == G) break;
        __builtin_amdgcn_s_sleep(1);
        if ((++sp & 255u) == 0u) { if (xb_ld(&bar[XB_TMO])) break; if (sp > XB_SPIN_CAP) { atomicAdd(&bar[XB_TMO], 1u); break; } }
    }
    nloc = mine > 0u ? mine : 1u; nx = cnt > 0u ? cnt : 1u;
}
__device__ __forceinline__ void xcd_barrier(const XcdBarrier& b) {
    asm volatile("s_waitcnt vmcnt(0)" ::: "memory");
    __syncthreads();
    if (threadIdx.x == 0) {
        unsigned* bar = b.bar;
        __builtin_amdgcn_s_waitcnt(0);
        unsigned nloc = b.st[0], nx = b.st[1];
        if (nloc == 0u) { xcd_barrier_complete(bar, b.x, nloc, nx); b.st[0] = nloc; b.st[1] = nx; }
        const unsigned old = xb_add(&bar[XB_XSUB(b.x)], 1u);
        const unsigned gen = old / nloc;
        if (old + 1u == (gen + 1u) * nloc) {
            __builtin_amdgcn_fence(__ATOMIC_RELEASE, "agent");
            asm volatile("s_waitcnt vmcnt(0)" ::: "memory");
            const unsigned og = xb_add(&bar[XB_TOP], 1u);
            const unsigned tg = og / nx;
            if (og + 1u == (tg + 1u) * nx) xb_add(&bar[XB_TOPGEN], 1u);
            else XB_SPIN(xb_ld(&bar[XB_TOPGEN]) == tg, bar);
            __builtin_amdgcn_fence(__ATOMIC_ACQUIRE, "agent");
            xb_add(&bar[XB_XGEN(b.x)], 1u);
            asm volatile("s_waitcnt vmcnt(0)" ::: "memory");
        } else {
            XB_SPIN(xb_ld(&bar[XB_XGEN(b.x)]) == gen, bar);
            __builtin_amdgcn_fence(__ATOMIC_ACQUIRE, "agent");
            asm volatile("s_waitcnt vmcnt(0)" ::: "memory");
        }
    }
    __syncthreads();
}

struct ConvItem { const float* src; bf16_t* dst; int N, K, w0, adj; };
__host__ __device__ __forceinline__ int invperm32(int v) { return 16 * ((v >> 2) & 1) + 4 * (v >> 3) + (v & 3); }
__device__ __forceinline__ int conv_rowoff(int w, int adj) {
    const int h = adj ? (w >> 5) & 1 : w >> 7, R = adj ? 32 * (w >> 6) + invperm32(w & 31) : 32 * ((w & 127) >> 5) + invperm32(w & 31);
    return (h * 128 + R) * 64;
}
constexpr int CONV_ITEMS = (4 * 2048 + 6144 + 2048 + 8192 + 2048 + 8 * 8192) / 2;
constexpr int CONV_LDS = 64 * 65 * 4;
__device__ __forceinline__ ConvItem conv_decode(const Args& a, int it) {
    unsigned char* ws = a.ws; const float* W; bf16_t* WT; int K, N, mode = 0;
    if (it < 4 * 1024) { const int m = it >> 10; it &= 1023; const int jj = m >> 1; mode = 1 + (m & 1); W = a.in[15 + (m & 1)] + (size_t)jj * D * D; WT = (bf16_t*)(ws + WS_WSSM) + (size_t)jj * 4096 * D; K = D; N = D; }
    else if ((it -= 4 * 1024) < 3072) { W = a.in[17]; WT = (bf16_t*)(ws + WS_WQKV); K = D; N = 3 * D; }
    else if ((it -= 3072) < 1024) { W = a.in[19]; WT = (bf16_t*)(ws + WS_WAO); K = D; N = D; }
    else if ((it -= 1024) < 4096) { W = a.in[20]; WT = (bf16_t*)(ws + WS_WHIN); K = D; N = 4 * D; }
    else if ((it -= 4096) < 1024) { W = a.in[23]; WT = (bf16_t*)(ws + WS_WHO); K = D; N = D; }
    else if ((it -= 1024) < 4 * 4096) { const int l = it >> 12; it &= 4095; W = a.in[28] + (size_t)l * D * FF; WT = (bf16_t*)(ws + WS_WF1) + (size_t)l * FF * D; K = D; N = FF; }
    else { it -= 4 * 4096; const int l = it >> 12; it &= 4095; W = a.in[29] + (size_t)l * FF * D; WT = (bf16_t*)(ws + WS_WF2) + (size_t)l * D * FF; K = FF; N = D; }
    const int nb = N / 64, kb = it / nb, n0 = 64 * (it - kb * nb), k0 = 64 * kb;
    const int row0 = mode == 0 ? n0 : 256 * (n0 >> 7) + 128 * (mode - 1) + (n0 & 127);
    ConvItem c; c.src = W + (size_t)k0 * N + n0; c.dst = WT + ((size_t)(row0 >> 8) * (K / 64) + kb) * 16384; c.N = N; c.K = K; c.w0 = row0 & 255; c.adj = mode == 0; return c;
}
__device__ __forceinline__ void conv_load(const ConvItem& c, f32x4 (&wv)[16], int lane) {
#pragma unroll
    for (int i = 0; i < 16; ++i) wv[i] = __builtin_nontemporal_load((const f32x4*)(c.src + (size_t)(4 * i + (lane >> 4)) * c.N + 4 * (lane & 15)));
}
__device__ __forceinline__ void conv_store(const ConvItem& c, const f32x4 (&wv)[16], LAS float* scr, int lane) {
#pragma unroll
    for (int i = 0; i < 16; ++i) { LAS float* d = scr + (4 * i + (lane >> 4)) * 65 + 4 * (lane & 15); d[0] = wv[i][0]; d[1] = wv[i][1]; d[2] = wv[i][2]; d[3] = wv[i][3]; }
    asm volatile("s_waitcnt lgkmcnt(0)" ::: "memory");
    const int cc = lane & 7;
#pragma unroll
    for (int j = 0; j < 8; ++j) { const int n = (lane >> 3) + 8 * j; const LAS float* sp = scr + (8 * cc) * 65 + n;
        u32x4 o; o.x = pk2(sp[0 * 65], sp[1 * 65]); o.y = pk2(sp[2 * 65], sp[3 * 65]); o.z = pk2(sp[4 * 65], sp[5 * 65]); o.w = pk2(sp[6 * 65], sp[7 * 65]);
        *(u32x4*)(c.dst + conv_rowoff(c.w0 + n, c.adj) + 8 * cc) = o; }
    asm volatile("s_waitcnt lgkmcnt(0)" ::: "memory");
}
__device__ __forceinline__ void conv_worker(const Args& a, LAS float* scr, int w, int nw, int lane) {
    f32x4 va[16], vb[16];
    int it = w; if (it >= CONV_ITEMS) return;
    ConvItem ca = conv_decode(a, it), cb = ca; conv_load(ca, va, lane);
    for (;;) {
        const bool hb = it + nw < CONV_ITEMS; if (hb) { cb = conv_decode(a, it + nw); conv_load(cb, vb, lane); }
        conv_store(ca, va, scr, lane); if (!hb) break; it += nw;
        const bool ha = it + nw < CONV_ITEMS; if (ha) { ca = conv_decode(a, it + nw); conv_load(ca, va, lane); }
        conv_store(cb, vb, scr, lane); if (!ha) break; it += nw;
    }
}
__device__ __forceinline__ void params1_item(const Args& a, int idx) {
    unsigned char* par = a.ws + WS_PAR;
    if (idx < 2 * NG * NP) {
        const int j = idx / (NG * NP), g = (idx / NP) % NG;
        const double are = a.in[7][idx], aim = a.in[8][idx], dt = exp((double)a.in[9][j * NG + g]);
        const double e = exp(are * dt), cr = e * cos(aim * dt), ci = e * sin(aim * dt);
        float* ab = (float*)(par + PAR_ABAR) + (size_t)idx * 2; ab[0] = (float)cr; ab[1] = (float)ci;
    }
    if (idx < D) {
        const float* lg = a.in[21]; float v0 = lg[idx], v1 = lg[D + idx], v2 = lg[2 * D + idx], v3 = lg[3 * D + idx];
        const float mx = fmaxf(fmaxf(v0, v1), fmaxf(v2, v3));
        v0 = expf(v0 - mx); v1 = expf(v1 - mx); v2 = expf(v2 - mx); v3 = expf(v3 - mx);
        ((float*)(par + PAR_LB))[idx] = (v1 + v2) / (v0 + v1 + v2 + v3);
    }
}
__device__ __forceinline__ void params2_item(const Args& a, int idx);
__device__ __forceinline__ void ph_params(const Args& a, int nblk, int b) {
    const int tid = tid_fresh(); const int nth = nblk * 512;
    for (int idx = b * 512 + tid; idx < 2 * NG * 8 * 64 + 2 * NG * 4 * 64; idx += nth) params2_item(a, idx);
    for (int idx = b * 512 + tid; idx < 2 * NG * NP; idx += nth) params1_item(a, idx);
}

template <int C> __device__ __forceinline__ float dppf(float v) { return __builtin_bit_cast(float, __builtin_amdgcn_mov_dpp(__builtin_bit_cast(int, v), C, 0xf, 0xf, true)); }
__device__ __forceinline__ float wave_sum_dpp(float v) {
    v += dppf<0x121>(v); v += dppf<0x122>(v); v += dppf<0x124>(v); v += dppf<0x128>(v);
    const int iv = __builtin_bit_cast(int, v);
    return (__builtin_bit_cast(float, __builtin_amdgcn_readlane(iv, 0)) + __builtin_bit_cast(float, __builtin_amdgcn_readlane(iv, 16))) + (__builtin_bit_cast(float, __builtin_amdgcn_readlane(iv, 32)) + __builtin_bit_cast(float, __builtin_amdgcn_readlane(iv, 48)));
}
__device__ __forceinline__ void ph_ln(const Args& a, int L, int which, bool final_, bool split, bool wr_x, bool res_inputs, int nblk, int b) {
    unsigned char* ws = a.ws; const bf16_t* P = (const bf16_t*)(ws + WS_SCR + SCR_PART);
    const bf16_t* Z = (const bf16_t*)(ws + WS_Z); float* Xo = final_ ? a.out : (float*)(ws + WS_X); bf16_t* XB = (bf16_t*)(ws + WS_XB);
    auto lo = [](unsigned w) -> float { return __builtin_bit_cast(float, w << 16); }; auto hi = [](unsigned w) -> float { return __builtin_bit_cast(float, w & 0xffff0000u); };
    const float* gam = a.in[which ? 26 : 24] + (size_t)L * D; const float* bet = a.in[which ? 27 : 25] + (size_t)L * D;
    const int tid = tid_fresh(); const int lane = tid & 63, gw = b * 8 + (tid >> 6), ngw = nblk * 8;
    f32x4 gg[4][2], bb[4][2];
#pragma unroll
    for (int j = 0; j < 4; ++j)
#pragma unroll
        for (int h = 0; h < 2; ++h) { gg[j][h] = *(const f32x4*)(gam + 512 * j + 8 * lane + 4 * h); bb[j][h] = *(const f32x4*)(bet + 512 * j + 8 * lane + 4 * h); }
    u32x4 zc[4], xc[4];
    auto ldrow = [&](int r) { const u32x4* zr = (const u32x4*)(Z + (size_t)r * D) + lane;
#pragma unroll
        for (int j = 0; j < 4; ++j) zc[j] = zr[64 * j];
        if (!res_inputs) { const u32x4* xr = (const u32x4*)(XB + (size_t)r * D) + lane;
#pragma unroll
            for (int j = 0; j < 4; ++j) xc[j] = xr[64 * j]; } };
    if (gw < M) ldrow(gw);
    for (int r = gw; r < M; r += ngw) {
        float v[4][8];
#pragma unroll
        for (int j = 0; j < 4; ++j)
#pragma unroll
            for (int e = 0; e < 4; ++e) { v[j][2 * e] = lo(zc[j][e]); v[j][2 * e + 1] = hi(zc[j][e]); }
        if (!res_inputs) {
#pragma unroll
            for (int j = 0; j < 4; ++j)
#pragma unroll
                for (int e = 0; e < 4; ++e) { v[j][2 * e] += ALPHA * lo(xc[j][e]); v[j][2 * e + 1] += ALPHA * hi(xc[j][e]); } }
        if (r + ngw < M) ldrow(r + ngw);
        if (split && r >= MP) {
#pragma unroll
            for (int p = 0; p < 3; ++p) { const u32x4* pr = (const u32x4*)(P + ((size_t)p * MS + (r - MP)) * D) + lane;
#pragma unroll
                for (int j = 0; j < 4; ++j) { const u32x4 w = pr[64 * j];
#pragma unroll
                    for (int e = 0; e < 4; ++e) { v[j][2 * e] += lo(w[e]); v[j][2 * e + 1] += hi(w[e]); } } } }
        if (res_inputs) { const f32x4* xr = (const f32x4*)(r < MP ? a.in[0] + (size_t)r * D : a.in[1] + (size_t)(r - MP) * D) + 2 * lane;
#pragma unroll
            for (int j = 0; j < 4; ++j)
#pragma unroll
                for (int h = 0; h < 2; ++h) { const f32x4 x = xr[128 * j + h];
#pragma unroll
                    for (int e = 0; e < 4; ++e) v[j][4 * h + e] += ALPHA * x[e]; } }
        float s = 0.f;
#pragma unroll
        for (int j = 0; j < 4; ++j) s += ((v[j][0] + v[j][1]) + (v[j][2] + v[j][3])) + ((v[j][4] + v[j][5]) + (v[j][6] + v[j][7]));
        const float mean = wave_sum_dpp(s) * (1.f / D); float s2 = 0.f;
#pragma unroll
        for (int j = 0; j < 4; ++j)
#pragma unroll
            for (int e = 0; e < 8; ++e) { v[j][e] -= mean; s2 += v[j][e] * v[j][e]; }
        const float rstd = 1.f / sqrtf(wave_sum_dpp(s2) * (1.f / D) + LN_EPS);
        f32x4* xo = (f32x4*)(Xo + (size_t)r * D) + 2 * lane; u32x4* xb = (u32x4*)(XB + (size_t)r * D) + lane;
#pragma unroll
        for (int j = 0; j < 4; ++j) { f32x4 y[2];
#pragma unroll
            for (int h = 0; h < 2; ++h)
#pragma unroll
                for (int e = 0; e < 4; ++e) y[h][e] = v[j][4 * h + e] * rstd * gg[j][h][e] + bb[j][h][e];
            if (final_ || wr_x) { xo[128 * j] = y[0]; xo[128 * j + 1] = y[1]; }
            if (!final_) { u32x4 w; w.x = pk2(y[0][0], y[0][1]); w.y = pk2(y[0][2], y[0][3]); w.z = pk2(y[1][0], y[1][1]); w.w = pk2(y[1][2], y[1][3]); xb[64 * j] = w; } }
    }
}
__device__ __forceinline__ void params2_item(const Args& a, int idx) {
    unsigned char* par = a.ws + WS_PAR;
    if (idx < 2 * NG * 8 * 64) {
        const int lane = idx & 63, n8 = (idx >> 6) & 7, jg = idx >> 9; const int j = jg / NG, g = jg % NG; const int G4 = lane >> 4, c = lane & 15;
        const int pp = 16 * n8 + c, p = pp & 63, im = pp >> 6; const int sidx = (j * NG + g) * NP + p;
        const double are = a.in[7][sidx], aim = a.in[8][sidx], dt = exp((double)a.in[9][j * NG + g]);
        const double e = exp(are * dt), cr = e * cos(aim * dt), ci = e * sin(aim * dt);
        const double xr = cr - 1.0, xi = ci, den = are * are + aim * aim; const double fr = (xr * are + xi * aim) / den, fi = (xi * are - xr * aim) / den;
        unsigned w[4];
#pragma unroll
        for (int e2 = 0; e2 < 4; ++e2) { float v[2];
#pragma unroll
            for (int h = 0; h < 2; ++h) { const int q = (8 * G4 + 2 * e2 + h) & 15; const double br = a.in[10][(size_t)sidx * NQ + q], bi = a.in[11][(size_t)sidx * NQ + q];
                v[h] = (float)(im ? (fr * bi + fi * br) : (fr * br - fi * bi)); }
            w[e2] = pk2(v[0], v[1]); }
        ((u32x4*)(par + PAR_BFRAG))[idx] = (u32x4){w[0], w[1], w[2], w[3]};
    } else if (idx < 2 * NG * 8 * 64 + 2 * NG * 4 * 64) {
        const int id2 = idx - 2 * NG * 8 * 64; const int lane = id2 & 63, kk = (id2 >> 6) & 3, jg = id2 >> 8; const int G4 = lane >> 4, c = lane & 15;
        unsigned w[4];
#pragma unroll
        for (int e2 = 0; e2 < 4; ++e2) { float v[2];
#pragma unroll
            for (int h = 0; h < 2; ++h) { const int pp = 32 * kk + 8 * G4 + 2 * e2 + h; const size_t ci = ((size_t)jg * NQ + c) * NP + (pp & 63);
                v[h] = pp < 64 ? a.in[12][ci] : -a.in[13][ci]; }
            w[e2] = pk2(v[0], v[1]); }
        ((u32x4*)(par + PAR_CFRAG))[id2] = (u32x4){w[0], w[1], w[2], w[3]};
    }
}

__device__ __forceinline__ f32x4 mfma_t(bf16x8 a, bf16x8 b, f32x4 c) {
    asm volatile("s_nop 4" : "+v"(c) : "v"(a), "v"(b));
    f32x4 d = __builtin_amdgcn_mfma_f32_16x16x32_bf16(a, b, c, 0, 0, 0);
    asm volatile("s_nop 7" : "+v"(d) : "v"(a), "v"(b));
    return d;
}
__device__ __forceinline__ f32x4 mfma_u(bf16x8 a, bf16x8 b, f32x4 c) {
    f32x4 d = __builtin_amdgcn_mfma_f32_16x16x32_bf16(a, b, c, 0, 0, 0);
    asm volatile("" : "+v"(d) : "v"(a), "v"(b));
    return d;
}
__device__ __forceinline__ f32x4 mfma_a(bf16x8 a, bf16x8 b, f32x4 c) { f32x4 d = __builtin_amdgcn_mfma_f32_16x16x32_bf16(a, b, c, 0, 0, 0); asm("" : "+v"(d) : "v"(a), "v"(b)); return d; }
#define OPAQUE(x) asm volatile("" : "+v"(x))
#define MFMA_PRE1(x) asm volatile("s_nop 4" : "+v"(x))
#define MFMA_POST4(a, b, c, d) asm volatile("s_nop 7\n\ts_nop 7" : "+v"(a), "+v"(b), "+v"(c), "+v"(d))
#define MFMA_POST8(a, b, c, d, e, f, g, h) asm volatile("s_nop 7\n\ts_nop 7" : "+v"(a), "+v"(b), "+v"(c), "+v"(d), "+v"(e), "+v"(f), "+v"(g), "+v"(h))
#define MFMA_POST1(a) asm volatile("s_nop 7\n\ts_nop 7" : "+v"(a))
constexpr int SSM_BUS = 132;
constexpr int SSM_WLDS = 16 * SSM_BUS * 4 + 64 * 16 * 4;
template <bool FULL>
__device__ __forceinline__ void ssm_core(const Args& a, LAS unsigned char* wl, int j, int L, bool samp, int n, int g, int tb, int te, float& hr, float& hi, int lane) {
    unsigned char* ws = a.ws;
    const size_t rowbase = samp ? (size_t)MP + (size_t)n * DSEQ : (size_t)n * SEQ;
    const float* xbase = (L == 0) ? (samp ? a.in[1] + (size_t)n * DSEQ * D : a.in[0] + rowbase * D) : (const float*)(ws + WS_X) + rowbase * D;
    const int G4 = lane >> 4, c = lane & 15;
    const bf16x8* bfp = (const bf16x8*)(ws + WS_PAR + PAR_BFRAG) + (size_t)(j * NG + g) * 8 * 64 + lane;
    const bf16x8* cfp = (const bf16x8*)(ws + WS_PAR + PAR_CFRAG) + (size_t)(j * NG + g) * 4 * 64 + lane;
    bf16x8 Bf[8], Cf[4];
#pragma unroll
    for (int i = 0; i < 8; ++i) Bf[i] = bfp[i * 64];
    if (FULL) {
#pragma unroll
        for (int i = 0; i < 4; ++i) Cf[i] = cfp[i * 64]; }
    const float* ab = (const float*)(ws + WS_PAR + PAR_ABAR) + ((size_t)(j * NG + g) * NP + lane) * 2; const float ar = ab[0], ai = ab[1];
    const float dsk = a.in[14][(size_t)j * D + g * NQ + c];
    LAS float* BUs = (LAS float*)wl; LAS float* Us = (LAS float*)(wl + 16 * SSM_BUS * 4);
    bf16_t* Y = (bf16_t*)(ws + WS_Y);
    const float* up = xbase + (size_t)c * D + g * NQ + 8 * (G4 & 1);
    auto ldu = [&](int trow, f32x4& lo, f32x4& hi4) { const float* p = up + (size_t)trow * D; lo = *(const f32x4*)p; hi4 = *(const f32x4*)(p + 4); };
    f32x4 ub[4][2];
#pragma unroll
    for (int k = 0; k < 4; ++k) ldu(tb + 16 * k, ub[k][0], ub[k][1]);
    for (int t0 = tb; t0 < te; t0 += 64) {
#pragma unroll
        for (int k = 0; k < 4; ++k) { LAS f32x4* ud = (LAS f32x4*)(Us + (16 * k + c) * 16 + 8 * (G4 & 1)); ud[0] = ub[k][0]; ud[1] = ub[k][1]; }
        if (t0 + 64 < te) {
#pragma unroll
            for (int k = 0; k < 4; ++k) ldu(t0 + 64 + 16 * k, ub[k][0], ub[k][1]); }
        asm volatile("s_waitcnt lgkmcnt(0)" ::: "memory");
#pragma unroll 1
        for (int k = 0; k < 4; ++k) {
            bf16x8 afk;
            { const LAS f32x4* usrc = (const LAS f32x4*)(Us + (16 * k + c) * 16 + 8 * (G4 & 1)); const f32x4 x0 = usrc[0], x1 = usrc[1];
              u32x4 aw;
#pragma unroll
              for (int e2 = 0; e2 < 4; ++e2) { const float u0 = e2 < 2 ? x0[2 * e2] : x1[2 * e2 - 4], u1 = e2 < 2 ? x0[2 * e2 + 1] : x1[2 * e2 - 3];
                  const unsigned hp = pk2(u0, u1); const unsigned lp = pk2(u0 - __builtin_bit_cast(float, hp << 16), u1 - __builtin_bit_cast(float, hp & 0xffff0000u)); aw[e2] = G4 < 2 ? hp : lp; }
              afk = __builtin_bit_cast(bf16x8, aw); }
            f32x4 dd[8];
#pragma unroll
            for (int n8 = 0; n8 < 8; ++n8) dd[n8] = mfma_t(afk, Bf[n8], (f32x4){0.f, 0.f, 0.f, 0.f});
#pragma unroll
            for (int n8 = 0; n8 < 8; ++n8)
#pragma unroll
                for (int i = 0; i < 4; ++i) BUs[(4 * G4 + i) * SSM_BUS + 16 * n8 + c] = dd[n8][i];
            asm volatile("s_waitcnt lgkmcnt(0)" ::: "memory");
#pragma unroll
            for (int t = 0; t < 16; ++t) { const float br = BUs[t * SSM_BUS + lane], bi = BUs[t * SSM_BUS + 64 + lane];
                const float nr = fmaf(ar, hr, fmaf(-ai, hi, br)), ni = fmaf(ar, hi, fmaf(ai, hr, bi)); hr = nr; hi = ni;
                if (FULL) { BUs[t * SSM_BUS + lane] = hr; BUs[t * SSM_BUS + 64 + lane] = hi; } }
            asm volatile("s_waitcnt lgkmcnt(0)" ::: "memory");
            if (FULL) {
                f32x4 y = (f32x4){0.f, 0.f, 0.f, 0.f};
                u32x4 hw[4];
#pragma unroll
                for (int kk = 0; kk < 4; ++kk) { const LAS f32x4* hp = (const LAS f32x4*)(BUs + c * SSM_BUS + 32 * kk + 8 * G4); const f32x4 h0 = hp[0], h1 = hp[1];
                    hw[kk].x = pk2(h0[0], h0[1]); hw[kk].y = pk2(h0[2], h0[3]); hw[kk].z = pk2(h1[0], h1[1]); hw[kk].w = pk2(h1[2], h1[3]); }
#pragma unroll
                for (int kk = 0; kk < 4; ++kk) y = mfma_t(__builtin_bit_cast(bf16x8, hw[kk]), Cf[kk], y);
#pragma unroll
                for (int i = 0; i < 4; ++i) { const float us = Us[(16 * k + 4 * G4 + i) * 16 + c]; Y[(rowbase + t0 + 16 * k + 4 * G4 + i) * D + g * NQ + c] = (bf16_t)f2bf(gelu_tanh(y[i] + dsk * us)); }
                asm volatile("s_waitcnt lgkmcnt(0)" ::: "memory");
            }
        }
    }
}
__device__ __forceinline__ void ssm_item(const Args& a, LAS unsigned char* wl, int j, int L, bool samp, int n, int g, int lane) {
    float hr = 0.f, hi = 0.f;
    if (samp) { hr = a.in[2][((size_t)(j * DB + n) * NG + g) * NP + lane]; hi = a.in[3][((size_t)(j * DB + n) * NG + g) * NP + lane]; }
    ssm_core<true>(a, wl, j, L, samp, n, g, 0, samp ? DSEQ : SEQ, hr, hi, lane);
    const size_t so = ((size_t)(j * (samp ? DB : NB) + n) * NG + g) * NP + lane;
    a.out[(samp ? O_SRS : O_SRP) + so] = hr; a.out[(samp ? O_SIS : O_SIP) + so] = hi;
}
template <bool CONV> __device__ __forceinline__ void ph_ssm(const Args& a, LAS unsigned char* lds, int j, int L, int nblk, int b) {
    const int tid = tid_fresh(); const int wave = __builtin_amdgcn_readfirstlane(tid >> 6), lane = tid & 63;
    LAS unsigned char* wl = CONV ? (wave < 2 ? lds + wave * SSM_WLDS : lds + 2 * SSM_WLDS + (wave - 2) * CONV_LDS) : lds + wave * SSM_WLDS;
    if (wave < 2) { for (int it = b * 2 + wave; it < NB * NG; it += nblk * 2) ssm_item(a, wl, j, L, false, it / NG, it % NG, lane); }
    else { for (int it = b * 6 + (wave - 2); it < DB * NG; it += nblk * 6) ssm_item(a, wl, j, L, true, it / NG, it % NG, lane);
        if (CONV) conv_worker(a, (LAS float*)wl, b * 6 + (wave - 2), nblk * 6, lane); }
}
constexpr int SSM_EXCH = 8 * SSM_WLDS;
__device__ __forceinline__ void ph_ssm_split(const Args& a, LAS unsigned char* lds, int j, int L, int b) {
    unsigned char* ws = a.ws;
    const int tid = tid_fresh(); const int wave = __builtin_amdgcn_readfirstlane(tid >> 6), lane = tid & 63;
    LAS unsigned char* wl = lds + wave * SSM_WLDS; LAS f32x2* exch = (LAS f32x2*)(lds + SSM_EXCH);
    const int seq = 2 * b + (wave >> 2), seg = wave & 3, n = seq / NG, g = seq % NG;
    if (seg < 3) { float er = 0.f, ei = 0.f; ssm_core<false>(a, wl, j, L, false, n, g, 512 * seg, 512 * seg + 512, er, ei, lane); exch[wave * 64 + lane] = (f32x2){er, ei}; }
    else { for (int q = 0; q < 4; ++q) { const int it = 16 * b + 4 * (wave >> 2) + q; ssm_item(a, wl, j, L, true, it / NG, it % NG, lane); } }
    __syncthreads();
    float hr = 0.f, hi = 0.f;
    if (seg > 0) {
        const float* ab = (const float*)(ws + WS_PAR + PAR_ABAR) + ((size_t)(j * NG + g) * NP + lane) * 2; float pr = ab[0], pi = ab[1];
#pragma unroll
        for (int q = 0; q < 9; ++q) { const float nr = pr * pr - pi * pi, ni = 2.f * pr * pi; pr = nr; pi = ni; }
        for (int s2 = 0; s2 < seg; ++s2) { const f32x2 e = exch[((wave & 4) + s2) * 64 + lane]; const float nr = pr * hr - pi * hi + e[0], ni = pr * hi + pi * hr + e[1]; hr = nr; hi = ni; }
    }
    ssm_core<true>(a, wl, j, L, false, n, g, 512 * seg, 512 * seg + 512, hr, hi, lane);
    if (seg == 3) { const size_t so = ((size_t)(j * NB + n) * NG + g) * NP + lane; a.out[O_SRP + so] = hr; a.out[O_SIP + so] = hi; }
    { const int it = 16 * b + 8 + wave; ssm_item(a, wl, j, L, true, it / NG, it % NG, lane); }
}

typedef short s16x4 __attribute__((ext_vector_type(4)));
constexpr int AT_KS = 136, AT_VS = 144;
constexpr int AT_TILE = 64 * AT_KS * 2, AT_VTILE = 64 * AT_VS * 2;
constexpr int AT_LDS_K = 0, AT_LDS_V = 2 * AT_TILE, AT_LDS_TAB = AT_LDS_V + 2 * AT_VTILE, AT_LDS_BYTES = AT_LDS_TAB + 2 * 260 * 4;
template <bool SAMP>
__device__ __forceinline__ void attn_unit(const Args& a, LAS unsigned char* lds, int n, int cch, int hp) {
    unsigned char* ws = a.ws;
    const bf16_t* Qb = (const bf16_t*)(ws + WS_H); const bf16_t* Kb = Qb + (size_t)M * D; const bf16_t* Vb = Kb + (size_t)M * D; bf16_t* Y = (bf16_t*)(ws + WS_Y);
    const int tid = tid_fresh(), wave = __builtin_amdgcn_readfirstlane(tid >> 6), lane = tid & 63, G4 = lane >> 4, c = lane & 15, hh = wave >> 2, w4 = wave & 3;
    LAS float* tabs = (LAS float*)(lds + AT_LDS_TAB);
    const int srow = tid >> 4, scc = tid & 15;
    const int t0 = (!SAMP && cch < 8) ? 8 - cch : 0;
    const size_t qrow0 = SAMP ? (size_t)MP + (size_t)n * 64 : (size_t)n * SEQ + (size_t)cch * 64;
    const int h = 2 * hp + hh;
    __syncthreads();
    for (int i = tid; i < 2 * 257; i += 512) { const int th = i / 257, ti = i - th * 257; tabs[th * 260 + ti] = a.in[18][(size_t)(2 * hp + th) * 257 + ti]; }
    bf16x8 Qf[4];
    { const bf16_t* qp = Qb + (qrow0 + 16 * w4 + c) * D + h * HD + 8 * G4;
#pragma unroll
      for (int kk = 0; kk < 4; ++kk) Qf[kk] = *(const bf16x8*)(qp + 32 * kk); }
    f32x4 st[8];
    auto load_tile = [&](int tau) {
#pragma unroll
        for (int p = 0; p < 8; ++p) { const int r = srow + 32 * p, kv = r >> 7, th = (r >> 6) & 1, key = r & 63; const int hd = 2 * hp + th;
            const size_t krow = SAMP ? (size_t)MP + (size_t)n * 64 + key : (size_t)n * SEQ + (size_t)(cch - 8 + tau) * 64 + key;
            const bf16_t* src = (kv ? Vb : Kb) + krow * D + hd * HD + 8 * scc; st[p] = __builtin_bit_cast(f32x4, *(const u32x4*)src); }
    };
    auto store_tile = [&]() {
#pragma unroll
        for (int p = 0; p < 8; ++p) { const int r = srow + 32 * p, kv = r >> 7, th = (r >> 6) & 1, key = r & 63;
            *(LAS u32x4*)(lds + (kv ? AT_LDS_V + th * AT_VTILE + (key * AT_VS + 8 * scc) * 2 : AT_LDS_K + th * AT_TILE + (key * AT_KS + 8 * scc) * 2)) = __builtin_bit_cast(u32x4, st[p]); }
    };
    auto stage_f32 = [&](int tau) {
#pragma unroll
        for (int hf = 0; hf < 2; ++hf) {
#pragma unroll
            for (int p4 = 0; p4 < 4; ++p4) { const int p = 4 * hf + p4; const int r = srow + 32 * p, kv = r >> 7, th = (r >> 6) & 1, key = r & 63; const int hd = 2 * hp + th;
                const float* src = a.in[kv ? 5 : 4] + (((size_t)n * 512 + (size_t)tau * 64 + key) * NH + hd) * HD + 8 * scc;
                st[2 * p4] = *(const f32x4*)src; st[2 * p4 + 1] = *(const f32x4*)(src + 4); }
#pragma unroll
            for (int p4 = 0; p4 < 4; ++p4) { const int p = 4 * hf + p4; const int r = srow + 32 * p, kv = r >> 7, th = (r >> 6) & 1, key = r & 63;
                const f32x4 x0 = st[2 * p4], x1 = st[2 * p4 + 1]; u32x4 w; w.x = pk2(x0[0], x0[1]); w.y = pk2(x0[2], x0[3]); w.z = pk2(x1[0], x1[1]); w.w = pk2(x1[2], x1[3]);
                *(LAS u32x4*)(lds + (kv ? AT_LDS_V + th * AT_VTILE + (key * AT_VS + 8 * scc) * 2 : AT_LDS_K + th * AT_TILE + (key * AT_KS + 8 * scc) * 2)) = w; } }
    };
    f32x4 O[8];
#pragma unroll
    for (int i = 0; i < 8; ++i) O[i] = (f32x4){0.f, 0.f, 0.f, 0.f};
    float mrun = -1e30f, lrun = 0.f;
    const int qi = 16 * w4 + c;
    if (SAMP) stage_f32(0); else { load_tile(t0); store_tile(); }
    __syncthreads();
    const float bconst = tabs[hh * 260 + 256];
    const LAS unsigned char* kbase = lds + AT_LDS_K + hh * AT_TILE + (c * AT_KS + 8 * G4) * 2;
    const LAS unsigned char* vbase = lds + AT_LDS_V + hh * AT_VTILE + ((4 * G4 + (c >> 2)) * AT_VS + 4 * (c & 3)) * 2;
    for (int tau = t0; tau <= 8; ++tau) {
        if (SAMP ? tau == 7 : tau < 8) load_tile(tau + 1);
        f32x4 sa[4];
#pragma unroll
        for (int sub = 0; sub < 4; ++sub) { sa[sub] = (f32x4){0.f, 0.f, 0.f, 0.f};
            bf16x8 kf[4];
#pragma unroll
            for (int kk = 0; kk < 4; ++kk) kf[kk] = *(const LAS bf16x8*)(kbase + (16 * sub * AT_KS + 32 * kk) * 2);
#pragma unroll
            for (int kk = 0; kk < 4; ++kk) sa[sub] = mfma_t(kf[kk], Qf[kk], sa[sub]); }
        MFMA_POST4(sa[0], sa[1], sa[2], sa[3]);
        float mloc = -1e30f;
#pragma unroll
        for (int sub = 0; sub < 4; ++sub)
#pragma unroll
            for (int i = 0; i < 4; ++i) { float bias = bconst;
                if (tau >= 6) { int rel = qi - ((tau - 8) * 64 + 16 * sub + 4 * G4 + i); rel = rel > 128 ? 128 : rel; bias = tabs[hh * 260 + rel + 128]; }
                const float sv = sa[sub][i] * 0.08838834764831845f + bias; sa[sub][i] = sv; mloc = fmaxf(mloc, sv); }
        mloc = fmaxf(mloc, __shfl_xor(mloc, 16)); mloc = fmaxf(mloc, __shfl_xor(mloc, 32));
        const float mnew = fmaxf(mrun, mloc), alpha = __expf(mrun - mnew); mrun = mnew;
        float ps = 0.f;
#pragma unroll
        for (int sub = 0; sub < 4; ++sub)
#pragma unroll
            for (int i = 0; i < 4; ++i) { const float p = __expf(sa[sub][i] - mnew); sa[sub][i] = p; ps += p; }
        lrun = lrun * alpha + ps;
        u32x4 pw[2];
#pragma unroll
        for (int s2 = 0; s2 < 2; ++s2) { pw[s2].x = pk2(sa[2 * s2][0], sa[2 * s2][1]); pw[s2].y = pk2(sa[2 * s2][2], sa[2 * s2][3]); pw[s2].z = pk2(sa[2 * s2 + 1][0], sa[2 * s2 + 1][1]); pw[s2].w = pk2(sa[2 * s2 + 1][2], sa[2 * s2 + 1][3]); }
#pragma unroll
        for (int i = 0; i < 8; ++i) O[i] = O[i] * alpha;
        asm volatile("s_nop 4" : "+v"(pw[0]), "+v"(pw[1]), "+v"(O[0]), "+v"(O[1]), "+v"(O[2]), "+v"(O[3]), "+v"(O[4]), "+v"(O[5]), "+v"(O[6]), "+v"(O[7]));
#pragma unroll
        for (int dp = 0; dp < 4; ++dp) {
            bf16x8 vf[2][2];
#pragma unroll
            for (int d2 = 0; d2 < 2; ++d2)
#pragma unroll
                for (int s2 = 0; s2 < 2; ++s2) { const int dt = 2 * dp + d2;
                    const s16x4 va = __builtin_amdgcn_ds_read_tr16_b64_v4i16((LAS s16x4*)(vbase + ((32 * s2) * AT_VS + 16 * dt) * 2));
                    const s16x4 vb = __builtin_amdgcn_ds_read_tr16_b64_v4i16((LAS s16x4*)(vbase + ((32 * s2 + 16) * AT_VS + 16 * dt) * 2));
                    vf[d2][s2] = __builtin_shufflevector(va, vb, 0, 1, 2, 3, 4, 5, 6, 7); }
#pragma unroll
            for (int s2 = 0; s2 < 2; ++s2)
#pragma unroll
                for (int d2 = 0; d2 < 2; ++d2) O[2 * dp + d2] = mfma_t(vf[d2][s2], __builtin_bit_cast(bf16x8, pw[s2]), O[2 * dp + d2]); }
        MFMA_POST8(O[0], O[1], O[2], O[3], O[4], O[5], O[6], O[7]);
        if (tau < 8) { __syncthreads(); if (SAMP && tau < 7) stage_f32(tau + 1); else store_tile(); __syncthreads(); }
    }
    float lt = lrun; lt += __shfl_xor(lt, 16); lt += __shfl_xor(lt, 32);
    const float inv = 1.0f / lt;
    bf16_t* yp = Y + (qrow0 + 16 * w4 + c) * D + h * HD + 4 * G4;
#pragma unroll
    for (int dt = 0; dt < 8; ++dt) { u32x2 w; w.x = pk2(O[dt][0] * inv, O[dt][1] * inv); w.y = pk2(O[dt][2] * inv, O[dt][3] * inv); *(u32x2*)(yp + 16 * dt) = w; }
}
constexpr int AT2_BUF = AT_TILE + AT_VTILE;
constexpr int AT2_TAB = 2 * AT2_BUF, AT2_BYTES = AT2_TAB + 260 * 4;
template <bool SAMP>
__device__ __forceinline__ void attn_unit2(const Args& a, LAS unsigned char* lds, int n, int cch, int h) {
    constexpr int QC = SAMP ? 1 : 2;
    unsigned char* ws = a.ws;
    const bf16_t* Qb = (const bf16_t*)(ws + WS_H); const bf16_t* Kb = Qb + (size_t)M * D; const bf16_t* Vb = Kb + (size_t)M * D; bf16_t* Y = (bf16_t*)(ws + WS_Y);
    const int tid = tid_fresh(), wave = __builtin_amdgcn_readfirstlane(tid >> 6), lane = tid & 63, G4 = lane >> 4, c = lane & 15;
    LAS float* tabs = (LAS float*)(lds + AT2_TAB);
    const int k0 = SAMP ? 0 : (cch < 8 ? 0 : cch - 8), k1 = SAMP ? 8 : cch + 1;
    __syncthreads();
    if (wave >= 4) {
        const int tp = tid - 256, prow = tp >> 4, scc = tp & 15;
        f32x4 R[SAMP ? 16 : 8];
        auto tile_load = [&](int kc) {
            if (SAMP && kc < 8) {
#pragma unroll
                for (int p = 0; p < 8; ++p) { const int r = prow + 16 * p, kv = r >> 6, key = r & 63;
                    const float* src = a.in[kv ? 5 : 4] + (((size_t)n * 512 + (size_t)kc * 64 + key) * NH + h) * HD + 8 * scc; R[2 * p] = *(const f32x4*)src; R[2 * p + 1] = *(const f32x4*)(src + 4); }
            } else {
#pragma unroll
                for (int p = 0; p < 8; ++p) { const int r = prow + 16 * p, kv = r >> 6, key = r & 63;
                    const size_t krow = SAMP ? (size_t)MP + (size_t)n * 64 + key : (size_t)n * SEQ + (size_t)kc * 64 + key;
                    R[p] = __builtin_bit_cast(f32x4, *(const u32x4*)((kv ? Vb : Kb) + krow * D + h * HD + 8 * scc)); } }
        };
        auto tile_store = [&](int kc, int buf) {
            LAS unsigned char* bb = lds + buf * AT2_BUF;
#pragma unroll
            for (int p = 0; p < 8; ++p) { const int r = prow + 16 * p, kv = r >> 6, key = r & 63; u32x4 w;
                if (SAMP && kc < 8) { const f32x4 x0 = R[2 * p], x1 = R[2 * p + 1]; w.x = pk2(x0[0], x0[1]); w.y = pk2(x0[2], x0[3]); w.z = pk2(x1[0], x1[1]); w.w = pk2(x1[2], x1[3]); }
                else w = __builtin_bit_cast(u32x4, R[p]);
                *(LAS u32x4*)(bb + (kv ? AT_TILE + (key * AT_VS + 8 * scc) * 2 : (key * AT_KS + 8 * scc) * 2)) = w; }
        };
        for (int i = tp; i < 257; i += 256) tabs[i] = a.in[18][(size_t)h * 257 + i] * 1.4426950408889634f;
        tile_load(k0); tile_store(k0, 0);
        if (k0 < k1) tile_load(k0 + 1);
        __syncthreads();
        for (int kc = k0; kc <= k1; ++kc) {
            if (kc < k1) { tile_store(kc + 1, (kc - k0 + 1) & 1); if (kc + 1 < k1) tile_load(kc + 2); }
            __syncthreads(); }
        return;
    }
    const int w4 = wave;
    bf16x8 Qf[QC][4]; f32x4 O[QC][8]; float mrun[QC], lrun[QC];
#pragma unroll
    for (int q = 0; q < QC; ++q) { const size_t qrow = SAMP ? (size_t)MP + (size_t)n * 64 : (size_t)n * SEQ + (size_t)(cch + q) * 64;
        const bf16_t* qp = Qb + (qrow + 16 * w4 + c) * D + h * HD + 8 * G4;
#pragma unroll
        for (int kk = 0; kk < 4; ++kk) Qf[q][kk] = *(const bf16x8*)(qp + 32 * kk);
#pragma unroll
        for (int i = 0; i < 8; ++i) { O[q][i] = (f32x4){0.f, 0.f, 0.f, 0.f}; OPAQUE(O[q][i]); }
        mrun[q] = -1e30f; lrun[q] = 0.f; }
    const int qi = 16 * w4 + c;
    __syncthreads();
    const float bconst = tabs[256];
    for (int kc = k0; kc <= k1; ++kc) {
        const LAS unsigned char* bb = lds + ((kc - k0) & 1) * AT2_BUF;
        const LAS unsigned char* kbase = bb + (c * AT_KS + 8 * G4) * 2;
        const LAS unsigned char* vbase = bb + AT_TILE + ((4 * G4 + (c >> 2)) * AT_VS + 4 * (c & 3)) * 2;
#pragma unroll
        for (int q = 0; q < QC; ++q) {
            const int tau = SAMP ? kc : kc - (cch + q) + 8;
            if (tau >= 0 && tau <= 8) {
                f32x4 sa[4];
#pragma unroll
                for (int sub = 0; sub < 4; ++sub) { sa[sub] = (f32x4){0.f, 0.f, 0.f, 0.f}; OPAQUE(sa[sub]); }
#pragma unroll
                for (int sub = 0; sub < 4; ++sub)
#pragma unroll
                    for (int kk = 0; kk < 4; ++kk) { const bf16x8 kf = *(const LAS bf16x8*)(kbase + (16 * sub * AT_KS + 32 * kk) * 2); sa[sub] = mfma_a(kf, Qf[q][kk], sa[sub]); }
                float mloc = -1e30f;
#pragma unroll
                for (int sub = 0; sub < 4; ++sub)
#pragma unroll
                    for (int i = 0; i < 4; ++i) { float bias = bconst;
                        if (tau >= 6) { int rel = qi - ((tau - 8) * 64 + 16 * sub + 4 * G4 + i); rel = rel > 128 ? 128 : rel; bias = tabs[rel + 128]; }
                        const float sv = sa[sub][i] * (0.08838834764831845f * 1.4426950408889634f) + bias; sa[sub][i] = sv; mloc = fmaxf(mloc, sv); }
                mloc = fmaxf(mloc, __shfl_xor(mloc, 16)); mloc = fmaxf(mloc, __shfl_xor(mloc, 32));
                const float mnew = fmaxf(mrun[q], mloc), alpha = __builtin_amdgcn_exp2f(mrun[q] - mnew); mrun[q] = mnew;
                float ps = 0.f;
#pragma unroll
                for (int sub = 0; sub < 4; ++sub)
#pragma unroll
                    for (int i = 0; i < 4; ++i) { const float p = __builtin_amdgcn_exp2f(sa[sub][i] - mnew); sa[sub][i] = p; ps += p; }
                lrun[q] = lrun[q] * alpha + ps;
                u32x4 pw[2];
#pragma unroll
                for (int s2 = 0; s2 < 2; ++s2) { pw[s2].x = pk2(sa[2 * s2][0], sa[2 * s2][1]); pw[s2].y = pk2(sa[2 * s2][2], sa[2 * s2][3]); pw[s2].z = pk2(sa[2 * s2 + 1][0], sa[2 * s2 + 1][1]); pw[s2].w = pk2(sa[2 * s2 + 1][2], sa[2 * s2 + 1][3]); }
#pragma unroll
                for (int i = 0; i < 8; ++i) O[q][i] = O[q][i] * alpha;
#pragma unroll
                for (int dt = 0; dt < 8; ++dt)
#pragma unroll
                    for (int s2 = 0; s2 < 2; ++s2) {
                        const s16x4 va = __builtin_amdgcn_ds_read_tr16_b64_v4i16((LAS s16x4*)(vbase + ((32 * s2) * AT_VS + 16 * dt) * 2));
                        const s16x4 vb = __builtin_amdgcn_ds_read_tr16_b64_v4i16((LAS s16x4*)(vbase + ((32 * s2 + 16) * AT_VS + 16 * dt) * 2));
                        O[q][dt] = mfma_a(__builtin_shufflevector(va, vb, 0, 1, 2, 3, 4, 5, 6, 7), __builtin_bit_cast(bf16x8, pw[s2]), O[q][dt]); }
            }
        }
        __syncthreads();
    }
#pragma unroll
    for (int q = 0; q < QC; ++q) {
        float lt = lrun[q]; lt += __shfl_xor(lt, 16); lt += __shfl_xor(lt, 32);
        const float inv = 1.0f / lt;
        const size_t qrow = SAMP ? (size_t)MP + (size_t)n * 64 : (size_t)n * SEQ + (size_t)(cch + q) * 64;
        bf16_t* yp = Y + (qrow + 16 * w4 + c) * D + h * HD + 4 * G4;
#pragma unroll
        for (int dt = 0; dt < 8; ++dt) { u32x2 w; w.x = pk2(O[q][dt][0] * inv, O[q][dt][1] * inv); w.y = pk2(O[q][dt][2] * inv, O[q][dt][3] * inv); *(u32x2*)(yp + 16 * dt) = w; } }
}
__device__ __forceinline__ void ph_attn(const Args& a, LAS unsigned char* lds, int nblk, int b) {
    const int nper = (1536 + nblk - 1) / nblk;
    for (int i = 0; i < nper; ++i) { const int ii = (b & 1) ? (i + 4) % nper : i; const int u = b + ii * nblk; if (u >= 1536) continue;
        if (u < 1024) attn_unit2<false>(a, lds, u >> 8, 2 * ((u >> 4) & 15), u & 15);
        else { const int u2 = u - 1024; attn_unit2<true>(a, lds, u2 >> 4, 8, u2 & 15); }
    }
}

constexpr int HG_S = 136;
constexpr int HG_T64 = 64 * HG_S * 2;
constexpr int HGZ_QT = 0, HGZ_KT = HG_T64, HGZ_QH = 2 * HG_T64, HGZ_IS = 3 * HG_T64, HGZ_SS = 4 * HG_T64, HGZ_PART = HGZ_SS + 128 * HG_S * 2, HGZ_RED = HGZ_PART + 4096, HGZ_BYTES = HGZ_RED + 512;
constexpr int HGX_KH = 0, HGX_IS = HG_T64, HGX_PART = 2 * HG_T64, HGX_DK = HGX_PART + 4096, HGX_OUT = HGX_DK + 512, HGX_BYTES = HGX_OUT + 8 * 4096;
constexpr size_t SCR_DS = 0;
constexpr size_t SCR_DK = SCR_DS + (size_t)2048 * 16384 * 2;
constexpr size_t SCR_SP = SCR_DK + (size_t)2048 * 128 * 4;
static_assert(SCR_SP + (size_t)2048 * 16384 * 2 <= SCR_PART && SCR_PART + (size_t)3 * MS * D * 4 <= 252 * MiB, "scratch map");
struct HgPrep { float g[8][2]; float p[8][2]; float pref[2]; };
__device__ __forceinline__ void hg_loadf(const unsigned short* Fp, int kp, int tq, unsigned (&fv)[8]) {
#pragma unroll
    for (int j = 0; j < 8; ++j) fv[j] = *(const unsigned*)(Fp + (size_t)(8 * tq + j) * D + 2 * kp);
}
__device__ __forceinline__ void hg_prep(const unsigned (&fv)[8], LAS float* part, int kp, int tq, HgPrep& P) {
    float c0 = 1.f, c1 = 1.f;
#pragma unroll
    for (int j = 0; j < 8; ++j) { const f32x2 g = uph2(fv[j]); P.g[j][0] = g[0]; P.g[j][1] = g[1]; c0 *= 1.0f - g[0]; c1 *= 1.0f - g[1]; P.p[j][0] = c0; P.p[j][1] = c1; }
    *(LAS f32x2*)(part + tq * 128 + 2 * kp) = (f32x2){c0, c1};
    __syncthreads();
    float base0 = 1.f, base1 = 1.f, r0 = 1.f, r1 = 1.f;
#pragma unroll
    for (int q = 0; q < 8; ++q) { const f32x2 pp = *(const LAS f32x2*)(part + q * 128 + 2 * kp); if (q < tq) { base0 *= pp[0]; base1 *= pp[1]; } if (q < 4) { r0 *= pp[0]; r1 *= pp[1]; } }
#pragma unroll
    for (int j = 0; j < 8; ++j) { P.p[j][0] *= base0; P.p[j][1] *= base1; }
    P.pref[0] = r0; P.pref[1] = r1;
}
__device__ __forceinline__ bf16x8 tr2(const LAS unsigned char* p0, const LAS unsigned char* p1) {
    const s16x4 va = __builtin_amdgcn_ds_read_tr16_b64_v4i16((LAS s16x4*)p0), vb = __builtin_amdgcn_ds_read_tr16_b64_v4i16((LAS s16x4*)p1);
    return __builtin_shufflevector(va, vb, 0, 1, 2, 3, 4, 5, 6, 7);
}
__device__ __forceinline__ void hg_decode(int u, bool& samp, int& n, int& h, int& ch, size_t& row0) {
    if (u < 2048) { samp = false; ch = u & 31; h = (u >> 5) & 15; n = u >> 9; row0 = (size_t)n * SEQ + (size_t)ch * 64; }
    else { samp = true; const int u2 = u - 2048; h = u2 & 15; n = u2 >> 4; ch = 0; row0 = (size_t)MP + (size_t)n * 64; }
}
constexpr int HX2_KH = 0, HX2_IS = HG_T64, HX2_DK = 2 * HG_T64, HX2_BUF = HX2_DK + 512, HX2_OUT = 2 * HX2_BUF, HX2_BYTES = HX2_OUT + 4 * 8192;
__device__ __forceinline__ void ph_hgrn_x(const Args& a, LAS unsigned char* lds, int nblk, int b) {
    unsigned char* ws = a.ws; const bf16_t* Ib = (const bf16_t*)(ws + WS_H) + (size_t)M * D; const unsigned short* F = (const unsigned short*)(ws + WS_Z);
    const int tid = tid_fresh(), wave = __builtin_amdgcn_readfirstlane(tid >> 6), lane = tid & 63, G4 = lane >> 4, c = lane & 15;
    const int nun = (2560 - b + nblk - 1) / nblk;
    __syncthreads();
    if (wave >= 4) {
        auto prepare = [&](int u, int buf) {
            bool samp; int n, h, ch; size_t row0; hg_decode(u, samp, n, h, ch, row0);
            LAS unsigned char* bb = lds + buf * HX2_BUF;
            if (wave == 4) {
                const unsigned short* Fp = F + row0 * D + h * 128 + 2 * lane; float r0 = 1.f, r1 = 1.f;
                unsigned fv[64];
#pragma unroll
                for (int j = 0; j < 64; ++j) fv[j] = *(const unsigned*)(Fp + (size_t)j * D);
#pragma unroll
                for (int j = 63; j >= 0; --j) { const f32x2 g = uph2(fv[j]);
                    *(LAS unsigned*)(bb + HX2_KH + (j * HG_S + 2 * lane) * 2) = pk2(g[0] * r0, g[1] * r1); r0 *= 1.0f - g[0]; r1 *= 1.0f - g[1]; }
                *(LAS f32x2*)(bb + HX2_DK + 8 * lane) = (f32x2){r0, r1};
                if (!samp) *(f32x2*)((float*)(ws + WS_SCR + SCR_DK) + (size_t)u * 128 + 2 * lane) = (f32x2){r0, r1};
            } else if (wave < 7) {
                const int t2 = tid - 320, r = t2 >> 1, hf = t2 & 1; const u32x4* src = (const u32x4*)(Ib + (row0 + r) * D + h * 128 + 64 * hf);
                LAS u32x4* dst = (LAS u32x4*)(bb + HX2_IS + (r * HG_S + 64 * hf) * 2); u32x4 v[8];
#pragma unroll
                for (int i = 0; i < 8; ++i) v[i] = src[i];
#pragma unroll
                for (int i = 0; i < 8; ++i) dst[i] = v[i];
            }
        };
        prepare(b, 0);
        __syncthreads();
        for (int i = 0; i < nun; ++i) { if (i + 1 < nun) prepare(b + (i + 1) * nblk, (i + 1) & 1); __syncthreads(); }
        return;
    }
    __syncthreads();
    for (int i = 0; i < nun; ++i) {
        const int u = b + i * nblk; bool samp; int n, h, ch; size_t row0; hg_decode(u, samp, n, h, ch, row0);
        const LAS unsigned char* bb = lds + (i & 1) * HX2_BUF; const LAS float* dk = (const LAS float*)(bb + HX2_DK);
        LAS unsigned char* ost = lds + HX2_OUT + wave * 8192;
#pragma unroll
        for (int m2 = 0; m2 < 2; ++m2) { const int mk = 2 * wave + m2;
            const LAS unsigned char* ka = bb + HX2_KH + ((8 * G4 + (c >> 2)) * HG_S + 16 * mk + 4 * (c & 3)) * 2;
            const LAS unsigned char* ia = bb + HX2_IS + ((8 * G4 + (c >> 2)) * HG_S + 4 * (c & 3)) * 2;
            bf16x8 kfr[2];
#pragma unroll
            for (int kt = 0; kt < 2; ++kt) kfr[kt] = tr2(ka + (32 * kt) * HG_S * 2, ka + (32 * kt + 4) * HG_S * 2);
            const float dkc = dk[16 * mk + c];
#pragma unroll
            for (int nv = 0; nv < 8; ++nv) { f32x4 acc = (f32x4){0.f, 0.f, 0.f, 0.f}; OPAQUE(acc);
#pragma unroll
                for (int kt = 0; kt < 2; ++kt) { const bf16x8 ifr = tr2(ia + ((32 * kt) * HG_S + 16 * nv) * 2, ia + ((32 * kt + 4) * HG_S + 16 * nv) * 2); acc = mfma_a(ifr, kfr[kt], acc); }
                if (!samp) { u32x2 w; w.x = pk2(acc[0], acc[1]); w.y = pk2(acc[2], acc[3]); *(LAS u32x2*)(ost + m2 * 4096 + (c * 128 + 16 * nv + 4 * G4) * 2) = w; }
                else { const size_t so = (((size_t)n * NH + h) * 128 + 16 * mk + c) * 128 + 16 * nv + 4 * G4;
                    const f32x4 s0 = *(const f32x4*)(a.in[6] + so); *(f32x4*)(a.out + O_HS + so) = dkc * s0 + acc; } } }
        if (!samp) {
            asm volatile("s_waitcnt lgkmcnt(0)" ::: "memory");
            bf16_t* dsu = (bf16_t*)(ws + WS_SCR + SCR_DS) + (size_t)u * 16384 + (size_t)(32 * wave) * 128;
#pragma unroll
            for (int q = 0; q < 8; ++q) { const int row = 4 * q + (lane >> 4), chq = lane & 15; *(u32x4*)(dsu + row * 128 + 8 * chq) = *(const LAS u32x4*)(ost + (row * 128 + 8 * chq) * 2); }
            asm volatile("s_waitcnt lgkmcnt(0)" ::: "memory");
        }
        __syncthreads();
    }
}
__device__ __forceinline__ void ph_hgrn_y(const Args& a, int nblk, int b) {
    unsigned char* ws = a.ws; const bf16_t* DS = (const bf16_t*)(ws + WS_SCR + SCR_DS); const float* DK = (const float*)(ws + WS_SCR + SCR_DK); bf16_t* SP = (bf16_t*)(ws + WS_SCR + SCR_SP);
    const int nth = nblk * 512;
    const int tid = tid_fresh();
    for (int e4 = b * 512 + tid; e4 < 64 * 4096; e4 += nth) {
        const int pr = e4 >> 12, off = (e4 & 4095) * 4, k = off >> 7;
        f32x4 S = (f32x4){0.f, 0.f, 0.f, 0.f};
#pragma unroll 1
        for (int c8 = 0; c8 < 32; c8 += 8) {
            f32x4 d[8]; float dk[8];
#pragma unroll
            for (int i = 0; i < 8; ++i) { const size_t u = (size_t)pr * 32 + c8 + i; const u32x2 w = *(const u32x2*)(DS + u * 16384 + off);
                d[i] = (f32x4){__builtin_bit_cast(float, w.x << 16), __builtin_bit_cast(float, w.x & 0xffff0000u), __builtin_bit_cast(float, w.y << 16), __builtin_bit_cast(float, w.y & 0xffff0000u)}; dk[i] = DK[u * 128 + k]; }
#pragma unroll
            for (int i = 0; i < 8; ++i) { const size_t u = (size_t)pr * 32 + c8 + i;
                u32x2 w; w.x = pk2(S[0], S[1]); w.y = pk2(S[2], S[3]); *(u32x2*)(SP + u * 16384 + off) = w; S = S * dk[i] + d[i]; } }
        *(f32x4*)(a.out + O_HP + (size_t)pr * 16384 + off) = S;
    }
}
__device__ __forceinline__ void ph_hgrn_z(const Args& a, LAS unsigned char* lds, int nblk, int b) {
    unsigned char* ws = a.ws; const bf16_t* Qb = (const bf16_t*)(ws + WS_H); const bf16_t* Ib = Qb + (size_t)M * D; const bf16_t* Gb = Ib + (size_t)M * D; const unsigned short* F = (const unsigned short*)(ws + WS_Z);
    bf16_t* Y = (bf16_t*)(ws + WS_Y); const bf16_t* SP = (const bf16_t*)(ws + WS_SCR + SCR_SP);
    const int tid = tid_fresh(), wave = __builtin_amdgcn_readfirstlane(tid >> 6), lane = tid & 63, G4 = lane >> 4, c = lane & 15, kp = tid & 63, tq = tid >> 6;
    LAS float* part = (LAS float*)(lds + HGZ_PART); LAS float* red = (LAS float*)(lds + HGZ_RED);
    const int mt = wave;
    unsigned fF[8]; unsigned fQ[8]; u32x4 fI[2]; f32x4 fS[8];
    auto ldunit = [&](int u2) { bool s2; int n2, h2, c2; size_t r2; hg_decode(u2, s2, n2, h2, c2, r2); hg_loadf(F + r2 * D + h2 * 128, kp, tq, fF);
#pragma unroll
        for (int j = 0; j < 8; ++j) fQ[j] = *(const unsigned*)(Qb + (r2 + 8 * tq + j) * D + h2 * 128 + 2 * kp);
        const u32x4* src = (const u32x4*)(Ib + (r2 + (tid >> 3)) * D + h2 * 128 + 16 * (tid & 7)); fI[0] = src[0]; fI[1] = src[1];
        const int r = tid >> 2, cq = tid & 3;
        if (!s2) { const u32x4* sp = (const u32x4*)(SP + (size_t)u2 * 16384 + r * 128 + 32 * cq);
#pragma unroll
            for (int i = 0; i < 4; ++i) fS[i] = __builtin_bit_cast(f32x4, sp[i]); }
        else { const f32x4* sp = (const f32x4*)(a.in[6] + (((size_t)n2 * NH + h2) * 128 + r) * 128 + 32 * cq);
#pragma unroll
            for (int i = 0; i < 8; ++i) fS[i] = sp[i]; } };
    __syncthreads();
    if (tid < 128) red[tid] = a.in[22][tid];
    if (b < 2560) ldunit(b);
    for (int u = b; u < 2560; u += nblk) {
        bool samp; int n, h, ch; size_t row0; hg_decode(u, samp, n, h, ch, row0);
        __syncthreads();
        HgPrep P; hg_prep(fF, part, kp, tq, P);
#pragma unroll
        for (int j = 0; j < 8; ++j) { const int t = 8 * tq + j; const unsigned qw = fQ[j];
            const float q0 = __builtin_bit_cast(float, qw << 16), q1 = __builtin_bit_cast(float, qw & 0xffff0000u);
            const float ir0 = __builtin_amdgcn_rcpf(P.pref[0]), ir1 = __builtin_amdgcn_rcpf(P.pref[1]), ip0 = __builtin_amdgcn_rcpf(P.p[j][0]), ip1 = __builtin_amdgcn_rcpf(P.p[j][1]);
            *(LAS unsigned*)(lds + HGZ_QT + (t * HG_S + 2 * kp) * 2) = pk2(q0 * P.p[j][0] * ir0, q1 * P.p[j][1] * ir1);
            *(LAS unsigned*)(lds + HGZ_KT + (t * HG_S + 2 * kp) * 2) = pk2(P.g[j][0] * P.pref[0] * ip0, P.g[j][1] * P.pref[1] * ip1);
            *(LAS unsigned*)(lds + HGZ_QH + (t * HG_S + 2 * kp) * 2) = pk2(q0 * P.p[j][0], q1 * P.p[j][1]); }
        { const int r = tid >> 3, cq = tid & 7; LAS u32x4* dst = (LAS u32x4*)(lds + HGZ_IS + (r * HG_S + 16 * cq) * 2); dst[0] = fI[0]; dst[1] = fI[1]; }
        { const int r = tid >> 2, cq = tid & 3; LAS u32x4* dst = (LAS u32x4*)(lds + HGZ_SS + (r * HG_S + 32 * cq) * 2);
          if (!samp) {
#pragma unroll
              for (int i = 0; i < 4; ++i) dst[i] = __builtin_bit_cast(u32x4, fS[i]); }
          else {
#pragma unroll
              for (int i = 0; i < 4; ++i) { const f32x4 x0 = fS[2 * i], x1 = fS[2 * i + 1]; u32x4 w; w.x = pk2(x0[0], x0[1]); w.y = pk2(x0[2], x0[3]); w.z = pk2(x1[0], x1[1]); w.w = pk2(x1[2], x1[3]); dst[i] = w; } } }
        if (u + nblk < 2560) ldunit(u + nblk);
        __syncthreads();
        if (wave < 4) {
        const size_t yo = (row0 + 16 * mt + c) * D + h * 128 + 4 * G4;
        bf16x8 Qf[4], kf[4][4], vf0[8];
#pragma unroll
        for (int kk = 0; kk < 4; ++kk) Qf[kk] = *(const LAS bf16x8*)(lds + HGZ_QT + ((16 * mt + c) * HG_S + 32 * kk + 8 * G4) * 2);
#pragma unroll
        for (int ns = 0; ns < 4; ++ns)
#pragma unroll
            for (int kk = 0; kk < 4; ++kk) kf[ns][kk] = *(const LAS bf16x8*)(lds + HGZ_KT + ((16 * ns + c) * HG_S + 32 * kk + 8 * G4) * 2);
        const LAS unsigned char* ia = lds + HGZ_IS + ((4 * G4 + (c >> 2)) * HG_S + 4 * (c & 3)) * 2;
        const LAS unsigned char* sa = lds + HGZ_SS + ((8 * G4 + (c >> 2)) * HG_S + 4 * (c & 3)) * 2;
#pragma unroll
        for (int j = 0; j < 8; ++j) vf0[j] = tr2(ia + (16 * j) * 2, ia + (16 * HG_S + 16 * j) * 2);
        f32x4 At[4];
#pragma unroll
        for (int ns = 0; ns < 4; ++ns) { At[ns] = (f32x4){0.f, 0.f, 0.f, 0.f}; OPAQUE(At[ns]); }
#pragma unroll
        for (int kk = 0; kk < 4; ++kk)
#pragma unroll
            for (int ns = 0; ns < 4; ++ns) At[ns] = mfma_a(kf[ns][kk], Qf[kk], At[ns]);
        u32x2 gwv[8];
#pragma unroll
        for (int j = 0; j < 8; ++j) gwv[j] = *(const u32x2*)(Gb + yo + 16 * j);
        bf16x8 vf1[8], qh[4], sf[2][8];
#pragma unroll
        for (int j = 0; j < 8; ++j) vf1[j] = tr2(ia + ((32) * HG_S + 16 * j) * 2, ia + ((32 + 16) * HG_S + 16 * j) * 2);
#pragma unroll
        for (int kk = 0; kk < 4; ++kk) qh[kk] = *(const LAS bf16x8*)(lds + HGZ_QH + ((16 * mt + c) * HG_S + 32 * kk + 8 * G4) * 2);
#pragma unroll
        for (int ns = 0; ns < 4; ++ns)
#pragma unroll
            for (int i = 0; i < 4; ++i) if (16 * ns + 4 * G4 + i > 16 * mt + c) At[ns][i] = 0.f;
        f32x4 o[8];
#pragma unroll
        for (int j = 0; j < 8; ++j) { o[j] = (f32x4){0.f, 0.f, 0.f, 0.f}; OPAQUE(o[j]); }
        u32x4 pw[2];
#pragma unroll
        for (int ks = 0; ks < 2; ++ks) { pw[ks].x = pk2(At[2 * ks][0], At[2 * ks][1]); pw[ks].y = pk2(At[2 * ks][2], At[2 * ks][3]); pw[ks].z = pk2(At[2 * ks + 1][0], At[2 * ks + 1][1]); pw[ks].w = pk2(At[2 * ks + 1][2], At[2 * ks + 1][3]); }
#pragma unroll
        for (int j = 0; j < 8; ++j) o[j] = mfma_a(vf0[j], __builtin_bit_cast(bf16x8, pw[0]), o[j]);
#pragma unroll
        for (int j = 0; j < 8; ++j) sf[0][j] = tr2(sa + (16 * j) * 2, sa + (4 * HG_S + 16 * j) * 2);
#pragma unroll
        for (int j = 0; j < 8; ++j) o[j] = mfma_a(vf1[j], __builtin_bit_cast(bf16x8, pw[1]), o[j]);
#pragma unroll
        for (int kk = 0; kk < 4; ++kk) {
            if (kk < 3) {
#pragma unroll
                for (int j = 0; j < 8; ++j) sf[(kk + 1) & 1][j] = tr2(sa + ((32 * (kk + 1)) * HG_S + 16 * j) * 2, sa + ((32 * (kk + 1) + 4) * HG_S + 16 * j) * 2); }
#pragma unroll
            for (int j = 0; j < 8; ++j) o[j] = mfma_a(sf[kk & 1][j], qh[kk], o[j]); }
        float ss = 0.f;
#pragma unroll
        for (int j = 0; j < 8; ++j)
#pragma unroll
            for (int i = 0; i < 4; ++i) ss += o[j][i] * o[j][i];
        ss += __shfl_xor(ss, 16); ss += __shfl_xor(ss, 32);
        const float sc = 1.0f / sqrtf(ss * (1.0f / 128.0f) + RMS_EPS);
#pragma unroll
        for (int j = 0; j < 8; ++j) { const u32x2 gw = gwv[j]; const f32x4 ng = *(const LAS f32x4*)(red + 16 * j + 4 * G4);
            const float g0 = __builtin_bit_cast(float, gw.x << 16), g1 = __builtin_bit_cast(float, gw.x & 0xffff0000u), g2 = __builtin_bit_cast(float, gw.y << 16), g3 = __builtin_bit_cast(float, gw.y & 0xffff0000u);
            u32x2 w; w.x = pk2(o[j][0] * sc * ng[0] * g0 * sigmoidf_(g0), o[j][1] * sc * ng[1] * g1 * sigmoidf_(g1)); w.y = pk2(o[j][2] * sc * ng[2] * g2 * sigmoidf_(g2), o[j][3] * sc * ng[3] * g3 * sigmoidf_(g3));
            *(u32x2*)(Y + yo + 16 * j) = w; }
        }
    }
}

template <int L> __device__ __forceinline__ void do_layer(const Args& a, LAS unsigned char* lds, const XcdBarrier& bar, int G, int b) {
    unsigned char* ws = a.ws;
    bf16_t* XB = (bf16_t*)(ws + WS_XB); bf16_t* Z = (bf16_t*)(ws + WS_Z); unsigned short* ZF = (unsigned short*)(ws + WS_Z); bf16_t* H = (bf16_t*)(ws + WS_H); bf16_t* Y = (bf16_t*)(ws + WS_Y);
    constexpr int kind = L % 3, j = L / 3; bf16_t* PS = (bf16_t*)(ws + WS_SCR + SCR_PART);
    if constexpr (kind == 0) {
        if (L == 0 || G != 256) ph_ssm<L == 0>(a, lds, j, L, G, b); else ph_ssm_split(a, lds, j, L, b);
        xcd_barrier(bar);
        pg8::Gemm g{Y, (const bf16_t*)(ws + WS_WSSM) + (size_t)j * 4096 * D, D, D}; pg8::BStatOrder S; S.init(M, 4096, D, b);
        EpiSsmGate E{Z}; pg8::gemm_phase<EpiSsmGate, pg8::BStatOrder>(lds, g, S, E);
    } else if constexpr (kind == 1) {
        { pg8::Gemm g{XB, (const bf16_t*)(ws + WS_WQKV), D, D}; pg8::BStatOrder S; S.init(M, 6144, D, b);
          EpiQkv E{H, a.out}; pg8::gemm_phase<EpiQkv, pg8::BStatOrder>(lds, g, S, E); }
        xcd_barrier(bar);
        ph_attn(a, lds, G, b);
        xcd_barrier(bar);
        { pg8::Gemm g{Y, (const bf16_t*)(ws + WS_WAO), D, D}; pg8::SplitOrder S; S.init(D, b);
          EpiRes E{Z, PS}; pg8::gemm_phase<EpiRes, pg8::SplitOrder>(lds, g, S, E); }
    } else {
        { pg8::Gemm g{XB, (const bf16_t*)(ws + WS_WHIN), D, D}; pg8::BStatOrder S; S.init(M, 8192, D, b);
          EpiHgrnIn E{H, ZF, (const float*)(ws + WS_PAR + PAR_LB)}; pg8::gemm_phase<EpiHgrnIn, pg8::BStatOrder>(lds, g, S, E); }
        xcd_barrier(bar);
        ph_hgrn_x(a, lds, G, b);
        xcd_barrier(bar);
        ph_hgrn_y(a, G, b);
        xcd_barrier(bar);
        ph_hgrn_z(a, lds, G, b);
        xcd_barrier(bar);
        { pg8::Gemm g{Y, (const bf16_t*)(ws + WS_WHO), D, D}; pg8::SplitOrder S; S.init(D, b);
          EpiRes E{Z, PS}; pg8::gemm_phase<EpiRes, pg8::SplitOrder>(lds, g, S, E); }
    }
    xcd_barrier(bar);
    ph_ln(a, L, 0, false, kind != 0, false, L == 0, G, b);
    xcd_barrier(bar);
    { pg8::Gemm g{XB, (const bf16_t*)(ws + WS_WF1) + (size_t)L * FF * D, D, D}; pg8::BStatOrder S; S.init(M, FF, D, b);
      EpiFfn1 E{H}; pg8::gemm_phase<EpiFfn1, pg8::BStatOrder>(lds, g, S, E); }
    xcd_barrier(bar);
    { pg8::Gemm g{H, (const bf16_t*)(ws + WS_WF2) + (size_t)L * FF * D, FF, FF}; pg8::SplitOrder S; S.init(FF, b);
      EpiRes E{Z, PS}; pg8::gemm_phase<EpiRes, pg8::SplitOrder, true>(lds, g, S, E); }
    xcd_barrier(bar);
    ph_ln(a, L, 1, L == 3, true, L == 2, false, G, b);
    if constexpr (L < 3) xcd_barrier(bar);
}
constexpr int LDS_BAR_OFF = 131072;
constexpr int LDS_BYTES = LDS_BAR_OFF + 1024;
static_assert(pg8::STAGE_BYTES <= LDS_BAR_OFF && HGZ_BYTES <= LDS_BAR_OFF && HX2_BYTES <= LDS_BAR_OFF && AT2_BYTES <= LDS_BAR_OFF && SSM_EXCH + 8 * 64 * 8 <= LDS_BAR_OFF && 2 * SSM_WLDS + 6 * CONV_LDS <= LDS_BAR_OFF && CONV_LDS >= SSM_WLDS, "LDS map");
constexpr int CW_BAR = 4096;
__global__ void __launch_bounds__(512, 2) k_mega(Args a) {
    extern __shared__ __attribute__((aligned(16))) unsigned char lds_raw[];
    LAS unsigned char* lds = (LAS unsigned char*)lds_raw;
    unsigned char* ws = a.ws;
    if (threadIdx.x < 4) ((LAS unsigned*)(lds + LDS_BAR_OFF))[threadIdx.x] = 0u;
    __syncthreads();
    const XcdBarrier bar = xcd_barrier_post((unsigned*)(ws + WS_CTL) + CW_BAR, (volatile LAS unsigned*)(lds + LDS_BAR_OFF));
    const int G = gridDim.x, b = blockIdx.x;
    ph_params(a, G, b);
    xcd_barrier(bar);
    do_layer<0>(a, lds, bar, G, b);
    do_layer<1>(a, lds, bar, G, b);
    do_layer<2>(a, lds, bar, G, b);
    do_layer<3>(a, lds, bar, G, b);
}

extern "C" void kernel_launch(void* const* d_in, const int* in_sizes, int n_in, void* d_out, int out_size, void* d_ws, size_t ws_size, hipStream_t stream) {
    static int grid = 0;
    if (grid == 0) {
        if (n_in != 30 || (size_t)out_size != O_END || ws_size < WS_END) { fprintf(stderr, "kernel_launch: unexpected shapes (n_in %d out %d ws %zu, need %zu)\n", n_in, out_size, ws_size, (size_t)WS_END); grid = -1; return; }
        int dev = 0, cus = 0, per_cu = 0;
        if (hipGetDevice(&dev) != hipSuccess || hipDeviceGetAttribute(&cus, hipDeviceAttributeMultiprocessorCount, dev) != hipSuccess) { grid = -1; return; }
        if (hipFuncSetAttribute((const void*)k_mega, hipFuncAttributeMaxDynamicSharedMemorySize, LDS_BYTES) != hipSuccess) { fprintf(stderr, "kernel_launch: hipFuncSetAttribute failed\n"); grid = -1; return; }
        if (hipOccupancyMaxActiveBlocksPerMultiprocessor(&per_cu, (const void*)k_mega, 512, LDS_BYTES) != hipSuccess || per_cu < 1) fprintf(stderr, "kernel_launch: occupancy query says %d\n", per_cu);
        (void)hipGetLastError();
        grid = cus;
    }
    if (grid < 0) return;
    (void)hipMemsetAsync((char*)d_ws + WS_CTL, 0, 64 * 1024, stream);
    Args a{}; for (int i = 0; i < 30; ++i) a.in[i] = (const float*)d_in[i]; a.out = (float*)d_out; a.ws = (unsigned char*)d_ws;
    hipLaunchKernelGGL(k_mega, dim3(grid), dim3(512), LDS_BYTES, stream, a);
}
```
